# Optimizing an MI355X kernel written in HIP

```python
import math
import jax
import jax.numpy as jnp
from jax import lax
import numpy as np

D_MODEL = 1024
BATCH = 16
SEQ = 2048
DEPTH = 2

CTX_LEN = 256
GRID_W = 64
D_MIX = D_MODEL
W_A = D_MIX // 4
W_B = D_MIX // 4
W_C = D_MIX // 4
W_D = D_MIX - W_A - W_B - W_C
MLSTM_HEADS = 4
MLSTM_HD = W_A // MLSTM_HEADS
MLSTM_CHUNK = 64
SGU_GROUPS = 4
SGU_GD = W_B // SGU_GROUPS
SGU_CHUNK = 128
CONV_WIDTH = 31
CONV_PAD = CONV_WIDTH // 2
S5_P = 16
S5_GROUPS = W_D // S5_P
S5_N = 64
D_FF = -(-8 * D_MODEL // (3 * 256)) * 256
ALPHA = (2 * DEPTH) ** 0.25
BETA = (8 * DEPTH) ** -0.25
LN_EPS = 1e-5
OFF_B = 4 * W_A + 4 * MLSTM_HEADS
OFF_C = OFF_B + 2 * W_B
OFF_D = OFF_C + 2 * W_C
P_IN = OFF_D + W_D

kernel_name = 'hybrid_parallel_mlstm_sgu_conv_s5_dit'


def layer_norm(x, w, b):
    xf = x.astype(jnp.float32)
    mu = jnp.mean(xf, -1, keepdims=True)
    var = jnp.mean(jnp.square(xf - mu), -1, keepdims=True)
    return ((xf - mu) * lax.rsqrt(var + LN_EPS) * w + b).astype(x.dtype)


def swiglu(h, w_in, w_out):
    g, u = jnp.split(h @ w_in, 2, axis=-1)
    return (jax.nn.silu(g) * u) @ w_out


def mlstm_split(z, gate_bias):
    bsz, t, _ = z.shape
    heads = lambda a: a.reshape(bsz, t, MLSTM_HEADS, MLSTM_HD).transpose(0, 2, 1, 3)
    q, k, v, o = (z[..., i * W_A:(i + 1) * W_A] for i in range(4))
    g = (z[..., 4 * W_A:] + gate_bias).astype(jnp.float32)
    g = g.reshape(bsz, t, 4, MLSTM_HEADS).transpose(2, 0, 3, 1)
    gates = (g[0], jax.nn.log_sigmoid(g[1]), g[2], jax.nn.log_sigmoid(g[3]))
    return heads(q), heads(k) * MLSTM_HD ** -0.5, heads(v), o, gates


def mlstm_zero_state(bsz):
    return (jnp.zeros((bsz, MLSTM_HEADS, MLSTM_HD, MLSTM_HD), jnp.float32),
            jnp.zeros((bsz, MLSTM_HEADS, MLSTM_HD), jnp.float32),
            jnp.zeros((bsz, MLSTM_HEADS), jnp.float32))


def mlstm_context_state(k, v, ig, lf):
    k, v = k.astype(jnp.float32), v.astype(jnp.float32)
    cum = jnp.cumsum(lf, axis=-1)
    logw = cum[..., -1:] - cum + ig
    m = jnp.max(logw, axis=-1)
    e = jnp.exp(logw - m[..., None])
    C = jnp.einsum('bht,bhtv,bhtk->bhvk', e, v, k)
    n = jnp.einsum('bht,bhtk->bhk', e, k)
    return (C, n, m)


def mlstm_chunkwise(q, k, v, ig, lf, state):
    bsz, nh, t, d = q.shape
    nc = t // MLSTM_CHUNK
    chunks = lambda a: jnp.moveaxis(a.astype(jnp.float32).reshape(bsz, nh, nc, MLSTM_CHUNK, *a.shape[3:]), 2, 0)
    xs = tuple(chunks(a) for a in (q, k, v, ig, lf))
    lower = jnp.tril(jnp.ones((MLSTM_CHUNK, MLSTM_CHUNK), bool))

    def step(carry, inp):
        C, n, m = carry
        qc, kc, vc, ic, fc = inp
        b = jnp.cumsum(fc, axis=-1)
        logw = jnp.where(lower, b[..., :, None] - b[..., None, :] + ic[..., None, :], -jnp.inf)
        inter = b + m[..., None]
        m_t = jnp.maximum(inter, jnp.max(logw, axis=-1))
        w_inter = jnp.exp(inter - m_t)
        s = jnp.einsum('bhtd,bhsd->bhts', qc, kc) * jnp.exp(logw - m_t[..., None])
        num = jnp.einsum('bhts,bhsd->bhtd', s, vc) + w_inter[..., None] * jnp.einsum('bhvk,bhtk->bhtv', C, qc)
        den = jnp.sum(s, axis=-1) + w_inter * jnp.einsum('bhk,bhtk->bht', n, qc)
        h = num / jnp.maximum(jnp.abs(den), jnp.exp(-m_t))[..., None]
        b_end = b[..., -1]
        logu = b_end[..., None] - b + ic
        m_new = jnp.maximum(b_end + m, jnp.max(logu, axis=-1))
        e = jnp.exp(logu - m_new[..., None])
        decay = jnp.exp(b_end + m - m_new)
        C = decay[..., None, None] * C + jnp.einsum('bhs,bhsv,bhsk->bhvk', e, vc, kc)
        n = decay[..., None] * n + jnp.einsum('bhs,bhsk->bhk', e, kc)
        return (C, n, m_new), h

    state, h = lax.scan(step, state, xs)
    return jnp.moveaxis(h, 0, 2).reshape(bsz, nh, t, d), state


def mlstm_readout(h, o, norm_w):
    bsz, _, t, _ = h.shape
    h = h.transpose(0, 2, 1, 3)
    mu = jnp.mean(h, -1, keepdims=True)
    var = jnp.mean(jnp.square(h - mu), -1, keepdims=True)
    hn = (h - mu) * lax.rsqrt(var + LN_EPS) * norm_w.reshape(MLSTM_HEADS, MLSTM_HD)
    return (hn.reshape(bsz, t, W_A) * jax.nn.sigmoid(o.astype(jnp.float32))).astype(o.dtype)


def mlstm_mixer(zl, zc, gate_bias, norm_w, need_ctx):
    ql, kl, vl, ol, gl = mlstm_split(zl, gate_bias)
    qc, kc, vc, oc, gc = mlstm_split(zc, gate_bias)
    hl_dirs, hc_dirs = [], []
    for d in range(2):
        orient = (lambda a: jnp.flip(a, axis=2)) if d else (lambda a: a)
        if need_ctx:
            hc, state = mlstm_chunkwise(orient(qc), orient(kc), orient(vc), orient(gc[2 * d]),
                                        orient(gc[2 * d + 1]), mlstm_zero_state(zc.shape[0]))
            hc_dirs.append(orient(hc))
        else:
            state = mlstm_context_state(orient(kc), orient(vc), orient(gc[2 * d]), orient(gc[2 * d + 1]))
        hl, _ = mlstm_chunkwise(orient(ql), orient(kl), orient(vl), orient(gl[2 * d]), orient(gl[2 * d + 1]), state)
        hl_dirs.append(orient(hl))
    yl = mlstm_readout(hl_dirs[0] + hl_dirs[1], ol, norm_w)
    yc = mlstm_readout(hc_dirs[0] + hc_dirs[1], oc, norm_w) if need_ctx else None
    return yl, yc


def sgu_mixer(z, ln_w, ln_b, w_s, b_s):
    bsz, t, _ = z.shape
    u = jax.nn.gelu(z[..., :W_B])
    v = layer_norm(jax.nn.gelu(z[..., W_B:]), ln_w, ln_b)
    v = v.reshape(bsz, t // SGU_CHUNK, SGU_CHUNK, SGU_GROUPS, SGU_GD)
    v = jnp.einsum('gts,bnsgc->bntgc', w_s, v) + b_s.T[:, :, None]
    return u * v.reshape(bsz, t, W_B)


def conv_mixer(z, w, b, ln_w, ln_b, rows):
    a = z[..., :W_C] * jax.nn.sigmoid(z[..., W_C:])
    bsz, t, ch = a.shape
    a = a.reshape(bsz * rows, t // rows, ch)
    a = lax.conv_general_dilated(a, w[:, None, :], window_strides=(1,), padding=[(CONV_PAD, CONV_PAD)],
                                 dimension_numbers=('NWC', 'WIO', 'NWC'), feature_group_count=ch)
    a = a.reshape(bsz, t, ch) + b
    return jax.nn.silu(layer_norm(a, ln_w, ln_b))


def s5_discretize(a_re, a_im, log_dt, b_re, b_im):
    lam = lax.complex(a_re.astype(jnp.float32), a_im.astype(jnp.float32))
    lam_dt = lam * jnp.exp(log_dt.astype(jnp.float32))[:, None]
    a_bar = jnp.exp(lam_dt)
    b_bar = ((a_bar - 1.0) / lam)[..., None] * lax.complex(b_re.astype(jnp.float32), b_im.astype(jnp.float32))
    return lam_dt, a_bar, b_bar


def s5_scan(bu, a_bar):
    def combine(left, right):
        a_l, b_l = left
        a_r, b_r = right
        return a_r * a_l, a_r * b_l + b_r
    a = jnp.broadcast_to(a_bar, (1,) + bu.shape[1:])
    return lax.associative_scan(combine, (a, bu), axis=1)[1]


def s5_final_state(bu, lam_dt):
    t = bu.shape[1]
    lags = jnp.arange(t - 1, -1, -1, dtype=jnp.float32)
    return jnp.einsum('tgn,btgn->bgn', jnp.exp(lags[:, None, None] * lam_dt), bu)


def s5_mixer(zl, zc, a_re, a_im, log_dt, b_re, b_im, c_re, c_im, d_skip, glu_w, glu_b, need_ctx):
    grouped = lambda z: z.astype(jnp.float32).reshape(z.shape[0], z.shape[1], S5_GROUPS, S5_P)
    ul, uc = grouped(zl), grouped(zc)
    xl_dirs, xc_dirs = [], []
    for d in range(2):
        orient = (lambda a: jnp.flip(a, axis=1)) if d else (lambda a: a)
        lam_dt, a_bar, b_bar = s5_discretize(a_re[d], a_im[d], log_dt[d], b_re, b_im)
        bul = orient(jnp.einsum('btgp,gnp->btgn', ul, b_bar))
        buc = orient(jnp.einsum('btgp,gnp->btgn', uc, b_bar))
        if need_ctx:
            sc = s5_scan(buc, a_bar)
            h0 = sc[:, -1]
            xc_dirs.append(orient(sc))
        else:
            h0 = s5_final_state(buc, lam_dt)
        sl = s5_scan(bul.at[:, 0].add(a_bar * h0), a_bar)
        xl_dirs.append(orient(sl))
    c_mat = lax.complex(c_re.astype(jnp.float32), c_im.astype(jnp.float32))
    d_mat = d_skip.astype(jnp.float32).reshape(S5_GROUPS, S5_P)

    def readout(states, u, dtype):
        y = jnp.real(jnp.einsum('gpn,btgn->btgp', c_mat, states)) + d_mat * u
        y = jax.nn.gelu(y.reshape(u.shape[0], u.shape[1], W_D))
        return (y * jax.nn.sigmoid(y @ glu_w.astype(jnp.float32) + glu_b.astype(jnp.float32))).astype(dtype)

    yl = readout(xl_dirs[0] + xl_dirs[1], ul, zl.dtype)
    yc = readout(xc_dirs[0] + xc_dirs[1], uc, zc.dtype) if need_ctx else None
    return yl, yc


def setup_inputs(seed: int = 0) -> dict:
    key = jax.random.key(seed)
    ks = iter(jax.random.split(key, 48))
    f32 = jnp.float32
    nrm = lambda shape, scale: jax.random.normal(next(ks), shape, f32) * scale
    L, D = DEPTH, D_MODEL
    x = nrm((BATCH, SEQ, D), 1.0)
    c = nrm((BATCH, D), 1.0)
    ctx = nrm((BATCH, CTX_LEN, D), 1.0)
    c_ctx = nrm((D,), 1.0)
    w_mod = nrm((L, D, 6 * D), 0.5 * D ** -0.5)
    b_mod = nrm((L, 6 * D), 0.02)
    w_in = nrm((L, D, P_IN), D ** -0.5)
    ig_b = nrm((L, 2, 1, MLSTM_HEADS), 0.1)
    fg_b = jnp.linspace(3.0, 6.0, MLSTM_HEADS, dtype=f32) + nrm((L, 2, 1, MLSTM_HEADS), 0.1)
    mlstm_gate_bias = jnp.concatenate([ig_b, fg_b], axis=2).reshape(L, 4 * MLSTM_HEADS)
    mlstm_norm_w = 1.0 + nrm((L, W_A), 0.02)
    sgu_ln_w = 1.0 + nrm((L, W_B), 0.02)
    sgu_ln_b = nrm((L, W_B), 0.02)
    sgu_w = nrm((L, SGU_GROUPS, SGU_CHUNK, SGU_CHUNK), SGU_CHUNK ** -0.5)
    sgu_b = 1.0 + nrm((L, SGU_GROUPS, SGU_CHUNK), 0.02)
    conv_w = nrm((L, CONV_WIDTH, W_C), CONV_WIDTH ** -0.5)
    conv_b = nrm((L, W_C), 0.02)
    conv_ln_w = 1.0 + nrm((L, W_C), 0.02)
    conv_ln_b = nrm((L, W_C), 0.02)
    s5_a_re = -0.5 + nrm((L, 2, S5_GROUPS, S5_N), 0.01)
    s5_a_im = math.pi * jnp.arange(S5_N, dtype=f32) + nrm((L, 2, S5_GROUPS, S5_N), 0.01)
    s5_log_dt = jax.random.uniform(next(ks), (L, 2, S5_GROUPS), f32, math.log(1e-3), math.log(1e-1))
    s5_b_re = nrm((L, S5_GROUPS, S5_N, S5_P), (2 * S5_P) ** -0.5)
    s5_b_im = nrm((L, S5_GROUPS, S5_N, S5_P), (2 * S5_P) ** -0.5)
    s5_c_re = nrm((L, S5_GROUPS, S5_P, S5_N), (2 * S5_N) ** -0.5)
    s5_c_im = nrm((L, S5_GROUPS, S5_P, S5_N), (2 * S5_N) ** -0.5)
    s5_d = nrm((L, W_D), 1.0)
    s5_glu_w = nrm((L, W_D, W_D), W_D ** -0.5)
    s5_glu_b = nrm((L, W_D), 0.02)
    w_out = nrm((L, D_MIX, D), BETA * D_MIX ** -0.5)
    ln1_w = 1.0 + nrm((L, D), 0.02)
    ln1_b = nrm((L, D), 0.02)
    w_ffn_in = nrm((L, D, 2 * D_FF), D ** -0.5)
    w_ffn_out = nrm((L, D_FF, D), BETA * D_FF ** -0.5)
    ln2_w = 1.0 + nrm((L, D), 0.02)
    ln2_b = nrm((L, D), 0.02)
    return {'x': x, 'c': c, 'ctx': ctx, 'c_ctx': c_ctx, 'w_mod': w_mod, 'b_mod': b_mod, 'w_in': w_in,
            'mlstm_gate_bias': mlstm_gate_bias, 'mlstm_norm_w': mlstm_norm_w,
            'sgu_ln_w': sgu_ln_w, 'sgu_ln_b': sgu_ln_b, 'sgu_w': sgu_w, 'sgu_b': sgu_b,
            'conv_w': conv_w, 'conv_b': conv_b, 'conv_ln_w': conv_ln_w, 'conv_ln_b': conv_ln_b,
            's5_a_re': s5_a_re, 's5_a_im': s5_a_im, 's5_log_dt': s5_log_dt, 's5_b_re': s5_b_re,
            's5_b_im': s5_b_im, 's5_c_re': s5_c_re, 's5_c_im': s5_c_im, 's5_d': s5_d,
            's5_glu_w': s5_glu_w, 's5_glu_b': s5_glu_b, 'w_out': w_out, 'ln1_w': ln1_w, 'ln1_b': ln1_b,
            'w_ffn_in': w_ffn_in, 'w_ffn_out': w_ffn_out, 'ln2_w': ln2_w, 'ln2_b': ln2_b}


def reference(x, c, ctx, c_ctx, w_mod, b_mod, w_in, mlstm_gate_bias, mlstm_norm_w,
              sgu_ln_w, sgu_ln_b, sgu_w, sgu_b, conv_w, conv_b, conv_ln_w, conv_ln_b,
              s5_a_re, s5_a_im, s5_log_dt, s5_b_re, s5_b_im, s5_c_re, s5_c_im, s5_d,
              s5_glu_w, s5_glu_b, w_out, ln1_w, ln1_b, w_ffn_in, w_ffn_out, ln2_w, ln2_b):
    rows = x.shape[1] // GRID_W
    xc = ctx
    for l in range(DEPTH):
        need_ctx = l < DEPTH - 1
        w_in_l = w_in[l]
        mod = jax.nn.silu(c) @ w_mod[l] + b_mod[l]
        mod_c = jax.nn.silu(c_ctx) @ w_mod[l] + b_mod[l]
        sh1, sc1, g1, sh2, sc2, g2 = jnp.split(mod[:, None, :], 6, axis=-1)
        sh1c, sc1c, g1c, sh2c, sc2c, g2c = jnp.split(mod_c, 6, axis=-1)
        h = x * (1.0 + sc1) + sh1
        hc = xc * (1.0 + sc1c) + sh1c
        z = h @ w_in_l
        zc_a = hc @ w_in_l[:, :OFF_B]
        zc_d = hc @ w_in_l[:, OFF_D:]
        y_a, yc_a = mlstm_mixer(z[..., :OFF_B], zc_a, mlstm_gate_bias[l], mlstm_norm_w[l], need_ctx)
        y_b = sgu_mixer(z[..., OFF_B:OFF_C], sgu_ln_w[l], sgu_ln_b[l], sgu_w[l], sgu_b[l])
        y_c = conv_mixer(z[..., OFF_C:OFF_D], conv_w[l], conv_b[l], conv_ln_w[l], conv_ln_b[l], rows)
        y_d, yc_d = s5_mixer(z[..., OFF_D:], zc_d, s5_a_re[l], s5_a_im[l], s5_log_dt[l], s5_b_re[l], s5_b_im[l],
                             s5_c_re[l], s5_c_im[l], s5_d[l], s5_glu_w[l], s5_glu_b[l], need_ctx)
        y = jnp.concatenate([y_a, y_b, y_c, y_d], axis=-1) @ w_out[l]
        x = layer_norm(ALPHA * x + g1 * y, ln1_w[l], ln1_b[l])
        x = layer_norm(ALPHA * x + g2 * swiglu(x * (1.0 + sc2) + sh2, w_ffn_in[l], w_ffn_out[l]), ln2_w[l], ln2_b[l])
        if need_ctx:
            yc_b = sgu_mixer(hc @ w_in_l[:, OFF_B:OFF_C], sgu_ln_w[l], sgu_ln_b[l], sgu_w[l], sgu_b[l])
            yc_c = conv_mixer(hc @ w_in_l[:, OFF_C:OFF_D], conv_w[l], conv_b[l], conv_ln_w[l], conv_ln_b[l], 1)
            yc = jnp.concatenate([yc_a, yc_b, yc_c, yc_d], axis=-1) @ w_out[l]
            xc = layer_norm(ALPHA * xc + g1c * yc, ln1_w[l], ln1_b[l])
            xc = layer_norm(ALPHA * xc + g2c * swiglu(xc * (1.0 + sc2c) + sh2c, w_ffn_in[l], w_ffn_out[l]),
                            ln2_w[l], ln2_b[l])
    return x
```

```cpp
#include <hip/hip_runtime.h>
#include <hip/hip_cooperative_groups.h>
#include <cstdio>
#include <cstdint>
namespace pg8 {
#define PG8_LAS __attribute__((address_space(3)))
typedef unsigned short bf16_t;
typedef short bf16x8 __attribute__((ext_vector_type(8)));
typedef float f32x4 __attribute__((ext_vector_type(4)));
typedef unsigned u32x4 __attribute__((ext_vector_type(4)));
constexpr int BM = 256, BK = 64, HALF = 128, HTB = HALF * BK * 2  , STAGE_BYTES = 8 * HTB, NXCD = 8, WGM = 8;

__host__ __device__ __forceinline__ int lds_byte(int r, int c) { const int st = (r >> 4) * 2 + (c >> 5), rr = r & 15, cc = c & 31, ob = rr * 64 + cc * 2; return st * 1024 + (ob ^ (((ob >> 9) & 1) << 5)); }
__host__ __device__ __forceinline__ void stage_rc(int b, int& R, int& C) { const int st = b / 1024, sb = b % 1024, swz = sb ^ (((sb >> 9) & 1) << 5); R = (st >> 1) * 16 + swz / 64; C = (st & 1) * 32 + (swz % 64) / 2; }
__host__ __device__ __forceinline__ int perm32(int rho) { const int n = rho >> 4, i = rho & 15; return 8 * (i >> 2) + 4 * n + (i & 3); }

struct Unit { int pm, pn; };
struct Gemm { const bf16_t* A; const bf16_t* Bt; int M, N, K, lda, ldb, bgrp; size_t bgrp_stride; };

struct StaticOrder {
    int nM, nN, nwg, G, c;
    __host__ __device__ void init(int M, int N, int G_, int c_) { nM = M / BM; nN = N / BM; nwg = nM * nN; G = G_; c = c_; }
    __host__ __device__ bool next(int i, Unit& u) const {
        const long L = (long)i * G + c; if (L >= nwg) return false;
        int wgid = (int)L; { const int q = nwg / NXCD, r = nwg % NXCD, xcd = wgid % NXCD, off = wgid / NXCD; wgid = (xcd < r ? xcd * (q + 1) : r * (q + 1) + (xcd - r) * q) + off; }
        const int nig = WGM * nN, gid = wgid / nig, fm = gid * WGM, gsz = (nM - fm) < WGM ? (nM - fm) : WGM;
        u.pm = fm + ((wgid % nig) % gsz); u.pn = (wgid % nig) / gsz; return true;
    }
    __device__ __forceinline__ void a_ready(const Unit&) const {}
    __device__ __forceinline__ void done(const Unit&) const {}
};

__device__ __forceinline__ unsigned cvt_pk_bf16(float lo, float hi) { unsigned r; asm volatile("v_cvt_pk_bf16_f32 %0, %1, %2" : "=v"(r) : "v"(lo), "v"(hi)); return r; }
__device__ __forceinline__ float bflo(unsigned w) { return __uint_as_float(w << 16); }
__device__ __forceinline__ float bfhi(unsigned w) { return __uint_as_float(w & 0xffff0000u); }
__device__ __forceinline__ float sigm(float x) { return __builtin_amdgcn_rcpf(1.0f + __expf(-x)); }
__device__ __forceinline__ float gelu_t(float x) { const float u = 1.5957691216f * (x + 0.044715f * x * x * x); return x * sigm(u); }
__device__ __forceinline__ u32x4 pack8(const f32x4 a, const f32x4 b) { u32x4 w; w.x = cvt_pk_bf16(a[0], a[1]); w.y = cvt_pk_bf16(a[2], a[3]); w.z = cvt_pk_bf16(b[0], b[1]); w.w = cvt_pk_bf16(b[2], b[3]); return w; }

constexpr int NLAT = 32768, NROWS = 36864, ZLD = 2048, NCH_S5 = 2304;

struct EpiInProj {
    static constexpr bool PERM = true, AFTER_DRAIN = false;
    bf16_t* Z; bf16_t* UH;
    __device__ __forceinline__ void operator()(const f32x4 (&acc)[2][2][4][2], const Unit& u, int wr, int wc, int fr, int fq) const {
#pragma unroll
        for (int ai = 0; ai < 2; ++ai)
#pragma unroll
            for (int m = 0; m < 4; ++m) { const int row = u.pm * BM + ai * HALF + wr * 64 + m * 16 + fr;
#pragma unroll
                for (int bj = 0; bj < 2; ++bj) { const u32x4 w = pack8(acc[ai][bj][m][0], acc[ai][bj][m][1]); const int cc = bj * HALF + wc * 32 + 8 * fq;
                    if (u.pn < 8) *(u32x4*)(Z + (size_t)row * ZLD + u.pn * BM + cc) = w;
                    else { const int g = cc >> 4, q0 = cc & 15; *(u32x4*)(UH + ((size_t)(g * NCH_S5 + (row >> 4)) * 512 + (row & 15) * 16 + q0)) = w; } } }
    }
};
struct EpiResGate {
    static constexpr bool PERM = false, AFTER_DRAIN = false;
    const float* srcL; const float* srcC; float* dstL; float* dstC; const float* gate; float alpha;
    __device__ __forceinline__ void operator()(const f32x4 (&acc)[2][2][4][2], const Unit& u, int wr, int wc, int fr, int fq) const {
        const int row0 = u.pm * BM; const bool lat = row0 < NLAT; const int mi = lat ? (row0 >> 11) : 16;
        const float* src = lat ? srcL + (size_t)row0 * 1024 : srcC + (size_t)(row0 - NLAT) * 1024; float* dst = lat ? dstL + (size_t)row0 * 1024 : dstC + (size_t)(row0 - NLAT) * 1024;
        const float* gp = gate + (size_t)mi * 6144;
#pragma unroll
        for (int bj = 0; bj < 2; ++bj)
#pragma unroll
            for (int n = 0; n < 2; ++n) { const int col = u.pn * BM + bj * HALF + wc * 32 + n * 16 + 4 * fq; const f32x4 gv = *(const f32x4*)(gp + col);
#pragma unroll
                for (int ai = 0; ai < 2; ++ai)
#pragma unroll
                    for (int m = 0; m < 4; ++m) { const size_t off = (size_t)(ai * HALF + wr * 64 + m * 16 + fr) * 1024 + col; const f32x4 x = *(const f32x4*)(src + off); *(f32x4*)(dst + off) = x * alpha + gv * acc[ai][bj][m][n]; } }
    }
};
struct EpiSwiGlu {
    static constexpr bool PERM = true, AFTER_DRAIN = false;
    bf16_t* ACT; int ldc;
    __device__ __forceinline__ void operator()(const f32x4 (&acc)[2][2][4][2], const Unit& u, int wr, int wc, int fr, int fq) const {
#pragma unroll
        for (int ai = 0; ai < 2; ++ai)
#pragma unroll
            for (int m = 0; m < 4; ++m) { const int row = u.pm * BM + ai * HALF + wr * 64 + m * 16 + fr; f32x4 o[2];
#pragma unroll
                for (int n = 0; n < 2; ++n)
#pragma unroll
                    for (int e = 0; e < 4; ++e) { const float g = acc[ai][0][m][n][e]; o[n][e] = g * sigm(g) * acc[ai][1][m][n][e]; }
                *(u32x4*)(ACT + (size_t)row * ldc + u.pn * HALF + wc * 32 + 8 * fq) = pack8(o[0], o[1]); }
    }
};
struct EpiF32 {
    static constexpr bool PERM = false, AFTER_DRAIN = false;
    float* O; int ldc;
    __device__ __forceinline__ void operator()(const f32x4 (&acc)[2][2][4][2], const Unit& u, int wr, int wc, int fr, int fq) const {
#pragma unroll
        for (int ai = 0; ai < 2; ++ai)
#pragma unroll
            for (int m = 0; m < 4; ++m) { const size_t ro = (size_t)(u.pm * BM + ai * HALF + wr * 64 + m * 16 + fr) * ldc;
#pragma unroll
                for (int bj = 0; bj < 2; ++bj)
#pragma unroll
                    for (int n = 0; n < 2; ++n) *(f32x4*)(O + ro + u.pn * BM + bj * HALF + wc * 32 + n * 16 + 4 * fq) = acc[ai][bj][m][n]; }
    }
};
struct EpiS5Y {
    static constexpr bool PERM = true, AFTER_DRAIN = false;
    const bf16_t* UH; const float* dsk; bf16_t* YS5;
    __device__ __forceinline__ void operator()(const f32x4 (&acc)[2][2][4][2], const Unit& u, int wr, int wc, int fr, int fq) const {
        const int g = (u.pm * BM) / NCH_S5;
#pragma unroll
        for (int bj = 0; bj < 2; ++bj) { const int col = bj * HALF + wc * 32 + 8 * fq, t = col >> 4, p0 = col & 15;
            const f32x4 d0 = *(const f32x4*)(dsk + g * 16 + p0), d1 = *(const f32x4*)(dsk + g * 16 + p0 + 4);
#pragma unroll
            for (int ai = 0; ai < 2; ++ai)
#pragma unroll
                for (int m = 0; m < 4; ++m) { const int row = u.pm * BM + ai * HALF + wr * 64 + m * 16 + fr, chunk = row - g * NCH_S5;
                    const u32x4 uw = *(const u32x4*)(UH + (size_t)row * 512 + col); f32x4 a = acc[ai][bj][m][0], b = acc[ai][bj][m][1];
                    a[0] += d0[0] * bflo(uw.x); a[1] += d0[1] * bfhi(uw.x); a[2] += d0[2] * bflo(uw.y); a[3] += d0[3] * bfhi(uw.y);
                    b[0] += d1[0] * bflo(uw.z); b[1] += d1[1] * bfhi(uw.z); b[2] += d1[2] * bflo(uw.w); b[3] += d1[3] * bfhi(uw.w);
#pragma unroll
                    for (int e = 0; e < 4; ++e) { a[e] = gelu_t(a[e]); b[e] = gelu_t(b[e]); }
                    *(u32x4*)(YS5 + (size_t)(chunk * 16 + t) * 256 + g * 16 + p0) = pack8(a, b); } }
    }
};
struct EpiGlu {
    static constexpr bool PERM = true, AFTER_DRAIN = false;
    const bf16_t* YS5; const float* gb; bf16_t* Y;
    __device__ __forceinline__ void operator()(const f32x4 (&acc)[2][2][4][2], const Unit& u, int wr, int wc, int fr, int fq) const {
#pragma unroll
        for (int bj = 0; bj < 2; ++bj) { const int col = bj * HALF + wc * 32 + 8 * fq; const f32x4 b0 = *(const f32x4*)(gb + col), b1 = *(const f32x4*)(gb + col + 4);
#pragma unroll
            for (int ai = 0; ai < 2; ++ai)
#pragma unroll
                for (int m = 0; m < 4; ++m) { const int row = u.pm * BM + ai * HALF + wr * 64 + m * 16 + fr; const u32x4 yw = *(const u32x4*)(YS5 + (size_t)row * 256 + col);
                    f32x4 a = acc[ai][bj][m][0] + b0, b = acc[ai][bj][m][1] + b1;
                    a[0] = bflo(yw.x) * sigm(a[0]); a[1] = bfhi(yw.x) * sigm(a[1]); a[2] = bflo(yw.y) * sigm(a[2]); a[3] = bfhi(yw.y) * sigm(a[3]);
                    b[0] = bflo(yw.z) * sigm(b[0]); b[1] = bfhi(yw.z) * sigm(b[1]); b[2] = bflo(yw.w) * sigm(b[2]); b[3] = bfhi(yw.w) * sigm(b[3]);
                    *(u32x4*)(Y + (size_t)row * 1024 + 768 + col) = pack8(a, b); } }
    }
};

template <class Epi, class Sched, bool ALIGN_EPI = false, bool SP2 = false>
__device__ __forceinline__ void gemm_phase(PG8_LAS unsigned char* lds, const Gemm g, const Sched& S, const Epi& E) {
    const int tid = threadIdx.x, wid = __builtin_amdgcn_readfirstlane(tid >> 6), lane = tid & 63, wr = wid >> 2, wc = wid & 3, fr = lane & 15, fq = lane >> 4;
    const int K = g.K, nt = K / BK;
    unsigned voffA[2], voffB[2];
#pragma unroll
    for (int i = 0; i < 2; ++i) { int R, C; stage_rc(tid * 16 + i * 8192, R, C); const int Rb = Epi::PERM ? ((R & ~31) + perm32(R & 31)) : R;
        voffA[i] = (unsigned)(R * g.lda + C) * 2u; voffB[i] = (unsigned)(Rb * g.ldb + C) * 2u; }
    const size_t kstep = (size_t)(BK * 2);
    const size_t hstepA = (size_t)HALF * g.lda * 2, hstepB = (size_t)HALF * g.ldb * 2;
    const size_t tstepA = 2 * hstepA, tstepB = 2 * hstepB;
#define PG8_ABASE(u) ((const char*)g.A + (size_t)(u).pm * tstepA)
#define PG8_BBASE(u) ((const char*)g.Bt + (size_t)(u).pn * tstepB + (g.bgrp ? (size_t)((u).pm / g.bgrp) * g.bgrp_stride : (size_t)0))
    const unsigned ldsw = (unsigned)wid * 1024u;
    const int aoff = lds_byte(wr * 64 + fr, fq * 8), boff = lds_byte(wc * 32 + fr, fq * 8);
#define PG8_SA(b, h) (((b) * 2 + (h)) * HTB)
#define PG8_SB(b, h) ((4 + (b) * 2 + (h)) * HTB)
#define PG8_STAGE(bufoff, gbase, voff) do { _Pragma("unroll") for (int _i = 0; _i < 2; ++_i) \
        __builtin_amdgcn_global_load_lds((const unsigned*)((const char*)(gbase) + (voff)[_i]), (PG8_LAS unsigned*)(lds + (bufoff) + ldsw + _i * 8192), 16, 0, 0); } while (0)
#define PG8_LDA(dst, b, h) do { _Pragma("unroll") for (int m = 0; m < 4; ++m) _Pragma("unroll") for (int k = 0; k < 2; ++k) dst[m][k] = *(const PG8_LAS bf16x8*)(lds + PG8_SA(b, h) + aoff + m * 2048 + k * 1024); } while (0)
#define PG8_LDB(dst, b, h) do { _Pragma("unroll") for (int n = 0; n < 2; ++n) _Pragma("unroll") for (int k = 0; k < 2; ++k) dst[n][k] = *(const PG8_LAS bf16x8*)(lds + PG8_SB(b, h) + boff + n * 2048 + k * 1024); } while (0)
#define PG8_MMA(ai, bj, At, Bt) do { __builtin_amdgcn_s_setprio(1); _Pragma("unroll") for (int m = 0; m < 4; ++m) _Pragma("unroll") for (int n = 0; n < 2; ++n) _Pragma("unroll") for (int k = 0; k < 2; ++k) \
        acc[ai][bj][m][n] = __builtin_amdgcn_mfma_f32_16x16x32_bf16(Bt[n][k], At[m][k], acc[ai][bj][m][n], 0, 0, 0); __builtin_amdgcn_s_setprio(0); } while (0)
#define PG8_WAIT_V(n) asm volatile("s_waitcnt vmcnt(" #n ")" ::: "memory")
#define PG8_WAIT_L(n) asm volatile("s_waitcnt lgkmcnt(" #n ")" ::: "memory")
#define PG8_BAR __builtin_amdgcn_s_barrier()
#define PG8_SCHED __builtin_amdgcn_sched_barrier(0)
    Unit cur, nxt; int ui = 0;
    if (!S.next(0, cur)) return;
    f32x4 acc[2][2][4][2];
#pragma unroll
    for (int a = 0; a < 2; ++a)
#pragma unroll
        for (int b = 0; b < 2; ++b)
#pragma unroll
            for (int m = 0; m < 4; ++m)
#pragma unroll
                for (int n = 0; n < 2; ++n) acc[a][b][m][n] = (f32x4){0.f, 0.f, 0.f, 0.f};
    bf16x8 At[4][2], B0[2][2], B1[2][2];
    const char* cA = PG8_ABASE(cur); const char* cB = PG8_BBASE(cur);
    S.a_ready(cur);
    if constexpr (SP2) {
        PG8_STAGE(PG8_SB(0, 0), cB, voffB); PG8_STAGE(PG8_SB(0, 1), cB + hstepB, voffB); PG8_STAGE(PG8_SA(0, 0), cA, voffA); PG8_STAGE(PG8_SA(0, 1), cA + hstepA, voffA);
        if (wr == 1) PG8_BAR;
        PG8_WAIT_V(2); PG8_BAR;
        PG8_STAGE(PG8_SB(1, 0), cB + kstep, voffB); PG8_STAGE(PG8_SA(1, 0), cA + kstep, voffA); PG8_STAGE(PG8_SB(1, 1), cB + hstepB + kstep, voffB);
        PG8_WAIT_V(6); PG8_BAR;
    } else {
        PG8_STAGE(PG8_SB(0, 0), cB, voffB); PG8_STAGE(PG8_SA(0, 0), cA, voffA); PG8_STAGE(PG8_SB(0, 1), cB + hstepB, voffB); PG8_STAGE(PG8_SA(0, 1), cA + hstepA, voffA);
        if (wr == 1) PG8_BAR;
        PG8_WAIT_V(4); PG8_BAR;
        PG8_STAGE(PG8_SB(1, 0), cB + kstep, voffB); PG8_STAGE(PG8_SA(1, 0), cA + kstep, voffA); PG8_STAGE(PG8_SB(1, 1), cB + hstepB + kstep, voffB);
        PG8_WAIT_V(6); PG8_BAR;
    }
    for (;;) {
        const bool has_next = S.next(ui + 1, nxt);
        const char* nA = has_next ? PG8_ABASE(nxt) : cA; const char* nB = has_next ? PG8_BBASE(nxt) : cB;
        for (int t = 0; t < nt; t += 2) {
            const bool last = (t == nt - 2);
            const char* a1 = cA + (size_t)(t + 1) * kstep;
            const char* a2 = last ? nA : cA + (size_t)(t + 2) * kstep; const char* b2 = last ? nB : cB + (size_t)(t + 2) * kstep;
            const char* a3 = a2 + kstep; const char* b3 = b2 + kstep;
            if (last && has_next) S.a_ready(nxt);
            if constexpr (SP2) {
            PG8_LDB(B0, 0, 0); PG8_LDB(B1, 0, 1); PG8_SCHED; PG8_LDA(At, 0, 0); PG8_STAGE(PG8_SA(1, 1), a1 + hstepA, voffA);
            PG8_WAIT_V(8); PG8_WAIT_L(0); PG8_BAR; PG8_MMA(0, 0, At, B0); PG8_MMA(0, 1, At, B1); PG8_BAR; PG8_SCHED;
            PG8_LDA(At, 0, 1); PG8_STAGE(PG8_SB(0, 0), b2, voffB); PG8_STAGE(PG8_SB(0, 1), b2 + hstepB, voffB); PG8_STAGE(PG8_SA(0, 0), a2, voffA);
            PG8_WAIT_V(8); PG8_WAIT_L(0); PG8_BAR; PG8_MMA(1, 0, At, B0); PG8_MMA(1, 1, At, B1); PG8_BAR; PG8_SCHED;
            PG8_LDB(B0, 1, 0); PG8_LDB(B1, 1, 1); PG8_SCHED; PG8_LDA(At, 1, 0); PG8_STAGE(PG8_SA(0, 1), a2 + hstepA, voffA);
            PG8_WAIT_V(8); PG8_WAIT_L(0); PG8_BAR; PG8_MMA(0, 0, At, B0); PG8_MMA(0, 1, At, B1); PG8_BAR; PG8_SCHED;
            PG8_LDA(At, 1, 1); PG8_STAGE(PG8_SB(1, 0), b3, voffB); PG8_STAGE(PG8_SB(1, 1), b3 + hstepB, voffB); PG8_STAGE(PG8_SA(1, 0), a3, voffA);
            PG8_WAIT_V(8); PG8_WAIT_L(0); PG8_BAR; PG8_MMA(1, 0, At, B0); PG8_MMA(1, 1, At, B1); PG8_BAR; PG8_SCHED;
            } else {
            PG8_LDB(B0, 0, 0); PG8_SCHED; PG8_LDA(At, 0, 0); PG8_STAGE(PG8_SA(1, 1), a1 + hstepA, voffA);
            PG8_WAIT_L(8); PG8_BAR; PG8_WAIT_L(0); PG8_MMA(0, 0, At, B0); PG8_BAR; PG8_SCHED;
            PG8_LDB(B1, 0, 1); PG8_STAGE(PG8_SB(0, 0), b2, voffB);
            PG8_BAR; PG8_WAIT_L(0); PG8_MMA(0, 1, At, B1); PG8_BAR;
            PG8_LDA(At, 0, 1); PG8_STAGE(PG8_SA(0, 0), a2, voffA);
            PG8_BAR; PG8_WAIT_L(0); PG8_MMA(1, 0, At, B0); PG8_BAR; PG8_SCHED;
            PG8_STAGE(PG8_SB(0, 1), b2 + hstepB, voffB);
            PG8_WAIT_V(6); PG8_BAR; PG8_MMA(1, 1, At, B1); PG8_BAR;
            PG8_LDB(B0, 1, 0); PG8_SCHED; PG8_LDA(At, 1, 0); PG8_STAGE(PG8_SA(0, 1), a2 + hstepA, voffA);
            PG8_WAIT_L(8); PG8_BAR; PG8_WAIT_L(0); PG8_MMA(0, 0, At, B0); PG8_BAR; PG8_SCHED;
            PG8_LDB(B1, 1, 1); PG8_STAGE(PG8_SB(1, 0), b3, voffB);
            PG8_BAR; PG8_WAIT_L(0); PG8_MMA(0, 1, At, B1); PG8_BAR;
            PG8_LDA(At, 1, 1); PG8_STAGE(PG8_SA(1, 0), a3, voffA);
            PG8_BAR; PG8_WAIT_L(0); PG8_MMA(1, 0, At, B0); PG8_BAR; PG8_SCHED;
            PG8_STAGE(PG8_SB(1, 1), b3 + hstepB, voffB);
            PG8_WAIT_V(6); PG8_BAR; PG8_MMA(1, 1, At, B1); PG8_BAR;
            }
        }
        if constexpr (ALIGN_EPI) { if (wr == 0) PG8_BAR; }
        if constexpr (!Epi::AFTER_DRAIN) { E(acc, cur, wr, wc, fr, fq); S.done(cur); }
        if (!has_next) break;
#pragma unroll
        for (int a = 0; a < 2; ++a)
#pragma unroll
            for (int b = 0; b < 2; ++b)
#pragma unroll
                for (int m = 0; m < 4; ++m)
#pragma unroll
                    for (int n = 0; n < 2; ++n) acc[a][b][m][n] = (f32x4){0.f, 0.f, 0.f, 0.f};
        cur = nxt; cA = nA; cB = nB; ++ui;
        if constexpr (ALIGN_EPI) { if (wr == 1) PG8_BAR; }
    }
    PG8_WAIT_V(0);
    if constexpr (!ALIGN_EPI) { if (wr == 0) PG8_BAR; }
    PG8_BAR;
    if constexpr (Epi::AFTER_DRAIN) { E.fused(acc, cur, wr, wc, fr, fq, lds, wid, lane); S.done(cur); }
#undef PG8_ABASE
#undef PG8_BBASE
#undef PG8_SA
#undef PG8_SB
#undef PG8_STAGE
#undef PG8_LDA
#undef PG8_LDB
#undef PG8_MMA
#undef PG8_WAIT_V
#undef PG8_WAIT_L
#undef PG8_BAR
#undef PG8_SCHED
}
}

#ifndef MK_ONE_LAUNCH
#define MK_ONE_LAUNCH 1
#endif
namespace mk {
using namespace pg8;
#define LAS __attribute__((address_space(3)))
constexpr int D = 1024, NB = 16, SEQ = 2048, CTXL = 256, DFF = 2816, PIN = 2320, NPH = 20;
constexpr float ALPHA = 1.41421356237309515f, LN_EPS = 1e-5f;
constexpr size_t MiB = 1u << 20;
constexpr size_t WS_CTL = 0, WS_MOD = 1 * MiB, WS_WT = 2 * MiB, WT_LAYER = 30 * MiB;
constexpr size_t WT_IN = 0, WT_OUT = 9 * MiB / 2, WT_FFIN = 13 * MiB / 2, WT_FFOUT = 35 * MiB / 2, WT_GLU = 23 * MiB, WT_BTY = 93 * MiB / 4, WT_BTS = 109 * MiB / 4;
constexpr size_t WS_GATES = 62 * MiB, WS_XC = 65 * MiB, WS_HY = 81 * MiB, WS_Z = 153 * MiB, WS_ACT = 153 * MiB, WS_UH = 297 * MiB, WS_MST = 333 * MiB, WS_YS5 = 369 * MiB,
                 WS_S5S = 387 * MiB, WS_MISC = 423 * MiB, WS_HSUM = 427 * MiB, WS_Y32 = 463 * MiB, WS_END = 499 * MiB;
constexpr int LDS_BYTES = 147456;

struct Args { const float* in[34]; float* out; unsigned char* ws; int ph_lo, ph_hi; };
enum { I_X = 0, I_C, I_CTX, I_CCTX, I_WMOD, I_BMOD, I_WIN, I_GBIAS, I_MNORM, I_SLNW, I_SLNB, I_SW, I_SB, I_CW, I_CB, I_CLNW, I_CLNB, I_ARE, I_AIM, I_LDT, I_BRE, I_BIM, I_CRE, I_CIM, I_DSK, I_GLUW, I_GLUB,
       I_WOUT, I_LN1W, I_LN1B, I_WFFIN, I_WFFOUT, I_LN2W, I_LN2B };

struct Ctx { LAS unsigned char* lds; int tid, lane, wave, bid, G; const float* const* in; float* out; unsigned char* ws; };

__device__ __forceinline__ float bf2f(bf16_t h) { return __uint_as_float((unsigned)h << 16); }
__device__ __forceinline__ unsigned f2bf(float f) { unsigned u = __float_as_uint(f); return (u + 0x7fffu + ((u >> 16) & 1u)) >> 16; }
__device__ __forceinline__ unsigned pk2(float lo, float hi) { return f2bf(lo) | (f2bf(hi) << 16); }
__device__ __forceinline__ float wave_sum(float v) {
#pragma unroll
    for (int o = 1; o < 64; o <<= 1) v += __shfl_xor(v, o);
    return v;
}
__device__ __forceinline__ float logsig(float x) { return fminf(x, 0.f) - log1pf(expf(-fabsf(x))); }
__device__ __forceinline__ int chain_row(int b, int dir, int j) {
    if (j < CTXL) { const int t = dir ? CTXL - 1 - j : j; return NLAT + b * CTXL + t; }
    int t = j - CTXL; t = dir ? SEQ - 1 - t : t; return b * SEQ + t;
}
#define LDS_WAIT() asm volatile("s_waitcnt lgkmcnt(0)" ::: "memory")

__device__ __forceinline__ void transpose_item(const float* W, int ldw, int col0, bf16_t* WT, int K, int drow0, int k0, LAS float* scr, int lane) {
#pragma unroll 8
    for (int i = 0; i < 32; ++i) { const int kk = 2 * i + (lane >> 5); scr[kk * 33 + (lane & 31)] = W[(size_t)(k0 + kk) * ldw + col0 + (lane & 31)]; }
    LDS_WAIT(); asm volatile("" ::: "memory");
    const int c = lane & 7;
#pragma unroll
    for (int j = 0; j < 4; ++j) { const int n = (lane >> 3) + 8 * j; const LAS float* s = scr + (8 * c) * 33 + n;
        u32x4 o; o.x = pk2(s[0 * 33], s[1 * 33]); o.y = pk2(s[2 * 33], s[3 * 33]); o.z = pk2(s[4 * 33], s[5 * 33]); o.w = pk2(s[6 * 33], s[7 * 33]);
        *(u32x4*)(WT + (size_t)(drow0 + n) * K + k0 + 8 * c) = o; }
    LDS_WAIT(); asm volatile("" ::: "memory");
}
__device__ __forceinline__ void p_prologue(const Ctx& C) {
    LAS float* scr = (LAS float*)(C.lds + C.wave * 8448);
    const int gw = C.bid * 8 + C.wave, NGW = C.G * 8;
    constexpr int N_IN = 16 * 72, N_OUT = 16 * 32, N_FI = 16 * 176, N_FO = 44 * 32, N_GL = 4 * 8, N_L = N_IN + N_OUT + N_FI + N_FO + N_GL;
    for (int it = gw; it < 2 * N_L; it += NGW) {
        const int l = it / N_L; int r = it % N_L; unsigned char* wt = C.ws + WS_WT + (size_t)l * WT_LAYER;
        if (r < N_IN) { const int kb = r / 72, nb = r % 72; transpose_item(C.in[I_WIN] + (size_t)l * D * PIN, PIN, nb * 32 + (nb >= 32 ? 16 : 0), (bf16_t*)(wt + WT_IN), D, nb * 32, kb * 64, scr, C.lane); continue; } r -= N_IN;
        if (r < N_OUT) { const int kb = r / 32, nb = r % 32; transpose_item(C.in[I_WOUT] + (size_t)l * D * D, D, nb * 32, (bf16_t*)(wt + WT_OUT), D, nb * 32, kb * 64, scr, C.lane); continue; } r -= N_OUT;
        if (r < N_FI) { const int kb = r / 176, nb = r % 176, dr = nb * 32, pn = dr >> 8, bj = (dr >> 7) & 1, jj = dr & 127;
            transpose_item(C.in[I_WFFIN] + (size_t)l * D * 2 * DFF, 2 * DFF, bj * DFF + pn * 128 + jj, (bf16_t*)(wt + WT_FFIN), D, dr, kb * 64, scr, C.lane); continue; } r -= N_FI;
        if (r < N_FO) { const int kb = r / 32, nb = r % 32; transpose_item(C.in[I_WFFOUT] + (size_t)l * DFF * D, D, nb * 32, (bf16_t*)(wt + WT_FFOUT), DFF, nb * 32, kb * 64, scr, C.lane); continue; } r -= N_FO;
        { const int kb = r / 8, nb = r % 8; transpose_item(C.in[I_GLUW] + (size_t)l * 65536, 256, nb * 32, (bf16_t*)(wt + WT_GLU), 256, nb * 32, kb * 64, scr, C.lane); }
    }
    __syncthreads();
    LAS float* sc = (LAS float*)C.lds; LAS float* red = (LAS float*)(C.lds + 69632);
    if (C.bid < 192) {
        for (int idx = C.tid; idx < 17 * 1024; idx += 512) { const int i = idx >> 10, k = idx & 1023; const float v = i < 16 ? C.in[I_C][i * 1024 + k] : C.in[I_CCTX][k]; sc[idx] = v / (1.0f + expf(-v)); }
        __syncthreads();
        float* MOD = (float*)(C.ws + WS_MOD);
        for (int item = C.bid; item < 192; item += C.G) {
            const int l = item / 96, j = (item % 96) * 64 + C.lane; const float* w = C.in[I_WMOD] + (size_t)l * D * 6144 + j;
            float acc[17];
#pragma unroll
            for (int i = 0; i < 17; ++i) acc[i] = 0.f;
            for (int k = C.wave * 128; k < C.wave * 128 + 128; ++k) { const float wv = w[(size_t)k * 6144];
#pragma unroll
                for (int i = 0; i < 17; ++i) acc[i] += sc[i * 1024 + k] * wv; }
#pragma unroll
            for (int i = 0; i < 17; ++i) red[(C.wave * 17 + i) * 64 + C.lane] = acc[i];
            __syncthreads();
            for (int i = C.wave; i < 17; i += 8) { float s = 0.f;
#pragma unroll
                for (int w8 = 0; w8 < 8; ++w8) s += red[(w8 * 17 + i) * 64 + C.lane];
                MOD[(size_t)(l * 17 + i) * 6144 + j] = s + C.in[I_BMOD][l * 6144 + j]; }
            __syncthreads();
        }
    }
}

__device__ __forceinline__ void p_rowpass(const Ctx& C, int mode, int l) {
    const bool doLN = mode != 0, doH = !(mode == 2 && l == 1), doG = (mode == 0) || (mode == 2 && l == 0);
    const int nrows = (mode == 0 || l == 0) ? NROWS : NLAT;
    const int lm = (mode == 2) ? l + 1 : l;
    const float* MOD = (const float*)(C.ws + WS_MOD) + (size_t)(lm < 2 ? lm : 1) * 17 * 6144; const int osh = (mode == 1) ? 3072 : 0, osc = (mode == 1) ? 4096 : 1024;
    const float* lnw = C.in[mode == 1 ? I_LN1W : I_LN2W] + l * D; const float* lnb = C.in[mode == 1 ? I_LN1B : I_LN2B] + l * D;
    LAS float* wgT = (LAS float*)C.lds;
    if (doG) { const float* wg = C.in[I_WIN] + (size_t)lm * D * PIN + 1024;
        for (int idx = C.tid; idx < 16 * 1024; idx += 512) { const int k = idx >> 4, gi = idx & 15; wgT[gi * 1024 + k] = wg[(size_t)k * PIN + gi]; }
        __syncthreads(); }
    bf16_t* H = (bf16_t*)(C.ws + WS_HY); float* XC = (float*)(C.ws + WS_XC); float* GT = (float*)(C.ws + WS_GATES);
    for (int row = C.bid * 8 + C.wave; row < nrows; row += C.G * 8) {
        const bool lat = row < NLAT; const int mi = lat ? (row >> 11) : 16;
        float* xrow = lat ? C.out + (size_t)row * D : XC + (size_t)(row - NLAT) * D;
        const float* src = (mode == 0) ? (lat ? C.in[I_X] + (size_t)row * D : C.in[I_CTX] + (size_t)(row - NLAT) * D) : xrow;
        f32x4 v[4];
#pragma unroll
        for (int j = 0; j < 4; ++j) v[j] = *(const f32x4*)(src + 4 * C.lane + 256 * j);
        if (doLN) {
            float s = 0.f;
#pragma unroll
            for (int j = 0; j < 4; ++j) s += (v[j][0] + v[j][1]) + (v[j][2] + v[j][3]);
            const float mean = wave_sum(s) * (1.0f / D); float q = 0.f;
#pragma unroll
            for (int j = 0; j < 4; ++j) { v[j] = v[j] - mean; q += (v[j][0] * v[j][0] + v[j][1] * v[j][1]) + (v[j][2] * v[j][2] + v[j][3] * v[j][3]); }
            const float rstd = 1.0f / sqrtf(wave_sum(q) * (1.0f / D) + LN_EPS);
#pragma unroll
            for (int j = 0; j < 4; ++j) { const f32x4 w = *(const f32x4*)(lnw + 4 * C.lane + 256 * j), b = *(const f32x4*)(lnb + 4 * C.lane + 256 * j); v[j] = v[j] * rstd * w + b; *(f32x4*)(xrow + 4 * C.lane + 256 * j) = v[j]; }
        }
        if (doH) {
            const float* mp = MOD + (size_t)mi * 6144;
#pragma unroll
            for (int j = 0; j < 4; ++j) { const f32x4 sh = *(const f32x4*)(mp + osh + 4 * C.lane + 256 * j), scv = *(const f32x4*)(mp + osc + 4 * C.lane + 256 * j); v[j] = v[j] * (scv + 1.0f) + sh;
                unsigned long long o = (unsigned long long)pk2(v[j][0], v[j][1]) | ((unsigned long long)pk2(v[j][2], v[j][3]) << 32); *(unsigned long long*)(H + (size_t)row * D + 4 * C.lane + 256 * j) = o; }
            if (doG) {
                float keep = 0.f;
#pragma unroll 1
                for (int gi = 0; gi < 16; ++gi) { float p = 0.f;
#pragma unroll
                    for (int j = 0; j < 4; ++j) { const f32x4 w = *(const LAS f32x4*)(wgT + gi * 1024 + 4 * C.lane + 256 * j); p += (v[j][0] * w[0] + v[j][1] * w[1]) + (v[j][2] * w[2] + v[j][3] * w[3]); }
                    p = wave_sum(p); if (C.lane == gi) keep = p; }
                if (C.lane < 16) GT[(size_t)row * 16 + C.lane] = keep + C.in[I_GBIAS][lm * 16 + C.lane];
            }
        }
    }
}
__device__ __forceinline__ void nv_mlstm_chain(const Ctx& C, int b, int hd, int dir) {
    const bf16_t* Z = (const bf16_t*)(C.ws + WS_Z); const float* GT = (const float*)(C.ws + WS_GATES); float* HS = (float*)(C.ws + WS_HSUM);
    LAS float* qkv = (LAS float*)C.lds; LAS float* red = qkv + 192;
    const int tid = C.tid, vrow = tid >> 3, k0 = (tid & 7) * 8;
    float Cst[8]; for (int e = 0; e < 8; ++e) Cst[e] = 0.f;
    float nk = 0.f, m = 0.f, r0 = 0.f, ig_n, fg_n; int row_n;
#define NV_LOAD(j) do { const int row_ = chain_row(b, dir, (j)); row_n = row_; const bf16_t* zr = Z + (size_t)row_ * ZLD + hd * 64; \
        if (tid < 64) r0 = bf2f(zr[tid]); else if (tid < 128) r0 = bf2f(zr[256 + tid - 64]) * 0.125f; else if (tid < 192) r0 = bf2f(zr[512 + tid - 128]); \
        ig_n = GT[(size_t)row_ * 16 + dir * 8 + hd]; fg_n = GT[(size_t)row_ * 16 + dir * 8 + 4 + hd]; } while (0)
    NV_LOAD(0);
    for (int j = 0; j < CTXL + SEQ; ++j) {
        if (tid < 192) qkv[tid] = r0;
        const float ig = ig_n, lf = logsig(fg_n); const int row = row_n;
        __syncthreads();
        if (j + 1 < CTXL + SEQ) NV_LOAD(j + 1);
        const float mn = fmaxf(lf + m, ig), fdec = expf(lf + m - mn), iw = expf(ig - mn);
        if (tid < 64) { nk = fdec * nk + iw * qkv[64 + tid]; const float d = wave_sum(nk * qkv[tid]); if (tid == 0) red[0] = d; }
        const float vv = qkv[128 + vrow] * iw; float part = 0.f;
#pragma unroll
        for (int e = 0; e < 8; ++e) { Cst[e] = fdec * Cst[e] + vv * qkv[64 + k0 + e]; part += Cst[e] * qkv[k0 + e]; }
        part += __shfl_xor(part, 1); part += __shfl_xor(part, 2); part += __shfl_xor(part, 4);
        __syncthreads();
        const float den = red[0], h = part / fmaxf(fabsf(den), expf(-mn));
        if ((tid & 7) == 0) { float* hp = HS + (size_t)row * 256 + hd * 64 + vrow; if (dir) *hp += h; else *hp = h; }
        m = mn;
    }
#undef NV_LOAD
    __syncthreads();
}
__device__ __forceinline__ void nv_s5_item(const Ctx& C, int l, int b, int gh, int dir) {
    const bf16_t* UH = (const bf16_t*)(C.ws + WS_UH); float* Y32 = (float*)(C.ws + WS_Y32);
    const int g = gh * 8 + C.wave, n = C.lane;
    LAS float* base = (LAS float*)(C.lds + C.wave * 17920);
    LAS float* xr = base; LAS float* xi = base + 16 * 65; LAS float* cre = base + 2 * 16 * 65; LAS float* cim = cre + 1024; LAS float* us = cim + 1024;
    const float are = C.in[I_ARE][((l * 2 + dir) * 16 + g) * 64 + n], aim = C.in[I_AIM][((l * 2 + dir) * 16 + g) * 64 + n], dt = expf(C.in[I_LDT][(l * 2 + dir) * 16 + g]);
    const float mag = expf(are * dt), abr = mag * cosf(aim * dt), abi = mag * sinf(aim * dt), d2 = are * are + aim * aim;
    const float cr = ((abr - 1.f) * are + abi * aim) / d2, ci = (abi * are - (abr - 1.f) * aim) / d2;
    float br[16], bi[16];
#pragma unroll
    for (int q = 0; q < 16; ++q) { const float re = C.in[I_BRE][((size_t)(l * 16 + g) * 64 + n) * 16 + q], im = C.in[I_BIM][((size_t)(l * 16 + g) * 64 + n) * 16 + q]; br[q] = cr * re - ci * im; bi[q] = cr * im + ci * re; }
    for (int p = 0; p < 16; ++p) { cre[n * 16 + p] = C.in[I_CRE][((size_t)(l * 16 + g) * 16 + p) * 64 + n]; cim[n * 16 + p] = C.in[I_CIM][((size_t)(l * 16 + g) * 16 + p) * 64 + n]; }
    float sr = 0.f, si = 0.f;
    const int t_ = n >> 2, p0 = (n & 3) * 4;
    const f32x4 dv = *(const f32x4*)(C.in[I_DSK] + l * 256 + g * 16 + p0);
    for (int j0 = 0; j0 < CTXL + SEQ; j0 += 16) {
        { const int s = n >> 2, q0 = (n & 3) * 4, row = chain_row(b, dir, j0 + s); const bf16_t* up = UH + ((size_t)(g * NCH_S5 + (row >> 4)) * 512 + (row & 15) * 16 + q0);
#pragma unroll
          for (int e = 0; e < 4; ++e) us[s * 16 + q0 + e] = bf2f(up[e]); }
        __syncthreads();
        for (int s = 0; s < 16; ++s) { float bur = 0.f, bui = 0.f;
#pragma unroll
            for (int q = 0; q < 16; ++q) { const float uv = us[s * 16 + q]; bur += br[q] * uv; bui += bi[q] * uv; }
            const float nr = abr * sr - abi * si + bur, ni = abr * si + abi * sr + bui; sr = nr; si = ni; xr[s * 65 + n] = sr; xi[s * 65 + n] = si; }
        __syncthreads();
        f32x4 acc = {0.f, 0.f, 0.f, 0.f};
        for (int nn = 0; nn < 64; ++nn) { const float a = xr[t_ * 65 + nn], bq = xi[t_ * 65 + nn]; const f32x4 c1 = *(const LAS f32x4*)(cre + nn * 16 + p0), c2 = *(const LAS f32x4*)(cim + nn * 16 + p0); acc += c1 * a - c2 * bq; }
        const int row = chain_row(b, dir, j0 + t_); float* yp = Y32 + (size_t)row * 256 + g * 16 + p0;
        if (dir == 0) { f32x4 uu; uu[0] = us[t_ * 16 + p0]; uu[1] = us[t_ * 16 + p0 + 1]; uu[2] = us[t_ * 16 + p0 + 2]; uu[3] = us[t_ * 16 + p0 + 3]; *(f32x4*)yp = acc + dv * uu; }
        else { const f32x4 o = *(const f32x4*)yp; *(f32x4*)yp = o + acc; }
        __syncthreads();
    }
}
__device__ __forceinline__ void nv_glu_item(const Ctx& C, int l, int item) {
    const float* Y32 = (const float*)(C.ws + WS_Y32); bf16_t* Y = (bf16_t*)(C.ws + WS_HY); LAS float* ys = (LAS float*)C.lds;
    const int r0 = item * 32;
    for (int idx = C.tid; idx < 32 * 256; idx += 512) ys[idx] = gelu_t(Y32[(size_t)r0 * 256 + idx]);
    __syncthreads();
    const int c = C.tid & 255, th = C.tid >> 8; const float* w = C.in[I_GLUW] + (size_t)l * 65536 + c;
    float acc[16];
#pragma unroll
    for (int t = 0; t < 16; ++t) acc[t] = 0.f;
    for (int k = 0; k < 256; ++k) { const float wv = w[k * 256];
#pragma unroll
        for (int t = 0; t < 16; ++t) acc[t] += ys[(th * 16 + t) * 256 + k] * wv; }
    const float gb = C.in[I_GLUB][l * 256 + c];
#pragma unroll
    for (int t = 0; t < 16; ++t) { const int rr = th * 16 + t; Y[(size_t)(r0 + rr) * D + 768 + c] = (bf16_t)f2bf(ys[rr * 256 + c] * sigm(acc[t] + gb)); }
    __syncthreads();
}
__device__ __forceinline__ void nv_readout_row(const Ctx& C, int l, int row) {
    const float* HS = (const float*)(C.ws + WS_HSUM); const bf16_t* Z = (const bf16_t*)(C.ws + WS_Z); bf16_t* Y = (bf16_t*)(C.ws + WS_HY);
    const int ch = 4 * C.lane; f32x4 h = *(const f32x4*)(HS + (size_t)row * 256 + ch);
    float s = (h[0] + h[1]) + (h[2] + h[3]); s += __shfl_xor(s, 1); s += __shfl_xor(s, 2); s += __shfl_xor(s, 4); s += __shfl_xor(s, 8);
    const float mu = s * (1.0f / 64.0f); h = h - mu; float q = (h[0] * h[0] + h[1] * h[1]) + (h[2] * h[2] + h[3] * h[3]); q += __shfl_xor(q, 1); q += __shfl_xor(q, 2); q += __shfl_xor(q, 4); q += __shfl_xor(q, 8);
    const float rstd = 1.0f / sqrtf(q * (1.0f / 64.0f) + LN_EPS); const f32x4 nw = *(const f32x4*)(C.in[I_MNORM] + l * 256 + ch);
    const unsigned long long ow = *(const unsigned long long*)(Z + (size_t)row * ZLD + 768 + ch); const unsigned o0 = (unsigned)ow, o1 = (unsigned)(ow >> 32);
    const float y0 = h[0] * rstd * nw[0] * sigm(bflo(o0)), y1 = h[1] * rstd * nw[1] * sigm(bfhi(o0)), y2 = h[2] * rstd * nw[2] * sigm(bflo(o1)), y3 = h[3] * rstd * nw[3] * sigm(bfhi(o1));
    *(unsigned long long*)(Y + (size_t)row * D + ch) = (unsigned long long)pk2(y0, y1) | ((unsigned long long)pk2(y2, y3) << 32);
}
__device__ __forceinline__ void sgu_item(const Ctx& C, int l, int ci) {
    const bf16_t* Z = (const bf16_t*)(C.ws + WS_Z); bf16_t* Y = (bf16_t*)(C.ws + WS_HY); LAS float* V = (LAS float*)C.lds;
    const int r0 = ci < 256 ? ci * 128 : NLAT + (ci - 256) * 128;
    { const int ch = 4 * C.lane; const f32x4 lw = *(const f32x4*)(C.in[I_SLNW] + l * 256 + ch), lb = *(const f32x4*)(C.in[I_SLNB] + l * 256 + ch);
      for (int s = C.wave; s < 128; s += 8) {
        const unsigned long long zw = *(const unsigned long long*)(Z + (size_t)(r0 + s) * ZLD + 1280 + ch); const unsigned z0 = (unsigned)zw, z1 = (unsigned)(zw >> 32);
        f32x4 v = {gelu_t(bflo(z0)), gelu_t(bfhi(z0)), gelu_t(bflo(z1)), gelu_t(bfhi(z1))};
        const float mu = wave_sum((v[0] + v[1]) + (v[2] + v[3])) * (1.0f / 256.0f); v = v - mu;
        const float rstd = 1.0f / sqrtf(wave_sum((v[0] * v[0] + v[1] * v[1]) + (v[2] * v[2] + v[3] * v[3])) * (1.0f / 256.0f) + LN_EPS);
        *(LAS f32x4*)(V + s * 256 + ch) = v * rstd * lw + lb; } }
    __syncthreads();
    const int ch = C.tid & 255, g = __builtin_amdgcn_readfirstlane(C.wave & 3), th = __builtin_amdgcn_readfirstlane(C.wave >> 2);
    const float* ws = C.in[I_SW] + (size_t)(l * 4 + g) * 128 * 128; const float* bs = C.in[I_SB] + (l * 4 + g) * 128;
    for (int tb = 0; tb < 4; ++tb) { const int t0 = th * 64 + tb * 16; float acc[16];
#pragma unroll
        for (int t = 0; t < 16; ++t) acc[t] = 0.f;
        for (int s = 0; s < 128; s += 4) { const float v0 = V[s * 256 + ch], v1 = V[(s + 1) * 256 + ch], v2 = V[(s + 2) * 256 + ch], v3 = V[(s + 3) * 256 + ch];
#pragma unroll
            for (int t = 0; t < 16; ++t) { const f32x4 w = *(const f32x4*)(ws + (t0 + t) * 128 + s); acc[t] += (w[0] * v0 + w[1] * v1) + (w[2] * v2 + w[3] * v3); } }
#pragma unroll
        for (int t = 0; t < 16; ++t) { const int row = r0 + t0 + t; const float u = gelu_t(bf2f(Z[(size_t)row * ZLD + 1024 + ch])); Y[(size_t)row * D + 256 + ch] = (bf16_t)f2bf(u * (acc[t] + bs[t0 + t])); } }
    __syncthreads();
}
__device__ __forceinline__ void conv_item(const Ctx& C, int l, int ti) {
    const bf16_t* Z = (const bf16_t*)(C.ws + WS_Z); bf16_t* Y = (bf16_t*)(C.ws + WS_HY); LAS float* A = (LAS float*)C.lds;
    int r0, seg_lo, seg_len; if (ti < 512) { r0 = ti * 64; seg_lo = 0; seg_len = 64; } else { const int b = (ti - 512) >> 2, tq = (ti - 512) & 3; r0 = NLAT + b * 256 + tq * 64; seg_lo = tq * 64; seg_len = 256; }
    { const int ch = 4 * (C.tid & 63);
      for (int a = C.tid >> 6; a < 94; a += 8) { const int ts = seg_lo + a - 15; f32x4 v = {0.f, 0.f, 0.f, 0.f};
        if (ts >= 0 && ts < seg_len) { const bf16_t* zr = Z + (size_t)(r0 + a - 15) * ZLD + 1536 + ch; const unsigned long long vw = *(const unsigned long long*)zr, gw = *(const unsigned long long*)(zr + 256);
            const unsigned v0 = (unsigned)vw, v1 = (unsigned)(vw >> 32), g0 = (unsigned)gw, g1 = (unsigned)(gw >> 32);
            v[0] = bflo(v0) * sigm(bflo(g0)); v[1] = bfhi(v0) * sigm(bfhi(g0)); v[2] = bflo(v1) * sigm(bflo(g1)); v[3] = bfhi(v1) * sigm(bfhi(g1)); }
        *(LAS f32x4*)(A + a * 256 + ch) = v; } }
    __syncthreads();
    const int ch = C.tid & 255, th = C.tid >> 8; float o[32];
    { const float* cw = C.in[I_CW] + (size_t)l * 31 * 256 + ch; const float cb = C.in[I_CB][l * 256 + ch];
#pragma unroll
      for (int t = 0; t < 32; ++t) o[t] = cb;
      for (int j = 0; j < 31; ++j) { const float w = cw[j * 256];
#pragma unroll
        for (int t = 0; t < 32; ++t) o[t] += w * A[(th * 32 + t + j) * 256 + ch]; } }
    __syncthreads();
#pragma unroll
    for (int t = 0; t < 32; ++t) A[(th * 32 + t) * 256 + ch] = o[t];
    __syncthreads();
    { const int c4 = 4 * C.lane; const f32x4 lw = *(const f32x4*)(C.in[I_CLNW] + l * 256 + c4), lb = *(const f32x4*)(C.in[I_CLNB] + l * 256 + c4);
      for (int t = C.wave; t < 64; t += 8) { f32x4 v = *(const LAS f32x4*)(A + t * 256 + c4);
        const float mu = wave_sum((v[0] + v[1]) + (v[2] + v[3])) * (1.0f / 256.0f); v = v - mu;
        const float rstd = 1.0f / sqrtf(wave_sum((v[0] * v[0] + v[1] * v[1]) + (v[2] * v[2] + v[3] * v[3])) * (1.0f / 256.0f) + LN_EPS);
        v = v * rstd * lw + lb; const float y0 = v[0] * sigm(v[0]), y1 = v[1] * sigm(v[1]), y2 = v[2] * sigm(v[2]), y3 = v[3] * sigm(v[3]);
        *(unsigned long long*)(Y + (size_t)(r0 + t) * D + 512 + c4) = (unsigned long long)pk2(y0, y1) | ((unsigned long long)pk2(y2, y3) << 32); } }
    __syncthreads();
}
__device__ __forceinline__ const bf16_t* wt_ptr(const Ctx& C, int l, size_t off) { return (const bf16_t*)(C.ws + WS_WT + (size_t)l * WT_LAYER + off); }
template <class Epi> __device__ __forceinline__ void run_gemm(const Ctx& C, const Gemm& g, const Epi& E) {
    StaticOrder S; S.init(g.M, g.N, C.G, C.bid);
    gemm_phase<Epi, StaticOrder, true, true>(C.lds, g, S, E);
}
__device__ __forceinline__ void p_inproj(const Ctx& C, int l) {
    Gemm g{(const bf16_t*)(C.ws + WS_HY), wt_ptr(C, l, WT_IN), NROWS, 2304, D, D, D, 0, 0};
    EpiInProj E{(bf16_t*)(C.ws + WS_Z), (bf16_t*)(C.ws + WS_UH)}; run_gemm(C, g, E);
}
__device__ __forceinline__ void p_outproj(const Ctx& C, int l) {
    Gemm g{(const bf16_t*)(C.ws + WS_HY), wt_ptr(C, l, WT_OUT), l == 0 ? NROWS : NLAT, D, D, D, D, 0, 0};
    float* XC = (float*)(C.ws + WS_XC);
    EpiResGate E{l == 0 ? C.in[I_X] : C.out, l == 0 ? C.in[I_CTX] : XC, C.out, XC, (const float*)(C.ws + WS_MOD) + (size_t)l * 17 * 6144 + 2048, ALPHA}; run_gemm(C, g, E);
}
__device__ __forceinline__ void p_ffnin(const Ctx& C, int l) {
    Gemm g{(const bf16_t*)(C.ws + WS_HY), wt_ptr(C, l, WT_FFIN), l == 0 ? NROWS : NLAT, 2 * DFF, D, D, D, 0, 0};
    EpiSwiGlu E{(bf16_t*)(C.ws + WS_ACT), DFF}; run_gemm(C, g, E);
}
__device__ __forceinline__ void p_ffnout(const Ctx& C, int l) {
    Gemm g{(const bf16_t*)(C.ws + WS_ACT), wt_ptr(C, l, WT_FFOUT), l == 0 ? NROWS : NLAT, D, DFF, DFF, DFF, 0, 0};
    float* XC = (float*)(C.ws + WS_XC);
    EpiResGate E{C.out, XC, C.out, XC, (const float*)(C.ws + WS_MOD) + (size_t)l * 17 * 6144 + 5120, ALPHA}; run_gemm(C, g, E);
}
__device__ __forceinline__ void p_mixA(const Ctx& C, int l) {
    const int nsgu = l == 0 ? 288 : 256, ncv = l == 0 ? 576 : 512, total = 64 + 32 + nsgu + ncv;
    for (int it = C.bid; it < total; it += C.G) {
        int r = it;
        if (r < 64) { nv_mlstm_chain(C, r >> 2, r & 3, 0); continue; } r -= 64;
        if (r < 32) { nv_s5_item(C, l, r >> 1, r & 1, 0); continue; } r -= 32;
        if (r < nsgu) { sgu_item(C, l, r); continue; } r -= nsgu;
        conv_item(C, l, r);
    }
}
__device__ __forceinline__ void p_mixB(const Ctx& C, int l) {
    for (int it = C.bid; it < 96; it += C.G) { if (it < 64) nv_mlstm_chain(C, it >> 2, it & 3, 1); else nv_s5_item(C, l, (it - 64) >> 1, (it - 64) & 1, 1); }
}
__device__ __forceinline__ void p_mixC(const Ctx& C, int l) {
    const int nrows = l == 0 ? NROWS : NLAT;
    for (int row = C.bid * 8 + C.wave; row < nrows; row += C.G * 8) nv_readout_row(C, l, row);
    for (int it = C.bid; it < nrows / 32; it += C.G) nv_glu_item(C, l, it);
}

__global__ void __launch_bounds__(512, 2) mk_fwd(Args a) {
    extern __shared__ __attribute__((aligned(16))) unsigned char lds_raw[];
    Ctx C; C.lds = (LAS unsigned char*)lds_raw; C.tid = threadIdx.x; C.lane = C.tid & 63; C.wave = __builtin_amdgcn_readfirstlane(C.tid >> 6); C.bid = blockIdx.x; C.G = gridDim.x;
    C.in = a.in; C.out = a.out; C.ws = a.ws;
    const int lo = a.ph_lo, hi = a.ph_hi;
#define PH(k, body) if (lo <= (k) && (k) < hi) { body; if ((k) + 1 < hi) { __threadfence(); cooperative_groups::this_grid().sync(); } }
    PH(0, p_prologue(C))
    PH(1, p_rowpass(C, 0, 0))
    PH(2, p_inproj(C, 0))
    PH(3, p_mixA(C, 0))
    PH(4, p_mixB(C, 0))
    PH(5, p_mixC(C, 0))
    PH(6, p_outproj(C, 0))
    PH(7, p_rowpass(C, 1, 0))
    PH(8, p_ffnin(C, 0))
    PH(9, p_ffnout(C, 0))
    PH(10, p_rowpass(C, 2, 0))
    PH(11, p_inproj(C, 1))
    PH(12, p_mixA(C, 1))
    PH(13, p_mixB(C, 1))
    PH(14, p_mixC(C, 1))
    PH(15, p_outproj(C, 1))
    PH(16, p_rowpass(C, 1, 1))
    PH(17, p_ffnin(C, 1))
    PH(18, p_ffnout(C, 1))
    PH(19, p_rowpass(C, 2, 1))
#undef PH
}
}

extern "C" void kernel_launch(void* const* d_in, const int* in_sizes, int n_in, void* d_out, int out_size, void* d_ws, size_t ws_size, hipStream_t stream) {
    static int ready = 0;
    if (!ready) {
        if (n_in != 34 || in_sizes[0] != mk::NLAT * mk::D || out_size != mk::NLAT * mk::D || ws_size < mk::WS_END) { fprintf(stderr, "kernel_launch: unexpected shapes (n_in %d, in0 %d, out %d, ws %zu)\n", n_in, n_in > 0 ? in_sizes[0] : -1, out_size, ws_size); ready = -1; return; }
        if (hipFuncSetAttribute((const void*)mk::mk_fwd, hipFuncAttributeMaxDynamicSharedMemorySize, mk::LDS_BYTES) != hipSuccess) { fprintf(stderr, "kernel_launch: hipFuncSetAttribute failed\n"); ready = -1; return; }
        ready = 1;
    }
    if (ready < 0) return;
    mk::Args a{};
    for (int i = 0; i < 34; ++i) a.in[i] = (const float*)d_in[i];
    a.out = (float*)d_out; a.ws = (unsigned char*)d_ws;
#if MK_ONE_LAUNCH
    a.ph_lo = 0; a.ph_hi = mk::NPH;
    void* args[] = {&a};
    hipError_t e = hipLaunchCooperativeKernel((const void*)mk::mk_fwd, dim3(256), dim3(512), args, mk::LDS_BYTES, stream);
    if (e != hipSuccess) fprintf(stderr, "cooperative launch failed: %s\n", hipGetErrorString(e));
#else
    for (int ph = 0; ph < mk::NPH; ++ph) {
        a.ph_lo = ph; a.ph_hi = ph + 1;
        hipLaunchKernelGGL(mk::mk_fwd, dim3(256), dim3(512), mk::LDS_BYTES, stream, a);
    }
#endif
}
```

```cpp
#include <hip/hip_runtime.h>
#include <hip/hip_cooperative_groups.h>
#include <cstdio>
#include <cstdint>
namespace pg8 {
#define PG8_LAS __attribute__((address_space(3)))
typedef unsigned short bf16_t;
typedef short bf16x8 __attribute__((ext_vector_type(8)));
typedef float f32x4 __attribute__((ext_vector_type(4)));
typedef unsigned u32x4 __attribute__((ext_vector_type(4)));
constexpr int BM = 256, BK = 64, HALF = 128, HTB = HALF * BK * 2  , STAGE_BYTES = 8 * HTB, NXCD = 8, WGM = 8;

__host__ __device__ __forceinline__ int lds_byte(int r, int c) { const int st = (r >> 4) * 2 + (c >> 5), rr = r & 15, cc = c & 31, ob = rr * 64 + cc * 2; return st * 1024 + (ob ^ (((ob >> 9) & 1) << 5)); }
__host__ __device__ __forceinline__ void stage_rc(int b, int& R, int& C) { const int st = b / 1024, sb = b % 1024, swz = sb ^ (((sb >> 9) & 1) << 5); R = (st >> 1) * 16 + swz / 64; C = (st & 1) * 32 + (swz % 64) / 2; }
__host__ __device__ __forceinline__ int perm32(int rho) { const int n = rho >> 4, i = rho & 15; return 8 * (i >> 2) + 4 * n + (i & 3); }

struct Unit { int pm, pn; };
struct Gemm { const bf16_t* A; const bf16_t* Bt; int M, N, K, lda, ldb, bgrp; size_t bgrp_stride; };

struct StaticOrder {
    int nM, nN, nwg, G, c;
    __host__ __device__ void init(int M, int N, int G_, int c_) { nM = M / BM; nN = N / BM; nwg = nM * nN; G = G_; c = c_; }
    __host__ __device__ bool next(int i, Unit& u) const {
        const long L = (long)i * G + c; if (L >= nwg) return false;
        int wgid = (int)L; { const int q = nwg / NXCD, r = nwg % NXCD, xcd = wgid % NXCD, off = wgid / NXCD; wgid = (xcd < r ? xcd * (q + 1) : r * (q + 1) + (xcd - r) * q) + off; }
        const int nig = WGM * nN, gid = wgid / nig, fm = gid * WGM, gsz = (nM - fm) < WGM ? (nM - fm) : WGM;
        u.pm = fm + ((wgid % nig) % gsz); u.pn = (wgid % nig) / gsz; return true;
    }
    __device__ __forceinline__ void a_ready(const Unit&) const {}
    __device__ __forceinline__ void done(const Unit&) const {}
};

__device__ __forceinline__ unsigned cvt_pk_bf16(float lo, float hi) { unsigned r; asm volatile("v_cvt_pk_bf16_f32 %0, %1, %2" : "=v"(r) : "v"(lo), "v"(hi)); return r; }
__device__ __forceinline__ float bflo(unsigned w) { return __uint_as_float(w << 16); }
__device__ __forceinline__ float bfhi(unsigned w) { return __uint_as_float(w & 0xffff0000u); }
__device__ __forceinline__ float sigm(float x) { return __builtin_amdgcn_rcpf(1.0f + __expf(-x)); }
__device__ __forceinline__ float gelu_t(float x) { const float u = 1.5957691216f * (x + 0.044715f * x * x * x); return x * sigm(u); }
__device__ __forceinline__ u32x4 pack8(const f32x4 a, const f32x4 b) { u32x4 w; w.x = cvt_pk_bf16(a[0], a[1]); w.y = cvt_pk_bf16(a[2], a[3]); w.z = cvt_pk_bf16(b[0], b[1]); w.w = cvt_pk_bf16(b[2], b[3]); return w; }

constexpr int NLAT = 32768, NROWS = 36864, ZLD = 2048, NCH_S5 = 2304;

struct EpiInProj {
    static constexpr bool PERM = true, AFTER_DRAIN = false;
    bf16_t* Z; bf16_t* UH;
    __device__ __forceinline__ void operator()(const f32x4 (&acc)[2][2][4][2], const Unit& u, int wr, int wc, int fr, int fq) const {
#pragma unroll
        for (int ai = 0; ai < 2; ++ai)
#pragma unroll
            for (int m = 0; m < 4; ++m) { const int row = u.pm * BM + ai * HALF + wr * 64 + m * 16 + fr;
#pragma unroll
                for (int bj = 0; bj < 2; ++bj) { const u32x4 w = pack8(acc[ai][bj][m][0], acc[ai][bj][m][1]); const int cc = bj * HALF + wc * 32 + 8 * fq;
                    if (u.pn < 8) *(u32x4*)(Z + (size_t)row * ZLD + u.pn * BM + cc) = w;
                    else { const int g = cc >> 4, q0 = cc & 15; *(u32x4*)(UH + ((size_t)(g * NCH_S5 + (row >> 4)) * 512 + (row & 15) * 16 + q0)) = w; } } }
    }
};
struct EpiResGate {
    static constexpr bool PERM = false, AFTER_DRAIN = false;
    const float* srcL; const float* srcC; float* dstL; float* dstC; const float* gate; float alpha;
    __device__ __forceinline__ void operator()(const f32x4 (&acc)[2][2][4][2], const Unit& u, int wr, int wc, int fr, int fq) const {
        const int row0 = u.pm * BM; const bool lat = row0 < NLAT; const int mi = lat ? (row0 >> 11) : 16;
        const float* src = lat ? srcL + (size_t)row0 * 1024 : srcC + (size_t)(row0 - NLAT) * 1024; float* dst = lat ? dstL + (size_t)row0 * 1024 : dstC + (size_t)(row0 - NLAT) * 1024;
        const float* gp = gate + (size_t)mi * 6144;
#pragma unroll
        for (int bj = 0; bj < 2; ++bj)
#pragma unroll
            for (int n = 0; n < 2; ++n) { const int col = u.pn * BM + bj * HALF + wc * 32 + n * 16 + 4 * fq; const f32x4 gv = *(const f32x4*)(gp + col);
#pragma unroll
                for (int ai = 0; ai < 2; ++ai)
#pragma unroll
                    for (int m = 0; m < 4; ++m) { const size_t off = (size_t)(ai * HALF + wr * 64 + m * 16 + fr) * 1024 + col; const f32x4 x = *(const f32x4*)(src + off); *(f32x4*)(dst + off) = x * alpha + gv * acc[ai][bj][m][n]; } }
    }
};
struct EpiSwiGlu {
    static constexpr bool PERM = true, AFTER_DRAIN = false;
    bf16_t* ACT; int ldc;
    __device__ __forceinline__ void operator()(const f32x4 (&acc)[2][2][4][2], const Unit& u, int wr, int wc, int fr, int fq) const {
#pragma unroll
        for (int ai = 0; ai < 2; ++ai)
#pragma unroll
            for (int m = 0; m < 4; ++m) { const int row = u.pm * BM + ai * HALF + wr * 64 + m * 16 + fr; f32x4 o[2];
#pragma unroll
                for (int n = 0; n < 2; ++n)
#pragma unroll
                    for (int e = 0; e < 4; ++e) { const float g = acc[ai][0][m][n][e]; o[n][e] = g * sigm(g) * acc[ai][1][m][n][e]; }
                *(u32x4*)(ACT + (size_t)row * ldc + u.pn * HALF + wc * 32 + 8 * fq) = pack8(o[0], o[1]); }
    }
};
struct EpiF32 {
    static constexpr bool PERM = false, AFTER_DRAIN = false;
    float* O; int ldc;
    __device__ __forceinline__ void operator()(const f32x4 (&acc)[2][2][4][2], const Unit& u, int wr, int wc, int fr, int fq) const {
#pragma unroll
        for (int ai = 0; ai < 2; ++ai)
#pragma unroll
            for (int m = 0; m < 4; ++m) { const size_t ro = (size_t)(u.pm * BM + ai * HALF + wr * 64 + m * 16 + fr) * ldc;
#pragma unroll
                for (int bj = 0; bj < 2; ++bj)
#pragma unroll
                    for (int n = 0; n < 2; ++n) *(f32x4*)(O + ro + u.pn * BM + bj * HALF + wc * 32 + n * 16 + 4 * fq) = acc[ai][bj][m][n]; }
    }
};
struct EpiS5Y {
    static constexpr bool PERM = true, AFTER_DRAIN = false;
    const bf16_t* UH; const float* dsk; bf16_t* YS5;
    __device__ __forceinline__ void operator()(const f32x4 (&acc)[2][2][4][2], const Unit& u, int wr, int wc, int fr, int fq) const {
        const int g = (u.pm * BM) / NCH_S5;
#pragma unroll
        for (int bj = 0; bj < 2; ++bj) { const int col = bj * HALF + wc * 32 + 8 * fq, t = col >> 4, p0 = col & 15;
            const f32x4 d0 = *(const f32x4*)(dsk + g * 16 + p0), d1 = *(const f32x4*)(dsk + g * 16 + p0 + 4);
#pragma unroll
            for (int ai = 0; ai < 2; ++ai)
#pragma unroll
                for (int m = 0; m < 4; ++m) { const int row = u.pm * BM + ai * HALF + wr * 64 + m * 16 + fr, chunk = row - g * NCH_S5;
                    const u32x4 uw = *(const u32x4*)(UH + (size_t)row * 512 + col); f32x4 a = acc[ai][bj][m][0], b = acc[ai][bj][m][1];
                    a[0] += d0[0] * bflo(uw.x); a[1] += d0[1] * bfhi(uw.x); a[2] += d0[2] * bflo(uw.y); a[3] += d0[3] * bfhi(uw.y);
                    b[0] += d1[0] * bflo(uw.z); b[1] += d1[1] * bfhi(uw.z); b[2] += d1[2] * bflo(uw.w); b[3] += d1[3] * bfhi(uw.w);
#pragma unroll
                    for (int e = 0; e < 4; ++e) { a[e] = gelu_t(a[e]); b[e] = gelu_t(b[e]); }
                    *(u32x4*)(YS5 + (size_t)(chunk * 16 + t) * 256 + g * 16 + p0) = pack8(a, b); } }
    }
};
struct EpiGlu {
    static constexpr bool PERM = true, AFTER_DRAIN = false;
    const bf16_t* YS5; const float* gb; bf16_t* Y;
    __device__ __forceinline__ void operator()(const f32x4 (&acc)[2][2][4][2], const Unit& u, int wr, int wc, int fr, int fq) const {
#pragma unroll
        for (int bj = 0; bj < 2; ++bj) { const int col = bj * HALF + wc * 32 + 8 * fq; const f32x4 b0 = *(const f32x4*)(gb + col), b1 = *(const f32x4*)(gb + col + 4);
#pragma unroll
            for (int ai = 0; ai < 2; ++ai)
#pragma unroll
                for (int m = 0; m < 4; ++m) { const int row = u.pm * BM + ai * HALF + wr * 64 + m * 16 + fr; const u32x4 yw = *(const u32x4*)(YS5 + (size_t)row * 256 + col);
                    f32x4 a = acc[ai][bj][m][0] + b0, b = acc[ai][bj][m][1] + b1;
                    a[0] = bflo(yw.x) * sigm(a[0]); a[1] = bfhi(yw.x) * sigm(a[1]); a[2] = bflo(yw.y) * sigm(a[2]); a[3] = bfhi(yw.y) * sigm(a[3]);
                    b[0] = bflo(yw.z) * sigm(b[0]); b[1] = bfhi(yw.z) * sigm(b[1]); b[2] = bflo(yw.w) * sigm(b[2]); b[3] = bfhi(yw.w) * sigm(b[3]);
                    *(u32x4*)(Y + (size_t)row * 1024 + 768 + col) = pack8(a, b); } }
    }
};

template <class Epi, class Sched, bool ALIGN_EPI = false, bool SP2 = false>
__device__ __forceinline__ void gemm_phase(PG8_LAS unsigned char* lds, const Gemm g, const Sched& S, const Epi& E) {
    const int tid = threadIdx.x, wid = __builtin_amdgcn_readfirstlane(tid >> 6), lane = tid & 63, wr = wid >> 2, wc = wid & 3, fr = lane & 15, fq = lane >> 4;
    const int K = g.K, nt = K / BK;
    unsigned voffA[2], voffB[2];
#pragma unroll
    for (int i = 0; i < 2; ++i) { int R, C; stage_rc(tid * 16 + i * 8192, R, C); const int Rb = Epi::PERM ? ((R & ~31) + perm32(R & 31)) : R;
        voffA[i] = (unsigned)(R * g.lda + C) * 2u; voffB[i] = (unsigned)(Rb * g.ldb + C) * 2u; }
    const size_t kstep = (size_t)(BK * 2);
    const size_t hstepA = (size_t)HALF * g.lda * 2, hstepB = (size_t)HALF * g.ldb * 2;
    const size_t tstepA = 2 * hstepA, tstepB = 2 * hstepB;
#define PG8_ABASE(u) ((const char*)g.A + (size_t)(u).pm * tstepA)
#define PG8_BBASE(u) ((const char*)g.Bt + (size_t)(u).pn * tstepB + (g.bgrp ? (size_t)((u).pm / g.bgrp) * g.bgrp_stride : (size_t)0))
    const unsigned ldsw = (unsigned)wid * 1024u;
    const int aoff = lds_byte(wr * 64 + fr, fq * 8), boff = lds_byte(wc * 32 + fr, fq * 8);
#define PG8_SA(b, h) (((b) * 2 + (h)) * HTB)
#define PG8_SB(b, h) ((4 + (b) * 2 + (h)) * HTB)
#define PG8_STAGE(bufoff, gbase, voff) do { _Pragma("unroll") for (int _i = 0; _i < 2; ++_i) \
        __builtin_amdgcn_global_load_lds((const unsigned*)((const char*)(gbase) + (voff)[_i]), (PG8_LAS unsigned*)(lds + (bufoff) + ldsw + _i * 8192), 16, 0, 0); } while (0)
#define PG8_LDA(dst, b, h) do { _Pragma("unroll") for (int m = 0; m < 4; ++m) _Pragma("unroll") for (int k = 0; k < 2; ++k) dst[m][k] = *(const PG8_LAS bf16x8*)(lds + PG8_SA(b, h) + aoff + m * 2048 + k * 1024); } while (0)
#define PG8_LDB(dst, b, h) do { _Pragma("unroll") for (int n = 0; n < 2; ++n) _Pragma("unroll") for (int k = 0; k < 2; ++k) dst[n][k] = *(const PG8_LAS bf16x8*)(lds + PG8_SB(b, h) + boff + n * 2048 + k * 1024); } while (0)
#define PG8_MMA(ai, bj, At, Bt) do { __builtin_amdgcn_s_setprio(1); _Pragma("unroll") for (int m = 0; m < 4; ++m) _Pragma("unroll") for (int n = 0; n < 2; ++n) _Pragma("unroll") for (int k = 0; k < 2; ++k) \
        acc[ai][bj][m][n] = __builtin_amdgcn_mfma_f32_16x16x32_bf16(Bt[n][k], At[m][k], acc[ai][bj][m][n], 0, 0, 0); __builtin_amdgcn_s_setprio(0); } while (0)
#define PG8_WAIT_V(n) asm volatile("s_waitcnt vmcnt(" #n ")" ::: "memory")
#define PG8_WAIT_L(n) asm volatile("s_waitcnt lgkmcnt(" #n ")" ::: "memory")
#define PG8_BAR __builtin_amdgcn_s_barrier()
#define PG8_SCHED __builtin_amdgcn_sched_barrier(0)
    Unit cur, nxt; int ui = 0;
    if (!S.next(0, cur)) return;
    f32x4 acc[2][2][4][2];
#pragma unroll
    for (int a = 0; a < 2; ++a)
#pragma unroll
        for (int b = 0; b < 2; ++b)
#pragma unroll
            for (int m = 0; m < 4; ++m)
#pragma unroll
                for (int n = 0; n < 2; ++n) acc[a][b][m][n] = (f32x4){0.f, 0.f, 0.f, 0.f};
    bf16x8 At[4][2], B0[2][2], B1[2][2];
    const char* cA = PG8_ABASE(cur); const char* cB = PG8_BBASE(cur);
    S.a_ready(cur);
    if constexpr (SP2) {
        PG8_STAGE(PG8_SB(0, 0), cB, voffB); PG8_STAGE(PG8_SB(0, 1), cB + hstepB, voffB); PG8_STAGE(PG8_SA(0, 0), cA, voffA); PG8_STAGE(PG8_SA(0, 1), cA + hstepA, voffA);
        if (wr == 1) PG8_BAR;
        PG8_WAIT_V(2); PG8_BAR;
        PG8_STAGE(PG8_SB(1, 0), cB + kstep, voffB); PG8_STAGE(PG8_SA(1, 0), cA + kstep, voffA); PG8_STAGE(PG8_SB(1, 1), cB + hstepB + kstep, voffB);
        PG8_WAIT_V(6); PG8_BAR;
    } else {
        PG8_STAGE(PG8_SB(0, 0), cB, voffB); PG8_STAGE(PG8_SA(0, 0), cA, voffA); PG8_STAGE(PG8_SB(0, 1), cB + hstepB, voffB); PG8_STAGE(PG8_SA(0, 1), cA + hstepA, voffA);
        if (wr == 1) PG8_BAR;
        PG8_WAIT_V(4); PG8_BAR;
        PG8_STAGE(PG8_SB(1, 0), cB + kstep, voffB); PG8_STAGE(PG8_SA(1, 0), cA + kstep, voffA); PG8_STAGE(PG8_SB(1, 1), cB + hstepB + kstep, voffB);
        PG8_WAIT_V(6); PG8_BAR;
    }
    for (;;) {
        const bool has_next = S.next(ui + 1, nxt);
        const char* nA = has_next ? PG8_ABASE(nxt) : cA; const char* nB = has_next ? PG8_BBASE(nxt) : cB;
        for (int t = 0; t < nt; t += 2) {
            const bool last = (t == nt - 2);
            const char* a1 = cA + (size_t)(t + 1) * kstep;
            const char* a2 = last ? nA : cA + (size_t)(t + 2) * kstep; const char* b2 = last ? nB : cB + (size_t)(t + 2) * kstep;
            const char* a3 = a2 + kstep; const char* b3 = b2 + kstep;
            if (last && has_next) S.a_ready(nxt);
            if constexpr (SP2) {
            PG8_LDB(B0, 0, 0); PG8_LDB(B1, 0, 1); PG8_SCHED; PG8_LDA(At, 0, 0); PG8_STAGE(PG8_SA(1, 1), a1 + hstepA, voffA);
            PG8_WAIT_V(8); PG8_WAIT_L(0); PG8_BAR; PG8_MMA(0, 0, At, B0); PG8_MMA(0, 1, At, B1); PG8_BAR; PG8_SCHED;
            PG8_LDA(At, 0, 1); PG8_STAGE(PG8_SB(0, 0), b2, voffB); PG8_STAGE(PG8_SB(0, 1), b2 + hstepB, voffB); PG8_STAGE(PG8_SA(0, 0), a2, voffA);
            PG8_WAIT_V(8); PG8_WAIT_L(0); PG8_BAR; PG8_MMA(1, 0, At, B0); PG8_MMA(1, 1, At, B1); PG8_BAR; PG8_SCHED;
            PG8_LDB(B0, 1, 0); PG8_LDB(B1, 1, 1); PG8_SCHED; PG8_LDA(At, 1, 0); PG8_STAGE(PG8_SA(0, 1), a2 + hstepA, voffA);
            PG8_WAIT_V(8); PG8_WAIT_L(0); PG8_BAR; PG8_MMA(0, 0, At, B0); PG8_MMA(0, 1, At, B1); PG8_BAR; PG8_SCHED;
            PG8_LDA(At, 1, 1); PG8_STAGE(PG8_SB(1, 0), b3, voffB); PG8_STAGE(PG8_SB(1, 1), b3 + hstepB, voffB); PG8_STAGE(PG8_SA(1, 0), a3, voffA);
            PG8_WAIT_V(8); PG8_WAIT_L(0); PG8_BAR; PG8_MMA(1, 0, At, B0); PG8_MMA(1, 1, At, B1); PG8_BAR; PG8_SCHED;
            } else {
            PG8_LDB(B0, 0, 0); PG8_SCHED; PG8_LDA(At, 0, 0); PG8_STAGE(PG8_SA(1, 1), a1 + hstepA, voffA);
            PG8_WAIT_L(8); PG8_BAR; PG8_WAIT_L(0); PG8_MMA(0, 0, At, B0); PG8_BAR; PG8_SCHED;
            PG8_LDB(B1, 0, 1); PG8_STAGE(PG8_SB(0, 0), b2, voffB);
            PG8_BAR; PG8_WAIT_L(0); PG8_MMA(0, 1, At, B1); PG8_BAR;
            PG8_LDA(At, 0, 1); PG8_STAGE(PG8_SA(0, 0), a2, voffA);
            PG8_BAR; PG8_WAIT_L(0); PG8_MMA(1, 0, At, B0); PG8_BAR; PG8_SCHED;
            PG8_STAGE(PG8_SB(0, 1), b2 + hstepB, voffB);
            PG8_WAIT_V(6); PG8_BAR; PG8_MMA(1, 1, At, B1); PG8_BAR;
            PG8_LDB(B0, 1, 0); PG8_SCHED; PG8_LDA(At, 1, 0); PG8_STAGE(PG8_SA(0, 1), a2 + hstepA, voffA);
            PG8_WAIT_L(8); PG8_BAR; PG8_WAIT_L(0); PG8_MMA(0, 0, At, B0); PG8_BAR; PG8_SCHED;
            PG8_LDB(B1, 1, 1); PG8_STAGE(PG8_SB(1, 0), b3, voffB);
            PG8_BAR; PG8_WAIT_L(0); PG8_MMA(0, 1, At, B1); PG8_BAR;
            PG8_LDA(At, 1, 1); PG8_STAGE(PG8_SA(1, 0), a3, voffA);
            PG8_BAR; PG8_WAIT_L(0); PG8_MMA(1, 0, At, B0); PG8_BAR; PG8_SCHED;
            PG8_STAGE(PG8_SB(1, 1), b3 + hstepB, voffB);
            PG8_WAIT_V(6); PG8_BAR; PG8_MMA(1, 1, At, B1); PG8_BAR;
            }
        }
        if constexpr (ALIGN_EPI) { if (wr == 0) PG8_BAR; }
        if constexpr (!Epi::AFTER_DRAIN) { E(acc, cur, wr, wc, fr, fq); S.done(cur); }
        if (!has_next) break;
#pragma unroll
        for (int a = 0; a < 2; ++a)
#pragma unroll
            for (int b = 0; b < 2; ++b)
#pragma unroll
                for (int m = 0; m < 4; ++m)
#pragma unroll
                    for (int n = 0; n < 2; ++n) acc[a][b][m][n] = (f32x4){0.f, 0.f, 0.f, 0.f};
        cur = nxt; cA = nA; cB = nB; ++ui;
        if constexpr (ALIGN_EPI) { if (wr == 1) PG8_BAR; }
    }
    PG8_WAIT_V(0);
    if constexpr (!ALIGN_EPI) { if (wr == 0) PG8_BAR; }
    PG8_BAR;
    if constexpr (Epi::AFTER_DRAIN) { E.fused(acc, cur, wr, wc, fr, fq, lds, wid, lane); S.done(cur); }
#undef PG8_ABASE
#undef PG8_BBASE
#undef PG8_SA
#undef PG8_SB
#undef PG8_STAGE
#undef PG8_LDA
#undef PG8_LDB
#undef PG8_MMA
#undef PG8_WAIT_V
#undef PG8_WAIT_L
#undef PG8_BAR
#undef PG8_SCHED
}
}

#ifndef MK_ONE_LAUNCH
#define MK_ONE_LAUNCH 1
#endif
namespace mk {
using namespace pg8;
#define LAS __attribute__((address_space(3)))
constexpr int D = 1024, NB = 16, SEQ = 2048, CTXL = 256, DFF = 2816, PIN = 2320, NPH = 20;
constexpr float ALPHA = 1.41421356237309515f, LN_EPS = 1e-5f;
constexpr size_t MiB = 1u << 20;
constexpr size_t WS_CTL = 0, WS_MOD = 1 * MiB, WS_WT = 2 * MiB, WT_LAYER = 30 * MiB;
constexpr size_t WT_IN = 0, WT_OUT = 9 * MiB / 2, WT_FFIN = 13 * MiB / 2, WT_FFOUT = 35 * MiB / 2, WT_GLU = 23 * MiB, WT_BTY = 93 * MiB / 4, WT_BTS = 109 * MiB / 4;
constexpr size_t WS_GATES = 62 * MiB, WS_XC = 65 * MiB, WS_HY = 81 * MiB, WS_Z = 153 * MiB, WS_ACT = 153 * MiB, WS_UH = 297 * MiB, WS_MST = 333 * MiB, WS_YS5 = 369 * MiB,
                 WS_S5S = 387 * MiB, WS_MISC = 423 * MiB, WS_HSUM = 427 * MiB, WS_Y32 = 463 * MiB, WS_END = 499 * MiB;
constexpr int LDS_BYTES = 147456;

struct Args { const float* in[34]; float* out; unsigned char* ws; int ph_lo, ph_hi; };
enum { I_X = 0, I_C, I_CTX, I_CCTX, I_WMOD, I_BMOD, I_WIN, I_GBIAS, I_MNORM, I_SLNW, I_SLNB, I_SW, I_SB, I_CW, I_CB, I_CLNW, I_CLNB, I_ARE, I_AIM, I_LDT, I_BRE, I_BIM, I_CRE, I_CIM, I_DSK, I_GLUW, I_GLUB,
       I_WOUT, I_LN1W, I_LN1B, I_WFFIN, I_WFFOUT, I_LN2W, I_LN2B };

struct Ctx { LAS unsigned char* lds; int tid, lane, wave, bid, G; const float* const* in; float* out; unsigned char* ws; };

__device__ __forceinline__ float bf2f(bf16_t h) { return __uint_as_float((unsigned)h << 16); }
__device__ __forceinline__ unsigned f2bf(float f) { unsigned u = __float_as_uint(f); return (u + 0x7fffu + ((u >> 16) & 1u)) >> 16; }
__device__ __forceinline__ unsigned pk2(float lo, float hi) { return f2bf(lo) | (f2bf(hi) << 16); }
__device__ __forceinline__ float wave_sum(float v) {
#pragma unroll
    for (int o = 1; o < 64; o <<= 1) v += __shfl_xor(v, o);
    return v;
}
__device__ __forceinline__ float logsig(float x) { return fminf(x, 0.f) - log1pf(expf(-fabsf(x))); }
__device__ __forceinline__ int chain_row(int b, int dir, int j) {
    if (j < CTXL) { const int t = dir ? CTXL - 1 - j : j; return NLAT + b * CTXL + t; }
    int t = j - CTXL; t = dir ? SEQ - 1 - t : t; return b * SEQ + t;
}
#define LDS_WAIT() asm volatile("s_waitcnt lgkmcnt(0)" ::: "memory")

__device__ __forceinline__ void transpose_item(const float* W, int ldw, int col0, bf16_t* WT, int K, int drow0, int k0, LAS float* scr, int lane) {
#pragma unroll 8
    for (int i = 0; i < 32; ++i) { const int kk = 2 * i + (lane >> 5); scr[kk * 33 + (lane & 31)] = W[(size_t)(k0 + kk) * ldw + col0 + (lane & 31)]; }
    LDS_WAIT(); asm volatile("" ::: "memory");
    const int c = lane & 7;
#pragma unroll
    for (int j = 0; j < 4; ++j) { const int n = (lane >> 3) + 8 * j; const LAS float* s = scr + (8 * c) * 33 + n;
        u32x4 o; o.x = pk2(s[0 * 33], s[1 * 33]); o.y = pk2(s[2 * 33], s[3 * 33]); o.z = pk2(s[4 * 33], s[5 * 33]); o.w = pk2(s[6 * 33], s[7 * 33]);
        *(u32x4*)(WT + (size_t)(drow0 + n) * K + k0 + 8 * c) = o; }
    LDS_WAIT(); asm volatile("" ::: "memory");
}
__device__ __forceinline__ void p_prologue(const Ctx& C) {
    LAS float* scr = (LAS float*)(C.lds + C.wave * 8448);
    const int gw = C.bid * 8 + C.wave, NGW = C.G * 8;
    constexpr int N_IN = 16 * 72, N_OUT = 16 * 32, N_FI = 16 * 176, N_FO = 44 * 32, N_GL = 4 * 8, N_L = N_IN + N_OUT + N_FI + N_FO + N_GL;
    for (int it = gw; it < 2 * N_L; it += NGW) {
        const int l = it / N_L; int r = it % N_L; unsigned char* wt = C.ws + WS_WT + (size_t)l * WT_LAYER;
        if (r < N_IN) { const int kb = r / 72, nb = r % 72; transpose_item(C.in[I_WIN] + (size_t)l * D * PIN, PIN, nb * 32 + (nb >= 32 ? 16 : 0), (bf16_t*)(wt + WT_IN), D, nb * 32, kb * 64, scr, C.lane); continue; } r -= N_IN;
        if (r < N_OUT) { const int kb = r / 32, nb = r % 32; transpose_item(C.in[I_WOUT] + (size_t)l * D * D, D, nb * 32, (bf16_t*)(wt + WT_OUT), D, nb * 32, kb * 64, scr, C.lane); continue; } r -= N_OUT;
        if (r < N_FI) { const int kb = r / 176, nb = r % 176, dr = nb * 32, pn = dr >> 8, bj = (dr >> 7) & 1, jj = dr & 127;
            transpose_item(C.in[I_WFFIN] + (size_t)l * D * 2 * DFF, 2 * DFF, bj * DFF + pn * 128 + jj, (bf16_t*)(wt + WT_FFIN), D, dr, kb * 64, scr, C.lane); continue; } r -= N_FI;
        if (r < N_FO) { const int kb = r / 32, nb = r % 32; transpose_item(C.in[I_WFFOUT] + (size_t)l * DFF * D, D, nb * 32, (bf16_t*)(wt + WT_FFOUT), DFF, nb * 32, kb * 64, scr, C.lane); continue; } r -= N_FO;
        { const int kb = r / 8, nb = r % 8; transpose_item(C.in[I_GLUW] + (size_t)l * 65536, 256, nb * 32, (bf16_t*)(wt + WT_GLU), 256, nb * 32, kb * 64, scr, C.lane); }
    }
    __syncthreads();
    LAS float* sc = (LAS float*)C.lds; LAS float* red = (LAS float*)(C.lds + 69632);
    if (C.bid < 192) {
        for (int idx = C.tid; idx < 17 * 1024; idx += 512) { const int i = idx >> 10, k = idx & 1023; const float v = i < 16 ? C.in[I_C][i * 1024 + k] : C.in[I_CCTX][k]; sc[idx] = v / (1.0f + expf(-v)); }
        __syncthreads();
        float* MOD = (float*)(C.ws + WS_MOD);
        for (int item = C.bid; item < 192; item += C.G) {
            const int l = item / 96, j = (item % 96) * 64 + C.lane; const float* w = C.in[I_WMOD] + (size_t)l * D * 6144 + j;
            float acc[17];
#pragma unroll
            for (int i = 0; i < 17; ++i) acc[i] = 0.f;
            for (int k = C.wave * 128; k < C.wave * 128 + 128; ++k) { const float wv = w[(size_t)k * 6144];
#pragma unroll
                for (int i = 0; i < 17; ++i) acc[i] += sc[i * 1024 + k] * wv; }
#pragma unroll
            for (int i = 0; i < 17; ++i) red[(C.wave * 17 + i) * 64 + C.lane] = acc[i];
            __syncthreads();
            for (int i = C.wave; i < 17; i += 8) { float s = 0.f;
#pragma unroll
                for (int w8 = 0; w8 < 8; ++w8) s += red[(w8 * 17 + i) * 64 + C.lane];
                MOD[(size_t)(l * 17 + i) * 6144 + j] = s + C.in[I_BMOD][l * 6144 + j]; }
            __syncthreads();
        }
    }
}

__device__ __forceinline__ void p_rowpass(const Ctx& C, int mode, int l) {
    const bool doLN = mode != 0, doH = !(mode == 2 && l == 1), doG = (mode == 0) || (mode == 2 && l == 0);
    const int nrows = (mode == 0 || l == 0) ? NROWS : NLAT;
    const int lm = (mode == 2) ? l + 1 : l;
    const float* MOD = (const float*)(C.ws + WS_MOD) + (size_t)(lm < 2 ? lm : 1) * 17 * 6144; const int osh = (mode == 1) ? 3072 : 0, osc = (mode == 1) ? 4096 : 1024;
    const float* lnw = C.in[mode == 1 ? I_LN1W : I_LN2W] + l * D; const float* lnb = C.in[mode == 1 ? I_LN1B : I_LN2B] + l * D;
    LAS float* wgT = (LAS float*)C.lds;
    if (doG) { const float* wg = C.in[I_WIN] + (size_t)lm * D * PIN + 1024;
        for (int idx = C.tid; idx < 16 * 1024; idx += 512) { const int k = idx >> 4, gi = idx & 15; wgT[gi * 1024 + k] = wg[(size_t)k * PIN + gi]; }
        __syncthreads(); }
    bf16_t* H = (bf16_t*)(C.ws + WS_HY); float* XC = (float*)(C.ws + WS_XC); float* GT = (float*)(C.ws + WS_GATES);
    for (int row = C.bid * 8 + C.wave; row < nrows; row += C.G * 8) {
        const bool lat = row < NLAT; const int mi = lat ? (row >> 11) : 16;
        float* xrow = lat ? C.out + (size_t)row * D : XC + (size_t)(row - NLAT) * D;
        const float* src = (mode == 0) ? (lat ? C.in[I_X] + (size_t)row * D : C.in[I_CTX] + (size_t)(row - NLAT) * D) : xrow;
        f32x4 v[4];
#pragma unroll
        for (int j = 0; j < 4; ++j) v[j] = *(const f32x4*)(src + 4 * C.lane + 256 * j);
        if (doLN) {
            float s = 0.f;
#pragma unroll
            for (int j = 0; j < 4; ++j) s += (v[j][0] + v[j][1]) + (v[j][2] + v[j][3]);
            const float mean = wave_sum(s) * (1.0f / D); float q = 0.f;
#pragma unroll
            for (int j = 0; j < 4; ++j) { v[j] = v[j] - mean; q += (v[j][0] * v[j][0] + v[j][1] * v[j][1]) + (v[j][2] * v[j][2] + v[j][3] * v[j][3]); }
            const float rstd = 1.0f / sqrtf(wave_sum(q) * (1.0f / D) + LN_EPS);
#pragma unroll
            for (int j = 0; j < 4; ++j) { const f32x4 w = *(const f32x4*)(lnw + 4 * C.lane + 256 * j), b = *(const f32x4*)(lnb + 4 * C.lane + 256 * j); v[j] = v[j] * rstd * w + b; *(f32x4*)(xrow + 4 * C.lane + 256 * j) = v[j]; }
        }
        if (doH) {
            const float* mp = MOD + (size_t)mi * 6144;
#pragma unroll
            for (int j = 0; j < 4; ++j) { const f32x4 sh = *(const f32x4*)(mp + osh + 4 * C.lane + 256 * j), scv = *(const f32x4*)(mp + osc + 4 * C.lane + 256 * j); v[j] = v[j] * (scv + 1.0f) + sh;
                unsigned long long o = (unsigned long long)pk2(v[j][0], v[j][1]) | ((unsigned long long)pk2(v[j][2], v[j][3]) << 32); *(unsigned long long*)(H + (size_t)row * D + 4 * C.lane + 256 * j) = o; }
            if (doG) {
                float keep = 0.f;
#pragma unroll 1
                for (int gi = 0; gi < 16; ++gi) { float p = 0.f;
#pragma unroll
                    for (int j = 0; j < 4; ++j) { const f32x4 w = *(const LAS f32x4*)(wgT + gi * 1024 + 4 * C.lane + 256 * j); p += (v[j][0] * w[0] + v[j][1] * w[1]) + (v[j][2] * w[2] + v[j][3] * w[3]); }
                    p = wave_sum(p); if (C.lane == gi) keep = p; }
                if (C.lane < 16) GT[(size_t)row * 16 + C.lane] = keep + C.in[I_GBIAS][lm * 16 + C.lane];
            }
        }
    }
}
__device__ __forceinline__ void nv_mlstm_chain(const Ctx& C, int b, int hd, int dir) {
    const bf16_t* Z = (const bf16_t*)(C.ws + WS_Z); const float* GT = (const float*)(C.ws + WS_GATES); float* HS = (float*)(C.ws + WS_HSUM);
    LAS float* qkv = (LAS float*)C.lds; LAS float* red = qkv + 192;
    const int tid = C.tid, vrow = tid >> 3, k0 = (tid & 7) * 8;
    float Cst[8]; for (int e = 0; e < 8; ++e) Cst[e] = 0.f;
    float nk = 0.f, m = 0.f, r0 = 0.f, ig_n, fg_n; int row_n;
#define NV_LOAD(j) do { const int row_ = chain_row(b, dir, (j)); row_n = row_; const bf16_t* zr = Z + (size_t)row_ * ZLD + hd * 64; \
        if (tid < 64) r0 = bf2f(zr[tid]); else if (tid < 128) r0 = bf2f(zr[256 + tid - 64]) * 0.125f; else if (tid < 192) r0 = bf2f(zr[512 + tid - 128]); \
        ig_n = GT[(size_t)row_ * 16 + dir * 8 + hd]; fg_n = GT[(size_t)row_ * 16 + dir * 8 + 4 + hd]; } while (0)
    NV_LOAD(0);
    for (int j = 0; j < CTXL + SEQ; ++j) {
        if (tid < 192) qkv[tid] = r0;
        const float ig = ig_n, lf = logsig(fg_n); const int row = row_n;
        __syncthreads();
        if (j + 1 < CTXL + SEQ) NV_LOAD(j + 1);
        const float mn = fmaxf(lf + m, ig), fdec = expf(lf + m - mn), iw = expf(ig - mn);
        if (tid < 64) { nk = fdec * nk + iw * qkv[64 + tid]; const float d = wave_sum(nk * qkv[tid]); if (tid == 0) red[0] = d; }
        const float vv = qkv[128 + vrow] * iw; float part = 0.f;
#pragma unroll
        for (int e = 0; e < 8; ++e) { Cst[e] = fdec * Cst[e] + vv * qkv[64 + k0 + e]; part += Cst[e] * qkv[k0 + e]; }
        part += __shfl_xor(part, 1); part += __shfl_xor(part, 2); part += __shfl_xor(part, 4);
        __syncthreads();
        const float den = red[0], h = part / fmaxf(fabsf(den), expf(-mn));
        if ((tid & 7) == 0) { float* hp = HS + (size_t)row * 256 + hd * 64 + vrow; if (dir) *hp += h; else *hp = h; }
        m = mn;
    }
#undef NV_LOAD
    __syncthreads();
}
__device__ __forceinline__ void nv_s5_item(const Ctx& C, int l, int b, int gh, int dir) {
    const bf16_t* UH = (const bf16_t*)(C.ws + WS_UH); float* Y32 = (float*)(C.ws + WS_Y32);
    const int g = gh * 8 + C.wave, n = C.lane;
    LAS float* base = (LAS float*)(C.lds + C.wave * 17920);
    LAS float* xr = base; LAS float* xi = base + 16 * 65; LAS float* cre = base + 2 * 16 * 65; LAS float* cim = cre + 1024; LAS float* us = cim + 1024;
    const float are = C.in[I_ARE][((l * 2 + dir) * 16 + g) * 64 + n], aim = C.in[I_AIM][((l * 2 + dir) * 16 + g) * 64 + n], dt = expf(C.in[I_LDT][(l * 2 + dir) * 16 + g]);
    const float mag = expf(are * dt), abr = mag * cosf(aim * dt), abi = mag * sinf(aim * dt), d2 = are * are + aim * aim;
    const float cr = ((abr - 1.f) * are + abi * aim) / d2, ci = (abi * are - (abr - 1.f) * aim) / d2;
    float br[16], bi[16];
#pragma unroll
    for (int q = 0; q < 16; ++q) { const float re = C.in[I_BRE][((size_t)(l * 16 + g) * 64 + n) * 16 + q], im = C.in[I_BIM][((size_t)(l * 16 + g) * 64 + n) * 16 + q]; br[q] = cr * re - ci * im; bi[q] = cr * im + ci * re; }
    for (int p = 0; p < 16; ++p) { cre[n * 16 + p] = C.in[I_CRE][((size_t)(l * 16 + g) * 16 + p) * 64 + n]; cim[n * 16 + p] = C.in[I_CIM][((size_t)(l * 16 + g) * 16 + p) * 64 + n]; }
    float sr = 0.f, si = 0.f;
    const int t_ = n >> 2, p0 = (n & 3) * 4;
    const f32x4 dv = *(const f32x4*)(C.in[I_DSK] + l * 256 + g * 16 + p0);
    for (int j0 = 0; j0 < CTXL + SEQ; j0 += 16) {
        { const int s = n >> 2, q0 = (n & 3) * 4, row = chain_row(b, dir, j0 + s); const bf16_t* up = UH + ((size_t)(g * NCH_S5 + (row >> 4)) * 512 + (row & 15) * 16 + q0);
#pragma unroll
          for (int e = 0; e < 4; ++e) us[s * 16 + q0 + e] = bf2f(up[e]); }
        __syncthreads();
        for (int s = 0; s < 16; ++s) { float bur = 0.f, bui = 0.f;
#pragma unroll
            for (int q = 0; q < 16; ++q) { const float uv = us[s * 16 + q]; bur += br[q] * uv; bui += bi[q] * uv; }
            const float nr = abr * sr - abi * si + bur, ni = abr * si + abi * sr + bui; sr = nr; si = ni; xr[s * 65 + n] = sr; xi[s * 65 + n] = si; }
        __syncthreads();
        f32x4 acc = {0.f, 0.f, 0.f, 0.f};
        for (int nn = 0; nn < 64; ++nn) { const float a = xr[t_ * 65 + nn], bq = xi[t_ * 65 + nn]; const f32x4 c1 = *(const LAS f32x4*)(cre + nn * 16 + p0), c2 = *(const LAS f32x4*)(cim + nn * 16 + p0); acc += c1 * a - c2 * bq; }
        const int row = chain_row(b, dir, j0 + t_); float* yp = Y32 + (size_t)row * 256 + g * 16 + p0;
        if (dir == 0) { f32x4 uu; uu[0] = us[t_ * 16 + p0]; uu[1] = us[t_ * 16 + p0 + 1]; uu[2] = us[t_ * 16 + p0 + 2]; uu[3] = us[t_ * 16 + p0 + 3]; *(f32x4*)yp = acc + dv * uu; }
        else { const f32x4 o = *(const f32x4*)yp; *(f32x4*)yp = o + acc; }
        __syncthreads();
    }
}
__device__ __forceinline__ void nv_glu_item(const Ctx& C, int l, int item) {
    const float* Y32 = (const float*)(C.ws + WS_Y32); bf16_t* Y = (bf16_t*)(C.ws + WS_HY); LAS float* ys = (LAS float*)C.lds;
    const int r0 = item * 32;
    for (int idx = C.tid; idx < 32 * 256; idx += 512) ys[idx] = gelu_t(Y32[(size_t)r0 * 256 + idx]);
    __syncthreads();
    const int c = C.tid & 255, th = C.tid >> 8; const float* w = C.in[I_GLUW] + (size_t)l * 65536 + c;
    float acc[16];
#pragma unroll
    for (int t = 0; t < 16; ++t) acc[t] = 0.f;
    for (int k = 0; k < 256; ++k) { const float wv = w[k * 256];
#pragma unroll
        for (int t = 0; t < 16; ++t) acc[t] += ys[(th * 16 + t) * 256 + k] * wv; }
    const float gb = C.in[I_GLUB][l * 256 + c];
#pragma unroll
    for (int t = 0; t < 16; ++t) { const int rr = th * 16 + t; Y[(size_t)(r0 + rr) * D + 768 + c] = (bf16_t)f2bf(ys[rr * 256 + c] * sigm(acc[t] + gb)); }
    __syncthreads();
}
__device__ __forceinline__ void nv_readout_row(const Ctx& C, int l, int row) {
    const float* HS = (const float*)(C.ws + WS_HSUM); const bf16_t* Z = (const bf16_t*)(C.ws + WS_Z); bf16_t* Y = (bf16_t*)(C.ws + WS_HY);
    const int ch = 4 * C.lane; f32x4 h = *(const f32x4*)(HS + (size_t)row * 256 + ch);
    float s = (h[0] + h[1]) + (h[2] + h[3]); s += __shfl_xor(s, 1); s += __shfl_xor(s, 2); s += __shfl_xor(s, 4); s += __shfl_xor(s, 8);
    const float mu = s * (1.0f / 64.0f); h = h - mu; float q = (h[0] * h[0] + h[1] * h[1]) + (h[2] * h[2] + h[3] * h[3]); q += __shfl_xor(q, 1); q += __shfl_xor(q, 2); q += __shfl_xor(q, 4); q += __shfl_xor(q, 8);
    const float rstd = 1.0f / sqrtf(q * (1.0f / 64.0f) + LN_EPS); const f32x4 nw = *(const f32x4*)(C.in[I_MNORM] + l * 256 + ch);
    const unsigned long long ow = *(const unsigned long long*)(Z + (size_t)row * ZLD + 768 + ch); const unsigned o0 = (unsigned)ow, o1 = (unsigned)(ow >> 32);
    const float y0 = h[0] * rstd * nw[0] * sigm(bflo(o0)), y1 = h[1] * rstd * nw[1] * sigm(bfhi(o0)), y2 = h[2] * rstd * nw[2] * sigm(bflo(o1)), y3 = h[3] * rstd * nw[3] * sigm(bfhi(o1));
    *(unsigned long long*)(Y + (size_t)row * D + ch) = (unsigned long long)pk2(y0, y1) | ((unsigned long long)pk2(y2, y3) << 32);
}
__device__ __forceinline__ void sgu_item(const Ctx& C, int l, int ci) {
    const bf16_t* Z = (const bf16_t*)(C.ws + WS_Z); bf16_t* Y = (bf16_t*)(C.ws + WS_HY); LAS float* V = (LAS float*)C.lds;
    const int r0 = ci < 256 ? ci * 128 : NLAT + (ci - 256) * 128;
    { const int ch = 4 * C.lane; const f32x4 lw = *(const f32x4*)(C.in[I_SLNW] + l * 256 + ch), lb = *(const f32x4*)(C.in[I_SLNB] + l * 256 + ch);
      for (int s = C.wave; s < 128; s += 8) {
        const unsigned long long zw = *(const unsigned long long*)(Z + (size_t)(r0 + s) * ZLD + 1280 + ch); const unsigned z0 = (unsigned)zw, z1 = (unsigned)(zw >> 32);
        f32x4 v = {gelu_t(bflo(z0)), gelu_t(bfhi(z0)), gelu_t(bflo(z1)), gelu_t(bfhi(z1))};
        const float mu = wave_sum((v[0] + v[1]) + (v[2] + v[3])) * (1.0f / 256.0f); v = v - mu;
        const float rstd = 1.0f / sqrtf(wave_sum((v[0] * v[0] + v[1] * v[1]) + (v[2] * v[2] + v[3] * v[3])) * (1.0f / 256.0f) + LN_EPS);
        *(LAS f32x4*)(V + s * 256 + ch) = v * rstd * lw + lb; } }
    __syncthreads();
    const int ch = C.tid & 255, g = __builtin_amdgcn_readfirstlane(C.wave & 3), th = __builtin_amdgcn_readfirstlane(C.wave >> 2);
    const float* ws = C.in[I_SW] + (size_t)(l * 4 + g) * 128 * 128; const float* bs = C.in[I_SB] + (l * 4 + g) * 128;
    for (int tb = 0; tb < 4; ++tb) { const int t0 = th * 64 + tb * 16; float acc[16];
#pragma unroll
        for (int t = 0; t < 16; ++t) acc[t] = 0.f;
        for (int s = 0; s < 128; s += 4) { const float v0 = V[s * 256 + ch], v1 = V[(s + 1) * 256 + ch], v2 = V[(s + 2) * 256 + ch], v3 = V[(s + 3) * 256 + ch];
#pragma unroll
            for (int t = 0; t < 16; ++t) { const f32x4 w = *(const f32x4*)(ws + (t0 + t) * 128 + s); acc[t] += (w[0] * v0 + w[1] * v1) + (w[2] * v2 + w[3] * v3); } }
#pragma unroll
        for (int t = 0; t < 16; ++t) { const int row = r0 + t0 + t; const float u = gelu_t(bf2f(Z[(size_t)row * ZLD + 1024 + ch])); Y[(size_t)row * D + 256 + ch] = (bf16_t)f2bf(u * (acc[t] + bs[t0 + t])); } }
    __syncthreads();
}
__device__ __forceinline__ void conv_item(const Ctx& C, int l, int ti) {
    const bf16_t* Z = (const bf16_t*)(C.ws + WS_Z); bf16_t* Y = (bf16_t*)(C.ws + WS_HY); LAS float* A = (LAS float*)C.lds;
    int r0, seg_lo, seg_len; if (ti < 512) { r0 = ti * 64; seg_lo = 0; seg_len = 64; } else { const int b = (ti - 512) >> 2, tq = (ti - 512) & 3; r0 = NLAT + b * 256 + tq * 64; seg_lo = tq * 64; seg_len = 256; }
    { const int ch = 4 * (C.tid & 63);
      for (int a = C.tid >> 6; a < 94; a += 8) { const int ts = seg_lo + a - 15; f32x4 v = {0.f, 0.f, 0.f, 0.f};
        if (ts >= 0 && ts < seg_len) { const bf16_t* zr = Z + (size_t)(r0 + a - 15) * ZLD + 1536 + ch; const unsigned long long vw = *(const unsigned long long*)zr, gw = *(const unsigned long long*)(zr + 256);
            const unsigned v0 = (unsigned)vw, v1 = (unsigned)(vw >> 32), g0 = (unsigned)gw, g1 = (unsigned)(gw >> 32);
            v[0] = bflo(v0) * sigm(bflo(g0)); v[1] = bfhi(v0) * sigm(bfhi(g0)); v[2] = bflo(v1) * sigm(bflo(g1)); v[3] = bfhi(v1) * sigm(bfhi(g1)); }
        *(LAS f32x4*)(A + a * 256 + ch) = v; } }
    __syncthreads();
    const int ch = C.tid & 255, th = C.tid >> 8; float o[32];
    { const float* cw = C.in[I_CW] + (size_t)l * 31 * 256 + ch; const float cb = C.in[I_CB][l * 256 + ch];
#pragma unroll
      for (int t = 0; t < 32; ++t) o[t] = cb;
      for (int j = 0; j < 31; ++j) { const float w = cw[j * 256];
#pragma unroll
        for (int t = 0; t < 32; ++t) o[t] += w * A[(th * 32 + t + j) * 256 + ch]; } }
    __syncthreads();
#pragma unroll
    for (int t = 0; t < 32; ++t) A[(th * 32 + t) * 256 + ch] = o[t];
    __syncthreads();
    { const int c4 = 4 * C.lane; const f32x4 lw = *(const f32x4*)(C.in[I_CLNW] + l * 256 + c4), lb = *(const f32x4*)(C.in[I_CLNB] + l * 256 + c4);
      for (int t = C.wave; t < 64; t += 8) { f32x4 v = *(const LAS f32x4*)(A + t * 256 + c4);
        const float mu = wave_sum((v[0] + v[1]) + (v[2] + v[3])) * (1.0f / 256.0f); v = v - mu;
        const float rstd = 1.0f / sqrtf(wave_sum((v[0] * v[0] + v[1] * v[1]) + (v[2] * v[2] + v[3] * v[3])) * (1.0f / 256.0f) + LN_EPS);
        v = v * rstd * lw + lb; const float y0 = v[0] * sigm(v[0]), y1 = v[1] * sigm(v[1]), y2 = v[2] * sigm(v[2]), y3 = v[3] * sigm(v[3]);
        *(unsigned long long*)(Y + (size_t)(r0 + t) * D + 512 + c4) = (unsigned long long)pk2(y0, y1) | ((unsigned long long)pk2(y2, y3) << 32); } }
    __syncthreads();
}
constexpr size_t MSN_OFF = 0, MSS_OFF = 2 * MiB, MSM_OFF = 3 * MiB;
__device__ __forceinline__ int ml_row0(int b, int c) { return c < 32 ? b * SEQ + 64 * c : NLAT + b * CTXL + 64 * (c - 32); }
__device__ __forceinline__ int ml_jf(int c) { return c < 32 ? 4 + c : c - 32; }
__device__ __forceinline__ int ml_jb(int c) { return c < 32 ? 35 - c : 35 - c; }
template <int K> __device__ __forceinline__ void lds_mma(f32x4& acc, const LAS bf16_t* A, int lda, const LAS bf16_t* B, int ldb, int lane) {
    const LAS bf16_t* ap = A + (lane & 15) * lda + 8 * (lane >> 4); const LAS bf16_t* bp = B + (lane & 15) * ldb + 8 * (lane >> 4);
#pragma unroll
    for (int k = 0; k < K; k += 32) { const bf16x8 a = *(const LAS bf16x8*)(ap + k), b = *(const LAS bf16x8*)(bp + k); acc = __builtin_amdgcn_mfma_f32_16x16x32_bf16(a, b, acc, 0, 0, 0); }
}
__device__ __forceinline__ float scan_add(float v, int lane) {
#pragma unroll
    for (int o = 1; o < 64; o <<= 1) { const float t = __shfl_up(v, o); if (lane >= o) v += t; }
    return v;
}
__device__ __forceinline__ float scan_max(float v, int lane) {
#pragma unroll
    for (int o = 1; o < 64; o <<= 1) { const float t = __shfl_up(v, o); if (lane >= o) v = fmaxf(v, t); }
    return v;
}
__device__ __forceinline__ float wave_max(float v) {
#pragma unroll
    for (int o = 1; o < 64; o <<= 1) v = fmaxf(v, __shfl_xor(v, o));
    return v;
}
constexpr int TS = 72;

__device__ __forceinline__ void ml_state_item(const Ctx& C, int b, int hd, int c) {
    const bf16_t* Z = (const bf16_t*)(C.ws + WS_Z); const float* GT = (const float*)(C.ws + WS_GATES);
    bf16_t* MST = (bf16_t*)(C.ws + WS_MST); float* MSN = (float*)(C.ws + WS_MISC + MSN_OFF); float* MSS = (float*)(C.ws + WS_MISC + MSS_OFF);
    LAS bf16_t* KT = (LAS bf16_t*)C.lds;
    LAS bf16_t* VE = KT + 64 * TS;
    LAS float* ef = (LAS float*)(VE + 144 * TS); LAS float* eb = ef + 64;
    const int r0 = ml_row0(b, c), tid = C.tid, lane = C.lane;
    const int s = tid >> 3, c8 = 8 * (tid & 7);
    const u32x4 kw = *(const u32x4*)(Z + (size_t)(r0 + s) * ZLD + 256 + hd * 64 + c8), vw = *(const u32x4*)(Z + (size_t)(r0 + s) * ZLD + 512 + hd * 64 + c8);
    if (C.wave < 2) { const int dir = C.wave, tok = dir ? 63 - lane : lane;
        const float ig = GT[(size_t)(r0 + tok) * 16 + dir * 8 + hd], lf = logsig(GT[(size_t)(r0 + tok) * 16 + dir * 8 + 4 + hd]);
        const float bb = scan_add(lf, lane), bend = __shfl(bb, 63), lu = bend - bb + ig, ml = wave_max(lu);
        (dir ? eb : ef)[tok] = expf(lu - ml);
        if (lane == 0) { const int chain = (b * 4 + hd) * 2 + dir, j = dir ? ml_jb(c) : ml_jf(c); MSS[(chain * 36 + j) * 2] = ml; MSS[(chain * 36 + j) * 2 + 1] = bend; } }
    for (int idx = tid; idx < 14 * TS; idx += 512) VE[130 * TS + idx] = 0;
    __syncthreads();
    { const float e0 = ef[s], e1 = eb[s]; const unsigned kk[4] = {kw.x, kw.y, kw.z, kw.w}, vv[4] = {vw.x, vw.y, vw.z, vw.w};
#pragma unroll
      for (int e = 0; e < 4; ++e) { const float k0 = bflo(kk[e]) * 0.125f, k1 = bfhi(kk[e]) * 0.125f, v0 = bflo(vv[e]), v1 = bfhi(vv[e]);
        KT[(c8 + 2 * e) * TS + s] = (bf16_t)f2bf(k0); KT[(c8 + 2 * e + 1) * TS + s] = (bf16_t)f2bf(k1);
        VE[(c8 + 2 * e) * TS + s] = (bf16_t)f2bf(v0 * e0); VE[(c8 + 2 * e + 1) * TS + s] = (bf16_t)f2bf(v1 * e0);
        VE[(64 + c8 + 2 * e) * TS + s] = (bf16_t)f2bf(v0 * e1); VE[(64 + c8 + 2 * e + 1) * TS + s] = (bf16_t)f2bf(v1 * e1); }
      if (tid < 64) { VE[128 * TS + tid] = (bf16_t)f2bf(ef[tid]); VE[129 * TS + tid] = (bf16_t)f2bf(eb[tid]); } }
    __syncthreads();
    const int chf = (b * 4 + hd) * 2, jf = ml_jf(c), jb = ml_jb(c);
    for (int t = C.wave; t < 36; t += 8) { const int mt = t & 3, nt = t >> 2; f32x4 acc = {0.f, 0.f, 0.f, 0.f};
        lds_mma<64>(acc, KT + mt * 16 * TS, TS, VE + nt * 16 * TS, TS, lane);
        const int k = mt * 16 + 4 * (lane >> 4), n = nt * 16 + (lane & 15);
        if (n < 128) { const int dir = n >> 6, v = n & 63; bf16_t* dst = MST + ((size_t)((chf + dir) * 36 + (dir ? jb : jf)) * 4096 + v * 64 + k);
            *(unsigned long long*)dst = (unsigned long long)cvt_pk_bf16(acc[0], acc[1]) | ((unsigned long long)cvt_pk_bf16(acc[2], acc[3]) << 32); }
        else if (n < 130) { const int dir = n - 128; *(f32x4*)(MSN + ((size_t)((chf + dir) * 36 + (dir ? jb : jf)) * 64 + k)) = acc; } }
    __syncthreads();
}
__device__ __forceinline__ void ml_carry_item(const Ctx& C, int item) {
    const int chain = item >> 1, half = item & 1, tid = C.tid;
    bf16_t* base = (bf16_t*)(C.ws + WS_MST) + (size_t)chain * 36 * 4096 + half * 2048 + tid * 4;
    float* MSN = (float*)(C.ws + WS_MISC + MSN_OFF) + (size_t)chain * 36 * 64; const float* MSS = (const float*)(C.ws + WS_MISC + MSS_OFF) + chain * 72; float* MSM = (float*)(C.ws + WS_MISC + MSM_OFF) + chain * 36;
    unsigned long long v[36]; float nn[36];
#pragma unroll
    for (int j = 0; j < 36; ++j) v[j] = *(const unsigned long long*)(base + (size_t)j * 4096);
    const bool don = (half == 0 && tid < 64);
    if (don) {
#pragma unroll
        for (int j = 0; j < 36; ++j) nn[j] = MSN[j * 64 + tid]; }
    float c0 = 0.f, c1 = 0.f, c2 = 0.f, c3 = 0.f, nk = 0.f, m = 0.f;
#pragma unroll
    for (int j = 0; j < 36; ++j) {
        const float ml = MSS[2 * j], be = MSS[2 * j + 1], mn = fmaxf(be + m, ml), dec = expf(be + m - mn), sc = expf(ml - mn);
        *(unsigned long long*)(base + (size_t)j * 4096) = (unsigned long long)cvt_pk_bf16(c0, c1) | ((unsigned long long)cvt_pk_bf16(c2, c3) << 32);
        if (half == 0 && tid == 0) MSM[j] = m;
        const unsigned lo = (unsigned)v[j], hi = (unsigned)(v[j] >> 32);
        c0 = dec * c0 + sc * bflo(lo); c1 = dec * c1 + sc * bfhi(lo); c2 = dec * c2 + sc * bflo(hi); c3 = dec * c3 + sc * bfhi(hi);
        if (don) { MSN[j * 64 + tid] = nk; nk = dec * nk + sc * nn[j]; }
        m = mn;
    }
}
__device__ __forceinline__ void ml_out_item(const Ctx& C, int l, int b, int hd, int c) {
    const bf16_t* Z = (const bf16_t*)(C.ws + WS_Z); const float* GT = (const float*)(C.ws + WS_GATES); bf16_t* Y = (bf16_t*)(C.ws + WS_HY);
    const bf16_t* MST = (const bf16_t*)(C.ws + WS_MST); const float* MSN = (const float*)(C.ws + WS_MISC + MSN_OFF); const float* MSM = (const float*)(C.ws + WS_MISC + MSM_OFF);
    LAS bf16_t* Qs = (LAS bf16_t*)C.lds; LAS bf16_t* Ks = Qs + 64 * TS; LAS bf16_t* VT = Ks + 64 * TS; LAS bf16_t* CF = VT + 64 * TS; LAS bf16_t* CB = CF + 64 * TS;
    LAS float* QK = (LAS float*)(C.lds + 46080);
    LAS bf16_t* AP = (LAS bf16_t*)(C.lds + 63488);
    LAS float* sc = (LAS float*)(C.lds + 89088);
    const int r0 = ml_row0(b, c), tid = C.tid, lane = C.lane, chf = (b * 4 + hd) * 2, jf = ml_jf(c), jb = ml_jb(c);
    const int s = tid >> 3, c8 = 8 * (tid & 7);
    { const bf16_t* zr = Z + (size_t)(r0 + s) * ZLD + hd * 64 + c8;
      const u32x4 qw = *(const u32x4*)zr, kw = *(const u32x4*)(zr + 256), vw = *(const u32x4*)(zr + 512);
      const u32x4 cf = *(const u32x4*)(MST + (size_t)((chf) * 36 + jf) * 4096 + s * 64 + c8), cb = *(const u32x4*)(MST + (size_t)((chf + 1) * 36 + jb) * 4096 + s * 64 + c8);
      if (C.wave < 2) { const int dir = C.wave, tok = dir ? 63 - lane : lane; LAS float* sd = sc + dir * 256;
        const float ig = GT[(size_t)(r0 + tok) * 16 + dir * 8 + hd], lf = logsig(GT[(size_t)(r0 + tok) * 16 + dir * 8 + 4 + hd]), min_ = MSM[(chf + dir) * 36 + (dir ? jb : jf)];
        const float bb = scan_add(lf, lane), a = ig - bb, pm = scan_max(a, lane), mx = fmaxf(min_, pm);
        sd[tok] = -mx; sd[64 + tok] = a; sd[128 + tok] = expf(min_ - mx); sd[192 + tok] = expf(-(bb + mx));
        sc[512 + dir * 64 + lane] = MSN[(size_t)((chf + dir) * 36 + (dir ? jb : jf)) * 64 + lane]; }
      *(LAS u32x4*)(Qs + s * TS + c8) = qw; *(LAS u32x4*)(CF + s * TS + c8) = cf; *(LAS u32x4*)(CB + s * TS + c8) = cb;
      const unsigned kk[4] = {kw.x, kw.y, kw.z, kw.w}, vv[4] = {vw.x, vw.y, vw.z, vw.w}; u32x4 ks;
      ks.x = cvt_pk_bf16(bflo(kk[0]) * 0.125f, bfhi(kk[0]) * 0.125f); ks.y = cvt_pk_bf16(bflo(kk[1]) * 0.125f, bfhi(kk[1]) * 0.125f); ks.z = cvt_pk_bf16(bflo(kk[2]) * 0.125f, bfhi(kk[2]) * 0.125f); ks.w = cvt_pk_bf16(bflo(kk[3]) * 0.125f, bfhi(kk[3]) * 0.125f);
      *(LAS u32x4*)(Ks + s * TS + c8) = ks;
#pragma unroll
      for (int e = 0; e < 4; ++e) { VT[(c8 + 2 * e) * TS + s] = (bf16_t)(vv[e] & 0xffffu); VT[(c8 + 2 * e + 1) * TS + s] = (bf16_t)(vv[e] >> 16); } }
    __syncthreads();
    for (int t = C.wave; t < 16; t += 8) { const int mt = t >> 2, nt = t & 3; f32x4 acc = {0.f, 0.f, 0.f, 0.f};
        lds_mma<64>(acc, Qs + mt * 16 * TS, TS, Ks + nt * 16 * TS, TS, lane);
#pragma unroll
        for (int r = 0; r < 4; ++r) QK[(mt * 16 + 4 * (lane >> 4) + r) * 68 + nt * 16 + (lane & 15)] = acc[r]; }
    __syncthreads();
    { const int t = tid >> 3, s0 = 8 * (tid & 7);
      const float rtf = sc[t], wf = sc[128 + t], emf = sc[192 + t], rtb = sc[256 + t], wb = sc[256 + 128 + t], emb = sc[256 + 192 + t];
      float sf[8], sb[8], rsf = 0.f, rsb = 0.f, qnf = 0.f, qnb = 0.f;
      const u32x4 qw = *(const LAS u32x4*)(Qs + t * TS + s0); const unsigned qq[4] = {qw.x, qw.y, qw.z, qw.w}; float qv[8];
#pragma unroll
      for (int e = 0; e < 4; ++e) { qv[2 * e] = bflo(qq[e]); qv[2 * e + 1] = bfhi(qq[e]); }
#pragma unroll
      for (int e = 0; e < 8; ++e) { const int ss = s0 + e; const float qk = QK[t * 68 + ss];
        sf[e] = (ss <= t) ? qk * expf(rtf + sc[64 + ss]) : 0.f; sb[e] = (ss >= t) ? qk * expf(rtb + sc[256 + 64 + ss]) : 0.f; rsf += sf[e]; rsb += sb[e];
        qnf += qv[e] * sc[512 + ss]; qnb += qv[e] * sc[576 + ss]; }
#pragma unroll
      for (int o = 1; o < 8; o <<= 1) { rsf += __shfl_xor(rsf, o); rsb += __shfl_xor(rsb, o); qnf += __shfl_xor(qnf, o); qnb += __shfl_xor(qnb, o); }
      const float idf = 1.0f / fmaxf(fabsf(rsf + wf * qnf), emf), idb = 1.0f / fmaxf(fabsf(rsb + wb * qnb), emb), qf = wf * idf, qb = wb * idb;
      u32x4 pw, fw, bw;
      pw.x = cvt_pk_bf16(sf[0] * idf + sb[0] * idb, sf[1] * idf + sb[1] * idb); pw.y = cvt_pk_bf16(sf[2] * idf + sb[2] * idb, sf[3] * idf + sb[3] * idb);
      pw.z = cvt_pk_bf16(sf[4] * idf + sb[4] * idb, sf[5] * idf + sb[5] * idb); pw.w = cvt_pk_bf16(sf[6] * idf + sb[6] * idb, sf[7] * idf + sb[7] * idb);
      fw.x = cvt_pk_bf16(qv[0] * qf, qv[1] * qf); fw.y = cvt_pk_bf16(qv[2] * qf, qv[3] * qf); fw.z = cvt_pk_bf16(qv[4] * qf, qv[5] * qf); fw.w = cvt_pk_bf16(qv[6] * qf, qv[7] * qf);
      bw.x = cvt_pk_bf16(qv[0] * qb, qv[1] * qb); bw.y = cvt_pk_bf16(qv[2] * qb, qv[3] * qb); bw.z = cvt_pk_bf16(qv[4] * qb, qv[5] * qb); bw.w = cvt_pk_bf16(qv[6] * qb, qv[7] * qb);
      *(LAS u32x4*)(AP + t * 200 + s0) = pw; *(LAS u32x4*)(AP + t * 200 + 64 + s0) = fw; *(LAS u32x4*)(AP + t * 200 + 128 + s0) = bw; }
    __syncthreads();
    for (int t = C.wave; t < 16; t += 8) { const int mt = t >> 2, nt = t & 3; f32x4 acc = {0.f, 0.f, 0.f, 0.f};
        lds_mma<64>(acc, AP + mt * 16 * 200, 200, VT + nt * 16 * TS, TS, lane);
        lds_mma<64>(acc, AP + mt * 16 * 200 + 64, 200, CF + nt * 16 * TS, TS, lane);
        lds_mma<64>(acc, AP + mt * 16 * 200 + 128, 200, CB + nt * 16 * TS, TS, lane);
#pragma unroll
        for (int r = 0; r < 4; ++r) QK[(mt * 16 + 4 * (lane >> 4) + r) * 68 + nt * 16 + (lane & 15)] = acc[r]; }
    __syncthreads();
    { const int t = tid >> 3, v0 = 8 * (tid & 7); float h[8]; float sm = 0.f;
#pragma unroll
      for (int e = 0; e < 8; ++e) { h[e] = QK[t * 68 + v0 + e]; sm += h[e]; }
      sm += __shfl_xor(sm, 1); sm += __shfl_xor(sm, 2); sm += __shfl_xor(sm, 4); const float mu = sm * (1.0f / 64.0f); float q = 0.f;
#pragma unroll
      for (int e = 0; e < 8; ++e) { h[e] -= mu; q += h[e] * h[e]; }
      q += __shfl_xor(q, 1); q += __shfl_xor(q, 2); q += __shfl_xor(q, 4); const float rstd = 1.0f / sqrtf(q * (1.0f / 64.0f) + LN_EPS);
      const float* nw = C.in[I_MNORM] + l * 256 + hd * 64 + v0; const u32x4 ow = *(const u32x4*)(Z + (size_t)(r0 + t) * ZLD + 768 + hd * 64 + v0); const unsigned oo[4] = {ow.x, ow.y, ow.z, ow.w};
      float y[8];
#pragma unroll
      for (int e = 0; e < 4; ++e) { y[2 * e] = h[2 * e] * rstd * nw[2 * e] * sigm(bflo(oo[e])); y[2 * e + 1] = h[2 * e + 1] * rstd * nw[2 * e + 1] * sigm(bfhi(oo[e])); }
      u32x4 w; w.x = cvt_pk_bf16(y[0], y[1]); w.y = cvt_pk_bf16(y[2], y[3]); w.z = cvt_pk_bf16(y[4], y[5]); w.w = cvt_pk_bf16(y[6], y[7]);
      *(u32x4*)(Y + (size_t)(r0 + t) * D + hd * 64 + v0) = w; }
    __syncthreads();
}
__device__ __forceinline__ const bf16_t* wt_ptr(const Ctx& C, int l, size_t off) { return (const bf16_t*)(C.ws + WS_WT + (size_t)l * WT_LAYER + off); }
template <class Epi> __device__ __forceinline__ void run_gemm(const Ctx& C, const Gemm& g, const Epi& E) {
    StaticOrder S; S.init(g.M, g.N, C.G, C.bid);
    gemm_phase<Epi, StaticOrder, true, true>(C.lds, g, S, E);
}
__device__ __forceinline__ void p_inproj(const Ctx& C, int l) {
    Gemm g{(const bf16_t*)(C.ws + WS_HY), wt_ptr(C, l, WT_IN), NROWS, 2304, D, D, D, 0, 0};
    EpiInProj E{(bf16_t*)(C.ws + WS_Z), (bf16_t*)(C.ws + WS_UH)}; run_gemm(C, g, E);
}
__device__ __forceinline__ void p_outproj(const Ctx& C, int l) {
    Gemm g{(const bf16_t*)(C.ws + WS_HY), wt_ptr(C, l, WT_OUT), l == 0 ? NROWS : NLAT, D, D, D, D, 0, 0};
    float* XC = (float*)(C.ws + WS_XC);
    EpiResGate E{l == 0 ? C.in[I_X] : C.out, l == 0 ? C.in[I_CTX] : XC, C.out, XC, (const float*)(C.ws + WS_MOD) + (size_t)l * 17 * 6144 + 2048, ALPHA}; run_gemm(C, g, E);
}
__device__ __forceinline__ void p_ffnin(const Ctx& C, int l) {
    Gemm g{(const bf16_t*)(C.ws + WS_HY), wt_ptr(C, l, WT_FFIN), l == 0 ? NROWS : NLAT, 2 * DFF, D, D, D, 0, 0};
    EpiSwiGlu E{(bf16_t*)(C.ws + WS_ACT), DFF}; run_gemm(C, g, E);
}
__device__ __forceinline__ void p_ffnout(const Ctx& C, int l) {
    Gemm g{(const bf16_t*)(C.ws + WS_ACT), wt_ptr(C, l, WT_FFOUT), l == 0 ? NROWS : NLAT, D, DFF, DFF, DFF, 0, 0};
    float* XC = (float*)(C.ws + WS_XC);
    EpiResGate E{C.out, XC, C.out, XC, (const float*)(C.ws + WS_MOD) + (size_t)l * 17 * 6144 + 5120, ALPHA}; run_gemm(C, g, E);
}
__device__ __forceinline__ void p_mixA(const Ctx& C, int l) {
    const int nsgu = l == 0 ? 288 : 256, ncv = l == 0 ? 576 : 512, total = 32 + 2304 + nsgu + ncv;
    for (int it = C.bid; it < total; it += C.G) {
        int r = it;
        if (r < 32) { nv_s5_item(C, l, r >> 1, r & 1, 0); continue; } r -= 32;
        if (r < 2304) { const int b = r / 144, q = r % 144; ml_state_item(C, b, q / 36, q % 36); continue; } r -= 2304;
        if (r < nsgu) { sgu_item(C, l, r); continue; } r -= nsgu;
        conv_item(C, l, r);
    }
}
__device__ __forceinline__ void p_mixB(const Ctx& C, int l) {
    for (int it = C.bid; it < 32 + 256; it += C.G) { if (it < 32) nv_s5_item(C, l, it >> 1, it & 1, 1); else ml_carry_item(C, it - 32); }
}
__device__ __forceinline__ void p_mixC(const Ctx& C, int l) {
    const int nrows = l == 0 ? NROWS : NLAT, ncs = l == 0 ? 36 : 32;
    for (int it = C.bid; it < 64 * ncs; it += C.G) { const int bh = it / ncs; ml_out_item(C, l, bh >> 2, bh & 3, it % ncs); }
    for (int it = C.bid; it < nrows / 32; it += C.G) nv_glu_item(C, l, it);
}

__global__ void __launch_bounds__(512, 2) mk_fwd(Args a) {
    extern __shared__ __attribute__((aligned(16))) unsigned char lds_raw[];
    Ctx C; C.lds = (LAS unsigned char*)lds_raw; C.tid = threadIdx.x; C.lane = C.tid & 63; C.wave = __builtin_amdgcn_readfirstlane(C.tid >> 6); C.bid = blockIdx.x; C.G = gridDim.x;
    C.in = a.in; C.out = a.out; C.ws = a.ws;
    const int lo = a.ph_lo, hi = a.ph_hi;
#define PH(k, body) if (lo <= (k) && (k) < hi) { body; if ((k) + 1 < hi) { __threadfence(); cooperative_groups::this_grid().sync(); } }
    PH(0, p_prologue(C))
    PH(1, p_rowpass(C, 0, 0))
    PH(2, p_inproj(C, 0))
    PH(3, p_mixA(C, 0))
    PH(4, p_mixB(C, 0))
    PH(5, p_mixC(C, 0))
    PH(6, p_outproj(C, 0))
    PH(7, p_rowpass(C, 1, 0))
    PH(8, p_ffnin(C, 0))
    PH(9, p_ffnout(C, 0))
    PH(10, p_rowpass(C, 2, 0))
    PH(11, p_inproj(C, 1))
    PH(12, p_mixA(C, 1))
    PH(13, p_mixB(C, 1))
    PH(14, p_mixC(C, 1))
    PH(15, p_outproj(C, 1))
    PH(16, p_rowpass(C, 1, 1))
    PH(17, p_ffnin(C, 1))
    PH(18, p_ffnout(C, 1))
    PH(19, p_rowpass(C, 2, 1))
#undef PH
}
}

extern "C" void kernel_launch(void* const* d_in, const int* in_sizes, int n_in, void* d_out, int out_size, void* d_ws, size_t ws_size, hipStream_t stream) {
    static int ready = 0;
    if (!ready) {
        if (n_in != 34 || in_sizes[0] != mk::NLAT * mk::D || out_size != mk::NLAT * mk::D || ws_size < mk::WS_END) { fprintf(stderr, "kernel_launch: unexpected shapes (n_in %d, in0 %d, out %d, ws %zu)\n", n_in, n_in > 0 ? in_sizes[0] : -1, out_size, ws_size); ready = -1; return; }
        if (hipFuncSetAttribute((const void*)mk::mk_fwd, hipFuncAttributeMaxDynamicSharedMemorySize, mk::LDS_BYTES) != hipSuccess) { fprintf(stderr, "kernel_launch: hipFuncSetAttribute failed\n"); ready = -1; return; }
        ready = 1;
    }
    if (ready < 0) return;
    mk::Args a{};
    for (int i = 0; i < 34; ++i) a.in[i] = (const float*)d_in[i];
    a.out = (float*)d_out; a.ws = (unsigned char*)d_ws;
#if MK_ONE_LAUNCH
    a.ph_lo = 0; a.ph_hi = mk::NPH;
    void* args[] = {&a};
    hipError_t e = hipLaunchCooperativeKernel((const void*)mk::mk_fwd, dim3(256), dim3(512), args, mk::LDS_BYTES, stream);
    if (e != hipSuccess) fprintf(stderr, "cooperative launch failed: %s\n", hipGetErrorString(e));
#else
    for (int ph = 0; ph < mk::NPH; ++ph) {
        a.ph_lo = ph; a.ph_hi = ph + 1;
        hipLaunchKernelGGL(mk::mk_fwd, dim3(256), dim3(512), mk::LDS_BYTES, stream, a);
    }
#endif
}
```

```cpp
#include <hip/hip_runtime.h>
#include <hip/hip_cooperative_groups.h>
#include <cstdio>
#include <cstdint>
namespace pg8 {
#define PG8_LAS __attribute__((address_space(3)))
typedef unsigned short bf16_t;
typedef short bf16x8 __attribute__((ext_vector_type(8)));
typedef float f32x4 __attribute__((ext_vector_type(4)));
typedef unsigned u32x4 __attribute__((ext_vector_type(4)));
constexpr int BM = 256, BK = 64, HALF = 128, HTB = HALF * BK * 2  , STAGE_BYTES = 8 * HTB, NXCD = 8, WGM = 8;

__host__ __device__ __forceinline__ int lds_byte(int r, int c) { const int st = (r >> 4) * 2 + (c >> 5), rr = r & 15, cc = c & 31, ob = rr * 64 + cc * 2; return st * 1024 + (ob ^ (((ob >> 9) & 1) << 5)); }
__host__ __device__ __forceinline__ void stage_rc(int b, int& R, int& C) { const int st = b / 1024, sb = b % 1024, swz = sb ^ (((sb >> 9) & 1) << 5); R = (st >> 1) * 16 + swz / 64; C = (st & 1) * 32 + (swz % 64) / 2; }
__host__ __device__ __forceinline__ int perm32(int rho) { const int n = rho >> 4, i = rho & 15; return 8 * (i >> 2) + 4 * n + (i & 3); }

struct Unit { int pm, pn; };
struct Gemm { const bf16_t* A; const bf16_t* Bt; int M, N, K, lda, ldb, bgrp; size_t bgrp_stride; };

struct StaticOrder {
    int nM, nN, nwg, G, c;
    __host__ __device__ void init(int M, int N, int G_, int c_) { nM = M / BM; nN = N / BM; nwg = nM * nN; G = G_; c = c_; }
    __host__ __device__ bool next(int i, Unit& u) const {
        const long L = (long)i * G + c; if (L >= nwg) return false;
        int wgid = (int)L; { const int q = nwg / NXCD, r = nwg % NXCD, xcd = wgid % NXCD, off = wgid / NXCD; wgid = (xcd < r ? xcd * (q + 1) : r * (q + 1) + (xcd - r) * q) + off; }
        const int nig = WGM * nN, gid = wgid / nig, fm = gid * WGM, gsz = (nM - fm) < WGM ? (nM - fm) : WGM;
        u.pm = fm + ((wgid % nig) % gsz); u.pn = (wgid % nig) / gsz; return true;
    }
    __device__ __forceinline__ void a_ready(const Unit&) const {}
    __device__ __forceinline__ void done(const Unit&) const {}
};

__device__ __forceinline__ unsigned cvt_pk_bf16(float lo, float hi) { unsigned r; asm volatile("v_cvt_pk_bf16_f32 %0, %1, %2" : "=v"(r) : "v"(lo), "v"(hi)); return r; }
__device__ __forceinline__ float bflo(unsigned w) { return __uint_as_float(w << 16); }
__device__ __forceinline__ float bfhi(unsigned w) { return __uint_as_float(w & 0xffff0000u); }
__device__ __forceinline__ float sigm(float x) { return __builtin_amdgcn_rcpf(1.0f + __expf(-x)); }
__device__ __forceinline__ float gelu_t(float x) { const float u = 1.5957691216f * (x + 0.044715f * x * x * x); return x * sigm(u); }
__device__ __forceinline__ u32x4 pack8(const f32x4 a, const f32x4 b) { u32x4 w; w.x = cvt_pk_bf16(a[0], a[1]); w.y = cvt_pk_bf16(a[2], a[3]); w.z = cvt_pk_bf16(b[0], b[1]); w.w = cvt_pk_bf16(b[2], b[3]); return w; }

constexpr int NLAT = 32768, NROWS = 36864, ZLD = 2048, NCH_S5 = 2304;

struct EpiInProj {
    static constexpr bool PERM = true, AFTER_DRAIN = false;
    bf16_t* Z; bf16_t* UH;
    __device__ __forceinline__ void operator()(const f32x4 (&acc)[2][2][4][2], const Unit& u, int wr, int wc, int fr, int fq) const {
#pragma unroll
        for (int ai = 0; ai < 2; ++ai)
#pragma unroll
            for (int m = 0; m < 4; ++m) { const int row = u.pm * BM + ai * HALF + wr * 64 + m * 16 + fr;
#pragma unroll
                for (int bj = 0; bj < 2; ++bj) { const u32x4 w = pack8(acc[ai][bj][m][0], acc[ai][bj][m][1]); const int cc = bj * HALF + wc * 32 + 8 * fq;
                    if (u.pn < 8) *(u32x4*)(Z + (size_t)row * ZLD + u.pn * BM + cc) = w;
                    else { const int g = cc >> 4, q0 = cc & 15; *(u32x4*)(UH + ((size_t)(g * NCH_S5 + (row >> 4)) * 512 + (row & 15) * 16 + q0)) = w; } } }
    }
};
struct EpiResGate {
    static constexpr bool PERM = false, AFTER_DRAIN = false;
    const float* srcL; const float* srcC; float* dstL; float* dstC; const float* gate; float alpha;
    __device__ __forceinline__ void operator()(const f32x4 (&acc)[2][2][4][2], const Unit& u, int wr, int wc, int fr, int fq) const {
        const int row0 = u.pm * BM; const bool lat = row0 < NLAT; const int mi = lat ? (row0 >> 11) : 16;
        const float* src = lat ? srcL + (size_t)row0 * 1024 : srcC + (size_t)(row0 - NLAT) * 1024; float* dst = lat ? dstL + (size_t)row0 * 1024 : dstC + (size_t)(row0 - NLAT) * 1024;
        const float* gp = gate + (size_t)mi * 6144;
#pragma unroll
        for (int bj = 0; bj < 2; ++bj)
#pragma unroll
            for (int n = 0; n < 2; ++n) { const int col = u.pn * BM + bj * HALF + wc * 32 + n * 16 + 4 * fq; const f32x4 gv = *(const f32x4*)(gp + col);
#pragma unroll
                for (int ai = 0; ai < 2; ++ai)
#pragma unroll
                    for (int m = 0; m < 4; ++m) { const size_t off = (size_t)(ai * HALF + wr * 64 + m * 16 + fr) * 1024 + col; const f32x4 x = *(const f32x4*)(src + off); *(f32x4*)(dst + off) = x * alpha + gv * acc[ai][bj][m][n]; } }
    }
};
struct EpiSwiGlu {
    static constexpr bool PERM = true, AFTER_DRAIN = false;
    bf16_t* ACT; int ldc;
    __device__ __forceinline__ void operator()(const f32x4 (&acc)[2][2][4][2], const Unit& u, int wr, int wc, int fr, int fq) const {
#pragma unroll
        for (int ai = 0; ai < 2; ++ai)
#pragma unroll
            for (int m = 0; m < 4; ++m) { const int row = u.pm * BM + ai * HALF + wr * 64 + m * 16 + fr; f32x4 o[2];
#pragma unroll
                for (int n = 0; n < 2; ++n)
#pragma unroll
                    for (int e = 0; e < 4; ++e) { const float g = acc[ai][0][m][n][e]; o[n][e] = g * sigm(g) * acc[ai][1][m][n][e]; }
                *(u32x4*)(ACT + (size_t)row * ldc + u.pn * HALF + wc * 32 + 8 * fq) = pack8(o[0], o[1]); }
    }
};
struct EpiF32 {
    static constexpr bool PERM = false, AFTER_DRAIN = false;
    float* O; int ldc;
    __device__ __forceinline__ void operator()(const f32x4 (&acc)[2][2][4][2], const Unit& u, int wr, int wc, int fr, int fq) const {
#pragma unroll
        for (int ai = 0; ai < 2; ++ai)
#pragma unroll
            for (int m = 0; m < 4; ++m) { const size_t ro = (size_t)(u.pm * BM + ai * HALF + wr * 64 + m * 16 + fr) * ldc;
#pragma unroll
                for (int bj = 0; bj < 2; ++bj)
#pragma unroll
                    for (int n = 0; n < 2; ++n) *(f32x4*)(O + ro + u.pn * BM + bj * HALF + wc * 32 + n * 16 + 4 * fq) = acc[ai][bj][m][n]; }
    }
};
struct EpiS5Y {
    static constexpr bool PERM = true, AFTER_DRAIN = false;
    const bf16_t* UH; const float* dsk; bf16_t* YS5;
    __device__ __forceinline__ void operator()(const f32x4 (&acc)[2][2][4][2], const Unit& u, int wr, int wc, int fr, int fq) const {
        const int g = (u.pm * BM) / NCH_S5;
#pragma unroll
        for (int bj = 0; bj < 2; ++bj) { const int col = bj * HALF + wc * 32 + 8 * fq, t = col >> 4, p0 = col & 15;
            const f32x4 d0 = *(const f32x4*)(dsk + g * 16 + p0), d1 = *(const f32x4*)(dsk + g * 16 + p0 + 4);
#pragma unroll
            for (int ai = 0; ai < 2; ++ai)
#pragma unroll
                for (int m = 0; m < 4; ++m) { const int row = u.pm * BM + ai * HALF + wr * 64 + m * 16 + fr, chunk = row - g * NCH_S5;
                    const u32x4 uw = *(const u32x4*)(UH + (size_t)row * 512 + col); f32x4 a = acc[ai][bj][m][0], b = acc[ai][bj][m][1];
                    a[0] += d0[0] * bflo(uw.x); a[1] += d0[1] * bfhi(uw.x); a[2] += d0[2] * bflo(uw.y); a[3] += d0[3] * bfhi(uw.y);
                    b[0] += d1[0] * bflo(uw.z); b[1] += d1[1] * bfhi(uw.z); b[2] += d1[2] * bflo(uw.w); b[3] += d1[3] * bfhi(uw.w);
#pragma unroll
                    for (int e = 0; e < 4; ++e) { a[e] = gelu_t(a[e]); b[e] = gelu_t(b[e]); }
                    *(u32x4*)(YS5 + (size_t)(chunk * 16 + t) * 256 + g * 16 + p0) = pack8(a, b); } }
    }
};
struct EpiGlu {
    static constexpr bool PERM = true, AFTER_DRAIN = false;
    const bf16_t* YS5; const float* gb; bf16_t* Y;
    __device__ __forceinline__ void operator()(const f32x4 (&acc)[2][2][4][2], const Unit& u, int wr, int wc, int fr, int fq) const {
#pragma unroll
        for (int bj = 0; bj < 2; ++bj) { const int col = bj * HALF + wc * 32 + 8 * fq; const f32x4 b0 = *(const f32x4*)(gb + col), b1 = *(const f32x4*)(gb + col + 4);
#pragma unroll
            for (int ai = 0; ai < 2; ++ai)
#pragma unroll
                for (int m = 0; m < 4; ++m) { const int row = u.pm * BM + ai * HALF + wr * 64 + m * 16 + fr; const u32x4 yw = *(const u32x4*)(YS5 + (size_t)row * 256 + col);
                    f32x4 a = acc[ai][bj][m][0] + b0, b = acc[ai][bj][m][1] + b1;
                    a[0] = bflo(yw.x) * sigm(a[0]); a[1] = bfhi(yw.x) * sigm(a[1]); a[2] = bflo(yw.y) * sigm(a[2]); a[3] = bfhi(yw.y) * sigm(a[3]);
                    b[0] = bflo(yw.z) * sigm(b[0]); b[1] = bfhi(yw.z) * sigm(b[1]); b[2] = bflo(yw.w) * sigm(b[2]); b[3] = bfhi(yw.w) * sigm(b[3]);
                    *(u32x4*)(Y + (size_t)row * 1024 + 768 + col) = pack8(a, b); } }
    }
};

template <class Epi, class Sched, bool ALIGN_EPI = false, bool SP2 = false>
__device__ __forceinline__ void gemm_phase(PG8_LAS unsigned char* lds, const Gemm g, const Sched& S, const Epi& E) {
    const int tid = threadIdx.x, wid = __builtin_amdgcn_readfirstlane(tid >> 6), lane = tid & 63, wr = wid >> 2, wc = wid & 3, fr = lane & 15, fq = lane >> 4;
    const int K = g.K, nt = K / BK;
    unsigned voffA[2], voffB[2];
#pragma unroll
    for (int i = 0; i < 2; ++i) { int R, C; stage_rc(tid * 16 + i * 8192, R, C); const int Rb = Epi::PERM ? ((R & ~31) + perm32(R & 31)) : R;
        voffA[i] = (unsigned)(R * g.lda + C) * 2u; voffB[i] = (unsigned)(Rb * g.ldb + C) * 2u; }
    const size_t kstep = (size_t)(BK * 2);
    const size_t hstepA = (size_t)HALF * g.lda * 2, hstepB = (size_t)HALF * g.ldb * 2;
    const size_t tstepA = 2 * hstepA, tstepB = 2 * hstepB;
#define PG8_ABASE(u) ((const char*)g.A + (size_t)(u).pm * tstepA)
#define PG8_BBASE(u) ((const char*)g.Bt + (size_t)(u).pn * tstepB + (g.bgrp ? (size_t)((u).pm / g.bgrp) * g.bgrp_stride : (size_t)0))
    const unsigned ldsw = (unsigned)wid * 1024u;
    const int aoff = lds_byte(wr * 64 + fr, fq * 8), boff = lds_byte(wc * 32 + fr, fq * 8);
#define PG8_SA(b, h) (((b) * 2 + (h)) * HTB)
#define PG8_SB(b, h) ((4 + (b) * 2 + (h)) * HTB)
#define PG8_STAGE(bufoff, gbase, voff) do { _Pragma("unroll") for (int _i = 0; _i < 2; ++_i) \
        __builtin_amdgcn_global_load_lds((const unsigned*)((const char*)(gbase) + (voff)[_i]), (PG8_LAS unsigned*)(lds + (bufoff) + ldsw + _i * 8192), 16, 0, 0); } while (0)
#define PG8_LDA(dst, b, h) do { _Pragma("unroll") for (int m = 0; m < 4; ++m) _Pragma("unroll") for (int k = 0; k < 2; ++k) dst[m][k] = *(const PG8_LAS bf16x8*)(lds + PG8_SA(b, h) + aoff + m * 2048 + k * 1024); } while (0)
#define PG8_LDB(dst, b, h) do { _Pragma("unroll") for (int n = 0; n < 2; ++n) _Pragma("unroll") for (int k = 0; k < 2; ++k) dst[n][k] = *(const PG8_LAS bf16x8*)(lds + PG8_SB(b, h) + boff + n * 2048 + k * 1024); } while (0)
#define PG8_MMA(ai, bj, At, Bt) do { __builtin_amdgcn_s_setprio(1); _Pragma("unroll") for (int m = 0; m < 4; ++m) _Pragma("unroll") for (int n = 0; n < 2; ++n) _Pragma("unroll") for (int k = 0; k < 2; ++k) \
        acc[ai][bj][m][n] = __builtin_amdgcn_mfma_f32_16x16x32_bf16(Bt[n][k], At[m][k], acc[ai][bj][m][n], 0, 0, 0); __builtin_amdgcn_s_setprio(0); } while (0)
#define PG8_WAIT_V(n) asm volatile("s_waitcnt vmcnt(" #n ")" ::: "memory")
#define PG8_WAIT_L(n) asm volatile("s_waitcnt lgkmcnt(" #n ")" ::: "memory")
#define PG8_BAR __builtin_amdgcn_s_barrier()
#define PG8_SCHED __builtin_amdgcn_sched_barrier(0)
    Unit cur, nxt; int ui = 0;
    if (!S.next(0, cur)) return;
    f32x4 acc[2][2][4][2];
#pragma unroll
    for (int a = 0; a < 2; ++a)
#pragma unroll
        for (int b = 0; b < 2; ++b)
#pragma unroll
            for (int m = 0; m < 4; ++m)
#pragma unroll
                for (int n = 0; n < 2; ++n) acc[a][b][m][n] = (f32x4){0.f, 0.f, 0.f, 0.f};
    bf16x8 At[4][2], B0[2][2], B1[2][2];
    const char* cA = PG8_ABASE(cur); const char* cB = PG8_BBASE(cur);
    S.a_ready(cur);
    if constexpr (SP2) {
        PG8_STAGE(PG8_SB(0, 0), cB, voffB); PG8_STAGE(PG8_SB(0, 1), cB + hstepB, voffB); PG8_STAGE(PG8_SA(0, 0), cA, voffA); PG8_STAGE(PG8_SA(0, 1), cA + hstepA, voffA);
        if (wr == 1) PG8_BAR;
        PG8_WAIT_V(2); PG8_BAR;
        PG8_STAGE(PG8_SB(1, 0), cB + kstep, voffB); PG8_STAGE(PG8_SA(1, 0), cA + kstep, voffA); PG8_STAGE(PG8_SB(1, 1), cB + hstepB + kstep, voffB);
        PG8_WAIT_V(6); PG8_BAR;
    } else {
        PG8_STAGE(PG8_SB(0, 0), cB, voffB); PG8_STAGE(PG8_SA(0, 0), cA, voffA); PG8_STAGE(PG8_SB(0, 1), cB + hstepB, voffB); PG8_STAGE(PG8_SA(0, 1), cA + hstepA, voffA);
        if (wr == 1) PG8_BAR;
        PG8_WAIT_V(4); PG8_BAR;
        PG8_STAGE(PG8_SB(1, 0), cB + kstep, voffB); PG8_STAGE(PG8_SA(1, 0), cA + kstep, voffA); PG8_STAGE(PG8_SB(1, 1), cB + hstepB + kstep, voffB);
        PG8_WAIT_V(6); PG8_BAR;
    }
    for (;;) {
        const bool has_next = S.next(ui + 1, nxt);
        const char* nA = has_next ? PG8_ABASE(nxt) : cA; const char* nB = has_next ? PG8_BBASE(nxt) : cB;
        for (int t = 0; t < nt; t += 2) {
            const bool last = (t == nt - 2);
            const char* a1 = cA + (size_t)(t + 1) * kstep;
            const char* a2 = last ? nA : cA + (size_t)(t + 2) * kstep; const char* b2 = last ? nB : cB + (size_t)(t + 2) * kstep;
            const char* a3 = a2 + kstep; const char* b3 = b2 + kstep;
            if (last && has_next) S.a_ready(nxt);
            if constexpr (SP2) {
            PG8_LDB(B0, 0, 0); PG8_LDB(B1, 0, 1); PG8_SCHED; PG8_LDA(At, 0, 0); PG8_STAGE(PG8_SA(1, 1), a1 + hstepA, voffA);
            PG8_WAIT_V(8); PG8_WAIT_L(0); PG8_BAR; PG8_MMA(0, 0, At, B0); PG8_MMA(0, 1, At, B1); PG8_BAR; PG8_SCHED;
            PG8_LDA(At, 0, 1); PG8_STAGE(PG8_SB(0, 0), b2, voffB); PG8_STAGE(PG8_SB(0, 1), b2 + hstepB, voffB); PG8_STAGE(PG8_SA(0, 0), a2, voffA);
            PG8_WAIT_V(8); PG8_WAIT_L(0); PG8_BAR; PG8_MMA(1, 0, At, B0); PG8_MMA(1, 1, At, B1); PG8_BAR; PG8_SCHED;
            PG8_LDB(B0, 1, 0); PG8_LDB(B1, 1, 1); PG8_SCHED; PG8_LDA(At, 1, 0); PG8_STAGE(PG8_SA(0, 1), a2 + hstepA, voffA);
            PG8_WAIT_V(8); PG8_WAIT_L(0); PG8_BAR; PG8_MMA(0, 0, At, B0); PG8_MMA(0, 1, At, B1); PG8_BAR; PG8_SCHED;
            PG8_LDA(At, 1, 1); PG8_STAGE(PG8_SB(1, 0), b3, voffB); PG8_STAGE(PG8_SB(1, 1), b3 + hstepB, voffB); PG8_STAGE(PG8_SA(1, 0), a3, voffA);
            PG8_WAIT_V(8); PG8_WAIT_L(0); PG8_BAR; PG8_MMA(1, 0, At, B0); PG8_MMA(1, 1, At, B1); PG8_BAR; PG8_SCHED;
            } else {
            PG8_LDB(B0, 0, 0); PG8_SCHED; PG8_LDA(At, 0, 0); PG8_STAGE(PG8_SA(1, 1), a1 + hstepA, voffA);
            PG8_WAIT_L(8); PG8_BAR; PG8_WAIT_L(0); PG8_MMA(0, 0, At, B0); PG8_BAR; PG8_SCHED;
            PG8_LDB(B1, 0, 1); PG8_STAGE(PG8_SB(0, 0), b2, voffB);
            PG8_BAR; PG8_WAIT_L(0); PG8_MMA(0, 1, At, B1); PG8_BAR;
            PG8_LDA(At, 0, 1); PG8_STAGE(PG8_SA(0, 0), a2, voffA);
            PG8_BAR; PG8_WAIT_L(0); PG8_MMA(1, 0, At, B0); PG8_BAR; PG8_SCHED;
            PG8_STAGE(PG8_SB(0, 1), b2 + hstepB, voffB);
            PG8_WAIT_V(6); PG8_BAR; PG8_MMA(1, 1, At, B1); PG8_BAR;
            PG8_LDB(B0, 1, 0); PG8_SCHED; PG8_LDA(At, 1, 0); PG8_STAGE(PG8_SA(0, 1), a2 + hstepA, voffA);
            PG8_WAIT_L(8); PG8_BAR; PG8_WAIT_L(0); PG8_MMA(0, 0, At, B0); PG8_BAR; PG8_SCHED;
            PG8_LDB(B1, 1, 1); PG8_STAGE(PG8_SB(1, 0), b3, voffB);
            PG8_BAR; PG8_WAIT_L(0); PG8_MMA(0, 1, At, B1); PG8_BAR;
            PG8_LDA(At, 1, 1); PG8_STAGE(PG8_SA(1, 0), a3, voffA);
            PG8_BAR; PG8_WAIT_L(0); PG8_MMA(1, 0, At, B0); PG8_BAR; PG8_SCHED;
            PG8_STAGE(PG8_SB(1, 1), b3 + hstepB, voffB);
            PG8_WAIT_V(6); PG8_BAR; PG8_MMA(1, 1, At, B1); PG8_BAR;
            }
        }
        if constexpr (ALIGN_EPI) { if (wr == 0) PG8_BAR; }
        if constexpr (!Epi::AFTER_DRAIN) { E(acc, cur, wr, wc, fr, fq); S.done(cur); }
        if (!has_next) break;
#pragma unroll
        for (int a = 0; a < 2; ++a)
#pragma unroll
            for (int b = 0; b < 2; ++b)
#pragma unroll
                for (int m = 0; m < 4; ++m)
#pragma unroll
                    for (int n = 0; n < 2; ++n) acc[a][b][m][n] = (f32x4){0.f, 0.f, 0.f, 0.f};
        cur = nxt; cA = nA; cB = nB; ++ui;
        if constexpr (ALIGN_EPI) { if (wr == 1) PG8_BAR; }
    }
    PG8_WAIT_V(0);
    if constexpr (!ALIGN_EPI) { if (wr == 0) PG8_BAR; }
    PG8_BAR;
    if constexpr (Epi::AFTER_DRAIN) { E.fused(acc, cur, wr, wc, fr, fq, lds, wid, lane); S.done(cur); }
#undef PG8_ABASE
#undef PG8_BBASE
#undef PG8_SA
#undef PG8_SB
#undef PG8_STAGE
#undef PG8_LDA
#undef PG8_LDB
#undef PG8_MMA
#undef PG8_WAIT_V
#undef PG8_WAIT_L
#undef PG8_BAR
#undef PG8_SCHED
}
}

#ifndef MK_ONE_LAUNCH
#define MK_ONE_LAUNCH 1
#endif
namespace mk {
using namespace pg8;
#define LAS __attribute__((address_space(3)))
constexpr int D = 1024, NB = 16, SEQ = 2048, CTXL = 256, DFF = 2816, PIN = 2320, NPH = 22;
constexpr float ALPHA = 1.41421356237309515f, LN_EPS = 1e-5f;
constexpr size_t MiB = 1u << 20;
constexpr size_t WS_CTL = 0, WS_MOD = 1 * MiB, WS_WT = 2 * MiB, WT_LAYER = 30 * MiB;
constexpr size_t WT_IN = 0, WT_OUT = 9 * MiB / 2, WT_FFIN = 13 * MiB / 2, WT_FFOUT = 35 * MiB / 2, WT_GLU = 23 * MiB, WT_BTY = 93 * MiB / 4, WT_BTS = 109 * MiB / 4;
constexpr size_t WS_GATES = 62 * MiB, WS_XC = 65 * MiB, WS_HY = 81 * MiB, WS_Z = 153 * MiB, WS_ACT = 153 * MiB, WS_UH = 297 * MiB, WS_MST = 333 * MiB, WS_YS5 = 369 * MiB,
                 WS_S5S = 387 * MiB, WS_MISC = 423 * MiB, WS_HSUM = 427 * MiB, WS_Y32 = 463 * MiB, WS_END = 499 * MiB;
constexpr int LDS_BYTES = 147456;

struct Args { const float* in[34]; float* out; unsigned char* ws; int ph_lo, ph_hi; };
enum { I_X = 0, I_C, I_CTX, I_CCTX, I_WMOD, I_BMOD, I_WIN, I_GBIAS, I_MNORM, I_SLNW, I_SLNB, I_SW, I_SB, I_CW, I_CB, I_CLNW, I_CLNB, I_ARE, I_AIM, I_LDT, I_BRE, I_BIM, I_CRE, I_CIM, I_DSK, I_GLUW, I_GLUB,
       I_WOUT, I_LN1W, I_LN1B, I_WFFIN, I_WFFOUT, I_LN2W, I_LN2B };

struct Ctx { LAS unsigned char* lds; int tid, lane, wave, bid, G; const float* const* in; float* out; unsigned char* ws; };

__device__ __forceinline__ float bf2f(bf16_t h) { return __uint_as_float((unsigned)h << 16); }
__device__ __forceinline__ unsigned f2bf(float f) { unsigned u = __float_as_uint(f); return (u + 0x7fffu + ((u >> 16) & 1u)) >> 16; }
__device__ __forceinline__ unsigned pk2(float lo, float hi) { return f2bf(lo) | (f2bf(hi) << 16); }
__device__ __forceinline__ float wave_sum(float v) {
#pragma unroll
    for (int o = 1; o < 64; o <<= 1) v += __shfl_xor(v, o);
    return v;
}
__device__ __forceinline__ float logsig(float x) { return fminf(x, 0.f) - log1pf(expf(-fabsf(x))); }
__device__ __forceinline__ int chain_row(int b, int dir, int j) {
    if (j < CTXL) { const int t = dir ? CTXL - 1 - j : j; return NLAT + b * CTXL + t; }
    int t = j - CTXL; t = dir ? SEQ - 1 - t : t; return b * SEQ + t;
}
#define LDS_WAIT() asm volatile("s_waitcnt lgkmcnt(0)" ::: "memory")

__device__ __forceinline__ void s5_table_item(const Ctx& C, int l, int g, int part);
__device__ __forceinline__ void transpose_item(const float* W, int ldw, int col0, bf16_t* WT, int K, int drow0, int k0, LAS float* scr, int lane) {
#pragma unroll 8
    for (int i = 0; i < 32; ++i) { const int kk = 2 * i + (lane >> 5); scr[kk * 33 + (lane & 31)] = W[(size_t)(k0 + kk) * ldw + col0 + (lane & 31)]; }
    LDS_WAIT(); asm volatile("" ::: "memory");
    const int c = lane & 7;
#pragma unroll
    for (int j = 0; j < 4; ++j) { const int n = (lane >> 3) + 8 * j; const LAS float* s = scr + (8 * c) * 33 + n;
        u32x4 o; o.x = pk2(s[0 * 33], s[1 * 33]); o.y = pk2(s[2 * 33], s[3 * 33]); o.z = pk2(s[4 * 33], s[5 * 33]); o.w = pk2(s[6 * 33], s[7 * 33]);
        *(u32x4*)(WT + (size_t)(drow0 + n) * K + k0 + 8 * c) = o; }
    LDS_WAIT(); asm volatile("" ::: "memory");
}
__device__ __forceinline__ void p_prologue(const Ctx& C) {
    LAS float* scr = (LAS float*)(C.lds + C.wave * 8448);
    const int gw = C.bid * 8 + C.wave, NGW = C.G * 8;
    constexpr int N_IN = 16 * 72, N_OUT = 16 * 32, N_FI = 16 * 176, N_FO = 44 * 32, N_GL = 4 * 8, N_L = N_IN + N_OUT + N_FI + N_FO + N_GL;
    for (int it = gw; it < 2 * N_L; it += NGW) {
        const int l = it / N_L; int r = it % N_L; unsigned char* wt = C.ws + WS_WT + (size_t)l * WT_LAYER;
        if (r < N_IN) { const int kb = r / 72, nb = r % 72; transpose_item(C.in[I_WIN] + (size_t)l * D * PIN, PIN, nb * 32 + (nb >= 32 ? 16 : 0), (bf16_t*)(wt + WT_IN), D, nb * 32, kb * 64, scr, C.lane); continue; } r -= N_IN;
        if (r < N_OUT) { const int kb = r / 32, nb = r % 32; transpose_item(C.in[I_WOUT] + (size_t)l * D * D, D, nb * 32, (bf16_t*)(wt + WT_OUT), D, nb * 32, kb * 64, scr, C.lane); continue; } r -= N_OUT;
        if (r < N_FI) { const int kb = r / 176, nb = r % 176, dr = nb * 32, pn = dr >> 8, bj = (dr >> 7) & 1, jj = dr & 127;
            transpose_item(C.in[I_WFFIN] + (size_t)l * D * 2 * DFF, 2 * DFF, bj * DFF + pn * 128 + jj, (bf16_t*)(wt + WT_FFIN), D, dr, kb * 64, scr, C.lane); continue; } r -= N_FI;
        if (r < N_FO) { const int kb = r / 32, nb = r % 32; transpose_item(C.in[I_WFFOUT] + (size_t)l * DFF * D, D, nb * 32, (bf16_t*)(wt + WT_FFOUT), DFF, nb * 32, kb * 64, scr, C.lane); continue; } r -= N_FO;
        { const int kb = r / 8, nb = r % 8; transpose_item(C.in[I_GLUW] + (size_t)l * 65536, 256, nb * 32, (bf16_t*)(wt + WT_GLU), 256, nb * 32, kb * 64, scr, C.lane); }
    }
    __syncthreads();
    LAS float* sc = (LAS float*)C.lds; LAS float* red = (LAS float*)(C.lds + 69632);
    if (C.bid < 192) {
        for (int idx = C.tid; idx < 17 * 1024; idx += 512) { const int i = idx >> 10, k = idx & 1023; const float v = i < 16 ? C.in[I_C][i * 1024 + k] : C.in[I_CCTX][k]; sc[idx] = v / (1.0f + expf(-v)); }
        __syncthreads();
        float* MOD = (float*)(C.ws + WS_MOD);
        for (int item = C.bid; item < 192; item += C.G) {
            const int l = item / 96, j = (item % 96) * 64 + C.lane; const float* w = C.in[I_WMOD] + (size_t)l * D * 6144 + j;
            float acc[17];
#pragma unroll
            for (int i = 0; i < 17; ++i) acc[i] = 0.f;
            for (int k = C.wave * 128; k < C.wave * 128 + 128; ++k) { const float wv = w[(size_t)k * 6144];
#pragma unroll
                for (int i = 0; i < 17; ++i) acc[i] += sc[i * 1024 + k] * wv; }
#pragma unroll
            for (int i = 0; i < 17; ++i) red[(C.wave * 17 + i) * 64 + C.lane] = acc[i];
            __syncthreads();
            for (int i = C.wave; i < 17; i += 8) { float s = 0.f;
#pragma unroll
                for (int w8 = 0; w8 < 8; ++w8) s += red[(w8 * 17 + i) * 64 + C.lane];
                MOD[(size_t)(l * 17 + i) * 6144 + j] = s + C.in[I_BMOD][l * 6144 + j]; }
            __syncthreads();
        }
    }
    __syncthreads();
    for (int it = C.bid; it < 256; it += C.G) s5_table_item(C, it >> 7, (it >> 3) & 15, it & 7);
}

__device__ __forceinline__ void p_rowpass(const Ctx& C, int mode, int l) {
    const bool doLN = mode != 0, doH = !(mode == 2 && l == 1), doG = (mode == 0) || (mode == 2 && l == 0);
    const int nrows = (mode == 0 || l == 0) ? NROWS : NLAT;
    const int lm = (mode == 2) ? l + 1 : l;
    const float* MOD = (const float*)(C.ws + WS_MOD) + (size_t)(lm < 2 ? lm : 1) * 17 * 6144; const int osh = (mode == 1) ? 3072 : 0, osc = (mode == 1) ? 4096 : 1024;
    const float* lnw = C.in[mode == 1 ? I_LN1W : I_LN2W] + l * D; const float* lnb = C.in[mode == 1 ? I_LN1B : I_LN2B] + l * D;
    LAS float* wgT = (LAS float*)C.lds;
    if (doG) { const float* wg = C.in[I_WIN] + (size_t)lm * D * PIN + 1024;
        for (int idx = C.tid; idx < 16 * 1024; idx += 512) { const int k = idx >> 4, gi = idx & 15; wgT[gi * 1024 + k] = wg[(size_t)k * PIN + gi]; }
        __syncthreads(); }
    bf16_t* H = (bf16_t*)(C.ws + WS_HY); float* XC = (float*)(C.ws + WS_XC); float* GT = (float*)(C.ws + WS_GATES);
    for (int row = C.bid * 8 + C.wave; row < nrows; row += C.G * 8) {
        const bool lat = row < NLAT; const int mi = lat ? (row >> 11) : 16;
        float* xrow = lat ? C.out + (size_t)row * D : XC + (size_t)(row - NLAT) * D;
        const float* src = (mode == 0) ? (lat ? C.in[I_X] + (size_t)row * D : C.in[I_CTX] + (size_t)(row - NLAT) * D) : xrow;
        f32x4 v[4];
#pragma unroll
        for (int j = 0; j < 4; ++j) v[j] = *(const f32x4*)(src + 4 * C.lane + 256 * j);
        if (doLN) {
            float s = 0.f;
#pragma unroll
            for (int j = 0; j < 4; ++j) s += (v[j][0] + v[j][1]) + (v[j][2] + v[j][3]);
            const float mean = wave_sum(s) * (1.0f / D); float q = 0.f;
#pragma unroll
            for (int j = 0; j < 4; ++j) { v[j] = v[j] - mean; q += (v[j][0] * v[j][0] + v[j][1] * v[j][1]) + (v[j][2] * v[j][2] + v[j][3] * v[j][3]); }
            const float rstd = 1.0f / sqrtf(wave_sum(q) * (1.0f / D) + LN_EPS);
#pragma unroll
            for (int j = 0; j < 4; ++j) { const f32x4 w = *(const f32x4*)(lnw + 4 * C.lane + 256 * j), b = *(const f32x4*)(lnb + 4 * C.lane + 256 * j); v[j] = v[j] * rstd * w + b; *(f32x4*)(xrow + 4 * C.lane + 256 * j) = v[j]; }
        }
        if (doH) {
            const float* mp = MOD + (size_t)mi * 6144;
#pragma unroll
            for (int j = 0; j < 4; ++j) { const f32x4 sh = *(const f32x4*)(mp + osh + 4 * C.lane + 256 * j), scv = *(const f32x4*)(mp + osc + 4 * C.lane + 256 * j); v[j] = v[j] * (scv + 1.0f) + sh;
                unsigned long long o = (unsigned long long)pk2(v[j][0], v[j][1]) | ((unsigned long long)pk2(v[j][2], v[j][3]) << 32); *(unsigned long long*)(H + (size_t)row * D + 4 * C.lane + 256 * j) = o; }
            if (doG) {
                float keep = 0.f;
#pragma unroll 1
                for (int gi = 0; gi < 16; ++gi) { float p = 0.f;
#pragma unroll
                    for (int j = 0; j < 4; ++j) { const f32x4 w = *(const LAS f32x4*)(wgT + gi * 1024 + 4 * C.lane + 256 * j); p += (v[j][0] * w[0] + v[j][1] * w[1]) + (v[j][2] * w[2] + v[j][3] * w[3]); }
                    p = wave_sum(p); if (C.lane == gi) keep = p; }
                if (C.lane < 16) GT[(size_t)row * 16 + C.lane] = keep + C.in[I_GBIAS][lm * 16 + C.lane];
            }
        }
    }
}
__device__ __forceinline__ void nv_mlstm_chain(const Ctx& C, int b, int hd, int dir) {
    const bf16_t* Z = (const bf16_t*)(C.ws + WS_Z); const float* GT = (const float*)(C.ws + WS_GATES); float* HS = (float*)(C.ws + WS_HSUM);
    LAS float* qkv = (LAS float*)C.lds; LAS float* red = qkv + 192;
    const int tid = C.tid, vrow = tid >> 3, k0 = (tid & 7) * 8;
    float Cst[8]; for (int e = 0; e < 8; ++e) Cst[e] = 0.f;
    float nk = 0.f, m = 0.f, r0 = 0.f, ig_n, fg_n; int row_n;
#define NV_LOAD(j) do { const int row_ = chain_row(b, dir, (j)); row_n = row_; const bf16_t* zr = Z + (size_t)row_ * ZLD + hd * 64; \
        if (tid < 64) r0 = bf2f(zr[tid]); else if (tid < 128) r0 = bf2f(zr[256 + tid - 64]) * 0.125f; else if (tid < 192) r0 = bf2f(zr[512 + tid - 128]); \
        ig_n = GT[(size_t)row_ * 16 + dir * 8 + hd]; fg_n = GT[(size_t)row_ * 16 + dir * 8 + 4 + hd]; } while (0)
    NV_LOAD(0);
    for (int j = 0; j < CTXL + SEQ; ++j) {
        if (tid < 192) qkv[tid] = r0;
        const float ig = ig_n, lf = logsig(fg_n); const int row = row_n;
        __syncthreads();
        if (j + 1 < CTXL + SEQ) NV_LOAD(j + 1);
        const float mn = fmaxf(lf + m, ig), fdec = expf(lf + m - mn), iw = expf(ig - mn);
        if (tid < 64) { nk = fdec * nk + iw * qkv[64 + tid]; const float d = wave_sum(nk * qkv[tid]); if (tid == 0) red[0] = d; }
        const float vv = qkv[128 + vrow] * iw; float part = 0.f;
#pragma unroll
        for (int e = 0; e < 8; ++e) { Cst[e] = fdec * Cst[e] + vv * qkv[64 + k0 + e]; part += Cst[e] * qkv[k0 + e]; }
        part += __shfl_xor(part, 1); part += __shfl_xor(part, 2); part += __shfl_xor(part, 4);
        __syncthreads();
        const float den = red[0], h = part / fmaxf(fabsf(den), expf(-mn));
        if ((tid & 7) == 0) { float* hp = HS + (size_t)row * 256 + hd * 64 + vrow; if (dir) *hp += h; else *hp = h; }
        m = mn;
    }
#undef NV_LOAD
    __syncthreads();
}
__device__ __forceinline__ void nv_s5_item(const Ctx& C, int l, int b, int gh, int dir) {
    const bf16_t* UH = (const bf16_t*)(C.ws + WS_UH); float* Y32 = (float*)(C.ws + WS_Y32);
    const int g = gh * 8 + C.wave, n = C.lane;
    LAS float* base = (LAS float*)(C.lds + C.wave * 17920);
    LAS float* xr = base; LAS float* xi = base + 16 * 65; LAS float* cre = base + 2 * 16 * 65; LAS float* cim = cre + 1024; LAS float* us = cim + 1024;
    const float are = C.in[I_ARE][((l * 2 + dir) * 16 + g) * 64 + n], aim = C.in[I_AIM][((l * 2 + dir) * 16 + g) * 64 + n], dt = expf(C.in[I_LDT][(l * 2 + dir) * 16 + g]);
    const float mag = expf(are * dt), abr = mag * cosf(aim * dt), abi = mag * sinf(aim * dt), d2 = are * are + aim * aim;
    const float cr = ((abr - 1.f) * are + abi * aim) / d2, ci = (abi * are - (abr - 1.f) * aim) / d2;
    float br[16], bi[16];
#pragma unroll
    for (int q = 0; q < 16; ++q) { const float re = C.in[I_BRE][((size_t)(l * 16 + g) * 64 + n) * 16 + q], im = C.in[I_BIM][((size_t)(l * 16 + g) * 64 + n) * 16 + q]; br[q] = cr * re - ci * im; bi[q] = cr * im + ci * re; }
    for (int p = 0; p < 16; ++p) { cre[n * 16 + p] = C.in[I_CRE][((size_t)(l * 16 + g) * 16 + p) * 64 + n]; cim[n * 16 + p] = C.in[I_CIM][((size_t)(l * 16 + g) * 16 + p) * 64 + n]; }
    float sr = 0.f, si = 0.f;
    const int t_ = n >> 2, p0 = (n & 3) * 4;
    const f32x4 dv = *(const f32x4*)(C.in[I_DSK] + l * 256 + g * 16 + p0);
    for (int j0 = 0; j0 < CTXL + SEQ; j0 += 16) {
        { const int s = n >> 2, q0 = (n & 3) * 4, row = chain_row(b, dir, j0 + s); const bf16_t* up = UH + ((size_t)(g * NCH_S5 + (row >> 4)) * 512 + (row & 15) * 16 + q0);
#pragma unroll
          for (int e = 0; e < 4; ++e) us[s * 16 + q0 + e] = bf2f(up[e]); }
        __syncthreads();
        for (int s = 0; s < 16; ++s) { float bur = 0.f, bui = 0.f;
#pragma unroll
            for (int q = 0; q < 16; ++q) { const float uv = us[s * 16 + q]; bur += br[q] * uv; bui += bi[q] * uv; }
            const float nr = abr * sr - abi * si + bur, ni = abr * si + abi * sr + bui; sr = nr; si = ni; xr[s * 65 + n] = sr; xi[s * 65 + n] = si; }
        __syncthreads();
        f32x4 acc = {0.f, 0.f, 0.f, 0.f};
        for (int nn = 0; nn < 64; ++nn) { const float a = xr[t_ * 65 + nn], bq = xi[t_ * 65 + nn]; const f32x4 c1 = *(const LAS f32x4*)(cre + nn * 16 + p0), c2 = *(const LAS f32x4*)(cim + nn * 16 + p0); acc += c1 * a - c2 * bq; }
        const int row = chain_row(b, dir, j0 + t_); float* yp = Y32 + (size_t)row * 256 + g * 16 + p0;
        if (dir == 0) { f32x4 uu; uu[0] = us[t_ * 16 + p0]; uu[1] = us[t_ * 16 + p0 + 1]; uu[2] = us[t_ * 16 + p0 + 2]; uu[3] = us[t_ * 16 + p0 + 3]; *(f32x4*)yp = acc + dv * uu; }
        else { const f32x4 o = *(const f32x4*)yp; *(f32x4*)yp = o + acc; }
        __syncthreads();
    }
}
__device__ __forceinline__ void nv_glu_item(const Ctx& C, int l, int item) {
    const float* Y32 = (const float*)(C.ws + WS_Y32); bf16_t* Y = (bf16_t*)(C.ws + WS_HY); LAS float* ys = (LAS float*)C.lds;
    const int r0 = item * 32;
    for (int idx = C.tid; idx < 32 * 256; idx += 512) ys[idx] = gelu_t(Y32[(size_t)r0 * 256 + idx]);
    __syncthreads();
    const int c = C.tid & 255, th = C.tid >> 8; const float* w = C.in[I_GLUW] + (size_t)l * 65536 + c;
    float acc[16];
#pragma unroll
    for (int t = 0; t < 16; ++t) acc[t] = 0.f;
    for (int k = 0; k < 256; ++k) { const float wv = w[k * 256];
#pragma unroll
        for (int t = 0; t < 16; ++t) acc[t] += ys[(th * 16 + t) * 256 + k] * wv; }
    const float gb = C.in[I_GLUB][l * 256 + c];
#pragma unroll
    for (int t = 0; t < 16; ++t) { const int rr = th * 16 + t; Y[(size_t)(r0 + rr) * D + 768 + c] = (bf16_t)f2bf(ys[rr * 256 + c] * sigm(acc[t] + gb)); }
    __syncthreads();
}
__device__ __forceinline__ void nv_readout_row(const Ctx& C, int l, int row) {
    const float* HS = (const float*)(C.ws + WS_HSUM); const bf16_t* Z = (const bf16_t*)(C.ws + WS_Z); bf16_t* Y = (bf16_t*)(C.ws + WS_HY);
    const int ch = 4 * C.lane; f32x4 h = *(const f32x4*)(HS + (size_t)row * 256 + ch);
    float s = (h[0] + h[1]) + (h[2] + h[3]); s += __shfl_xor(s, 1); s += __shfl_xor(s, 2); s += __shfl_xor(s, 4); s += __shfl_xor(s, 8);
    const float mu = s * (1.0f / 64.0f); h = h - mu; float q = (h[0] * h[0] + h[1] * h[1]) + (h[2] * h[2] + h[3] * h[3]); q += __shfl_xor(q, 1); q += __shfl_xor(q, 2); q += __shfl_xor(q, 4); q += __shfl_xor(q, 8);
    const float rstd = 1.0f / sqrtf(q * (1.0f / 64.0f) + LN_EPS); const f32x4 nw = *(const f32x4*)(C.in[I_MNORM] + l * 256 + ch);
    const unsigned long long ow = *(const unsigned long long*)(Z + (size_t)row * ZLD + 768 + ch); const unsigned o0 = (unsigned)ow, o1 = (unsigned)(ow >> 32);
    const float y0 = h[0] * rstd * nw[0] * sigm(bflo(o0)), y1 = h[1] * rstd * nw[1] * sigm(bfhi(o0)), y2 = h[2] * rstd * nw[2] * sigm(bflo(o1)), y3 = h[3] * rstd * nw[3] * sigm(bfhi(o1));
    *(unsigned long long*)(Y + (size_t)row * D + ch) = (unsigned long long)pk2(y0, y1) | ((unsigned long long)pk2(y2, y3) << 32);
}
__device__ __forceinline__ void sgu_item(const Ctx& C, int l, int ci) {
    const bf16_t* Z = (const bf16_t*)(C.ws + WS_Z); bf16_t* Y = (bf16_t*)(C.ws + WS_HY); LAS float* V = (LAS float*)C.lds;
    const int r0 = ci < 256 ? ci * 128 : NLAT + (ci - 256) * 128;
    { const int ch = 4 * C.lane; const f32x4 lw = *(const f32x4*)(C.in[I_SLNW] + l * 256 + ch), lb = *(const f32x4*)(C.in[I_SLNB] + l * 256 + ch);
      for (int s = C.wave; s < 128; s += 8) {
        const unsigned long long zw = *(const unsigned long long*)(Z + (size_t)(r0 + s) * ZLD + 1280 + ch); const unsigned z0 = (unsigned)zw, z1 = (unsigned)(zw >> 32);
        f32x4 v = {gelu_t(bflo(z0)), gelu_t(bfhi(z0)), gelu_t(bflo(z1)), gelu_t(bfhi(z1))};
        const float mu = wave_sum((v[0] + v[1]) + (v[2] + v[3])) * (1.0f / 256.0f); v = v - mu;
        const float rstd = 1.0f / sqrtf(wave_sum((v[0] * v[0] + v[1] * v[1]) + (v[2] * v[2] + v[3] * v[3])) * (1.0f / 256.0f) + LN_EPS);
        *(LAS f32x4*)(V + s * 256 + ch) = v * rstd * lw + lb; } }
    __syncthreads();
    const int ch = C.tid & 255, g = __builtin_amdgcn_readfirstlane(C.wave & 3), th = __builtin_amdgcn_readfirstlane(C.wave >> 2);
    const float* ws = C.in[I_SW] + (size_t)(l * 4 + g) * 128 * 128; const float* bs = C.in[I_SB] + (l * 4 + g) * 128;
    for (int tb = 0; tb < 4; ++tb) { const int t0 = th * 64 + tb * 16; float acc[16];
#pragma unroll
        for (int t = 0; t < 16; ++t) acc[t] = 0.f;
        for (int s = 0; s < 128; s += 4) { const float v0 = V[s * 256 + ch], v1 = V[(s + 1) * 256 + ch], v2 = V[(s + 2) * 256 + ch], v3 = V[(s + 3) * 256 + ch];
#pragma unroll
            for (int t = 0; t < 16; ++t) { const f32x4 w = *(const f32x4*)(ws + (t0 + t) * 128 + s); acc[t] += (w[0] * v0 + w[1] * v1) + (w[2] * v2 + w[3] * v3); } }
#pragma unroll
        for (int t = 0; t < 16; ++t) { const int row = r0 + t0 + t; const float u = gelu_t(bf2f(Z[(size_t)row * ZLD + 1024 + ch])); Y[(size_t)row * D + 256 + ch] = (bf16_t)f2bf(u * (acc[t] + bs[t0 + t])); } }
    __syncthreads();
}
__device__ __forceinline__ void conv_item(const Ctx& C, int l, int ti) {
    const bf16_t* Z = (const bf16_t*)(C.ws + WS_Z); bf16_t* Y = (bf16_t*)(C.ws + WS_HY); LAS float* A = (LAS float*)C.lds;
    int r0, seg_lo, seg_len; if (ti < 512) { r0 = ti * 64; seg_lo = 0; seg_len = 64; } else { const int b = (ti - 512) >> 2, tq = (ti - 512) & 3; r0 = NLAT + b * 256 + tq * 64; seg_lo = tq * 64; seg_len = 256; }
    { const int ch = 4 * (C.tid & 63);
      for (int a = C.tid >> 6; a < 94; a += 8) { const int ts = seg_lo + a - 15; f32x4 v = {0.f, 0.f, 0.f, 0.f};
        if (ts >= 0 && ts < seg_len) { const bf16_t* zr = Z + (size_t)(r0 + a - 15) * ZLD + 1536 + ch; const unsigned long long vw = *(const unsigned long long*)zr, gw = *(const unsigned long long*)(zr + 256);
            const unsigned v0 = (unsigned)vw, v1 = (unsigned)(vw >> 32), g0 = (unsigned)gw, g1 = (unsigned)(gw >> 32);
            v[0] = bflo(v0) * sigm(bflo(g0)); v[1] = bfhi(v0) * sigm(bfhi(g0)); v[2] = bflo(v1) * sigm(bflo(g1)); v[3] = bfhi(v1) * sigm(bfhi(g1)); }
        *(LAS f32x4*)(A + a * 256 + ch) = v; } }
    __syncthreads();
    const int ch = C.tid & 255, th = C.tid >> 8; float o[32];
    { const float* cw = C.in[I_CW] + (size_t)l * 31 * 256 + ch; const float cb = C.in[I_CB][l * 256 + ch];
#pragma unroll
      for (int t = 0; t < 32; ++t) o[t] = cb;
      for (int j = 0; j < 31; ++j) { const float w = cw[j * 256];
#pragma unroll
        for (int t = 0; t < 32; ++t) o[t] += w * A[(th * 32 + t + j) * 256 + ch]; } }
    __syncthreads();
#pragma unroll
    for (int t = 0; t < 32; ++t) A[(th * 32 + t) * 256 + ch] = o[t];
    __syncthreads();
    { const int c4 = 4 * C.lane; const f32x4 lw = *(const f32x4*)(C.in[I_CLNW] + l * 256 + c4), lb = *(const f32x4*)(C.in[I_CLNB] + l * 256 + c4);
      for (int t = C.wave; t < 64; t += 8) { f32x4 v = *(const LAS f32x4*)(A + t * 256 + c4);
        const float mu = wave_sum((v[0] + v[1]) + (v[2] + v[3])) * (1.0f / 256.0f); v = v - mu;
        const float rstd = 1.0f / sqrtf(wave_sum((v[0] * v[0] + v[1] * v[1]) + (v[2] * v[2] + v[3] * v[3])) * (1.0f / 256.0f) + LN_EPS);
        v = v * rstd * lw + lb; const float y0 = v[0] * sigm(v[0]), y1 = v[1] * sigm(v[1]), y2 = v[2] * sigm(v[2]), y3 = v[3] * sigm(v[3]);
        *(unsigned long long*)(Y + (size_t)(r0 + t) * D + 512 + c4) = (unsigned long long)pk2(y0, y1) | ((unsigned long long)pk2(y2, y3) << 32); } }
    __syncthreads();
}
constexpr size_t MSN_OFF = 0, MSS_OFF = 2 * MiB, MSM_OFF = 3 * MiB;
__device__ __forceinline__ int ml_row0(int b, int c) { return c < 32 ? b * SEQ + 64 * c : NLAT + b * CTXL + 64 * (c - 32); }
__device__ __forceinline__ int ml_jf(int c) { return c < 32 ? 4 + c : c - 32; }
__device__ __forceinline__ int ml_jb(int c) { return c < 32 ? 35 - c : 35 - c; }
template <int K> __device__ __forceinline__ void lds_mma(f32x4& acc, const LAS bf16_t* A, int lda, const LAS bf16_t* B, int ldb, int lane) {
    const LAS bf16_t* ap = A + (lane & 15) * lda + 8 * (lane >> 4); const LAS bf16_t* bp = B + (lane & 15) * ldb + 8 * (lane >> 4);
#pragma unroll
    for (int k = 0; k < K; k += 32) { const bf16x8 a = *(const LAS bf16x8*)(ap + k), b = *(const LAS bf16x8*)(bp + k); acc = __builtin_amdgcn_mfma_f32_16x16x32_bf16(a, b, acc, 0, 0, 0); }
}
__device__ __forceinline__ float scan_add(float v, int lane) {
#pragma unroll
    for (int o = 1; o < 64; o <<= 1) { const float t = __shfl_up(v, o); if (lane >= o) v += t; }
    return v;
}
__device__ __forceinline__ float scan_max(float v, int lane) {
#pragma unroll
    for (int o = 1; o < 64; o <<= 1) { const float t = __shfl_up(v, o); if (lane >= o) v = fmaxf(v, t); }
    return v;
}
__device__ __forceinline__ float wave_max(float v) {
#pragma unroll
    for (int o = 1; o < 64; o <<= 1) v = fmaxf(v, __shfl_xor(v, o));
    return v;
}
constexpr int TS = 72;

__device__ __forceinline__ void ml_state_item(const Ctx& C, int b, int hd, int c) {
    const bf16_t* Z = (const bf16_t*)(C.ws + WS_Z); const float* GT = (const float*)(C.ws + WS_GATES);
    bf16_t* MST = (bf16_t*)(C.ws + WS_MST); float* MSN = (float*)(C.ws + WS_MISC + MSN_OFF); float* MSS = (float*)(C.ws + WS_MISC + MSS_OFF);
    LAS bf16_t* KT = (LAS bf16_t*)C.lds;
    LAS bf16_t* VE = KT + 64 * TS;
    LAS float* ef = (LAS float*)(VE + 144 * TS); LAS float* eb = ef + 64;
    const int r0 = ml_row0(b, c), tid = C.tid, lane = C.lane;
    const int s = tid >> 3, c8 = 8 * (tid & 7);
    const u32x4 kw = *(const u32x4*)(Z + (size_t)(r0 + s) * ZLD + 256 + hd * 64 + c8), vw = *(const u32x4*)(Z + (size_t)(r0 + s) * ZLD + 512 + hd * 64 + c8);
    if (C.wave < 2) { const int dir = C.wave, tok = dir ? 63 - lane : lane;
        const float ig = GT[(size_t)(r0 + tok) * 16 + dir * 8 + hd], lf = logsig(GT[(size_t)(r0 + tok) * 16 + dir * 8 + 4 + hd]);
        const float bb = scan_add(lf, lane), bend = __shfl(bb, 63), lu = bend - bb + ig, ml = wave_max(lu);
        (dir ? eb : ef)[tok] = expf(lu - ml);
        if (lane == 0) { const int chain = (b * 4 + hd) * 2 + dir, j = dir ? ml_jb(c) : ml_jf(c); MSS[(chain * 36 + j) * 2] = ml; MSS[(chain * 36 + j) * 2 + 1] = bend; } }
    for (int idx = tid; idx < 14 * TS; idx += 512) VE[130 * TS + idx] = 0;
    __syncthreads();
    { const float e0 = ef[s], e1 = eb[s]; const unsigned kk[4] = {kw.x, kw.y, kw.z, kw.w}, vv[4] = {vw.x, vw.y, vw.z, vw.w};
#pragma unroll
      for (int e = 0; e < 4; ++e) { const float k0 = bflo(kk[e]) * 0.125f, k1 = bfhi(kk[e]) * 0.125f, v0 = bflo(vv[e]), v1 = bfhi(vv[e]);
        KT[(c8 + 2 * e) * TS + s] = (bf16_t)f2bf(k0); KT[(c8 + 2 * e + 1) * TS + s] = (bf16_t)f2bf(k1);
        VE[(c8 + 2 * e) * TS + s] = (bf16_t)f2bf(v0 * e0); VE[(c8 + 2 * e + 1) * TS + s] = (bf16_t)f2bf(v1 * e0);
        VE[(64 + c8 + 2 * e) * TS + s] = (bf16_t)f2bf(v0 * e1); VE[(64 + c8 + 2 * e + 1) * TS + s] = (bf16_t)f2bf(v1 * e1); }
      if (tid < 64) { VE[128 * TS + tid] = (bf16_t)f2bf(ef[tid]); VE[129 * TS + tid] = (bf16_t)f2bf(eb[tid]); } }
    __syncthreads();
    const int chf = (b * 4 + hd) * 2, jf = ml_jf(c), jb = ml_jb(c);
    for (int t = C.wave; t < 36; t += 8) { const int mt = t & 3, nt = t >> 2; f32x4 acc = {0.f, 0.f, 0.f, 0.f};
        lds_mma<64>(acc, KT + mt * 16 * TS, TS, VE + nt * 16 * TS, TS, lane);
        const int k = mt * 16 + 4 * (lane >> 4), n = nt * 16 + (lane & 15);
        if (n < 128) { const int dir = n >> 6, v = n & 63; bf16_t* dst = MST + ((size_t)((chf + dir) * 36 + (dir ? jb : jf)) * 4096 + v * 64 + k);
            *(unsigned long long*)dst = (unsigned long long)cvt_pk_bf16(acc[0], acc[1]) | ((unsigned long long)cvt_pk_bf16(acc[2], acc[3]) << 32); }
        else if (n < 130) { const int dir = n - 128; *(f32x4*)(MSN + ((size_t)((chf + dir) * 36 + (dir ? jb : jf)) * 64 + k)) = acc; } }
    __syncthreads();
}
__device__ __forceinline__ void ml_carry_item(const Ctx& C, int item) {
    const int chain = item >> 1, half = item & 1, tid = C.tid;
    bf16_t* base = (bf16_t*)(C.ws + WS_MST) + (size_t)chain * 36 * 4096 + half * 2048 + tid * 4;
    float* MSN = (float*)(C.ws + WS_MISC + MSN_OFF) + (size_t)chain * 36 * 64; const float* MSS = (const float*)(C.ws + WS_MISC + MSS_OFF) + chain * 72; float* MSM = (float*)(C.ws + WS_MISC + MSM_OFF) + chain * 36;
    unsigned long long v[36]; float nn[36];
#pragma unroll
    for (int j = 0; j < 36; ++j) v[j] = *(const unsigned long long*)(base + (size_t)j * 4096);
    const bool don = (half == 0 && tid < 64);
    if (don) {
#pragma unroll
        for (int j = 0; j < 36; ++j) nn[j] = MSN[j * 64 + tid]; }
    float c0 = 0.f, c1 = 0.f, c2 = 0.f, c3 = 0.f, nk = 0.f, m = 0.f;
#pragma unroll
    for (int j = 0; j < 36; ++j) {
        const float ml = MSS[2 * j], be = MSS[2 * j + 1], mn = fmaxf(be + m, ml), dec = expf(be + m - mn), sc = expf(ml - mn);
        *(unsigned long long*)(base + (size_t)j * 4096) = (unsigned long long)cvt_pk_bf16(c0, c1) | ((unsigned long long)cvt_pk_bf16(c2, c3) << 32);
        if (half == 0 && tid == 0) MSM[j] = m;
        const unsigned lo = (unsigned)v[j], hi = (unsigned)(v[j] >> 32);
        c0 = dec * c0 + sc * bflo(lo); c1 = dec * c1 + sc * bfhi(lo); c2 = dec * c2 + sc * bflo(hi); c3 = dec * c3 + sc * bfhi(hi);
        if (don) { MSN[j * 64 + tid] = nk; nk = dec * nk + sc * nn[j]; }
        m = mn;
    }
}
__device__ __forceinline__ void ml_out_item(const Ctx& C, int l, int b, int hd, int c) {
    const bf16_t* Z = (const bf16_t*)(C.ws + WS_Z); const float* GT = (const float*)(C.ws + WS_GATES); bf16_t* Y = (bf16_t*)(C.ws + WS_HY);
    const bf16_t* MST = (const bf16_t*)(C.ws + WS_MST); const float* MSN = (const float*)(C.ws + WS_MISC + MSN_OFF); const float* MSM = (const float*)(C.ws + WS_MISC + MSM_OFF);
    LAS bf16_t* Qs = (LAS bf16_t*)C.lds; LAS bf16_t* Ks = Qs + 64 * TS; LAS bf16_t* VT = Ks + 64 * TS; LAS bf16_t* CF = VT + 64 * TS; LAS bf16_t* CB = CF + 64 * TS;
    LAS float* QK = (LAS float*)(C.lds + 46080);
    LAS bf16_t* AP = (LAS bf16_t*)(C.lds + 63488);
    LAS float* sc = (LAS float*)(C.lds + 89088);
    const int r0 = ml_row0(b, c), tid = C.tid, lane = C.lane, chf = (b * 4 + hd) * 2, jf = ml_jf(c), jb = ml_jb(c);
    const int s = tid >> 3, c8 = 8 * (tid & 7);
    { const bf16_t* zr = Z + (size_t)(r0 + s) * ZLD + hd * 64 + c8;
      const u32x4 qw = *(const u32x4*)zr, kw = *(const u32x4*)(zr + 256), vw = *(const u32x4*)(zr + 512);
      const u32x4 cf = *(const u32x4*)(MST + (size_t)((chf) * 36 + jf) * 4096 + s * 64 + c8), cb = *(const u32x4*)(MST + (size_t)((chf + 1) * 36 + jb) * 4096 + s * 64 + c8);
      if (C.wave < 2) { const int dir = C.wave, tok = dir ? 63 - lane : lane; LAS float* sd = sc + dir * 256;
        const float ig = GT[(size_t)(r0 + tok) * 16 + dir * 8 + hd], lf = logsig(GT[(size_t)(r0 + tok) * 16 + dir * 8 + 4 + hd]), min_ = MSM[(chf + dir) * 36 + (dir ? jb : jf)];
        const float bb = scan_add(lf, lane), a = ig - bb, pm = scan_max(a, lane), mx = fmaxf(min_, pm);
        sd[tok] = -mx; sd[64 + tok] = a; sd[128 + tok] = expf(min_ - mx); sd[192 + tok] = expf(-(bb + mx));
        sc[512 + dir * 64 + lane] = MSN[(size_t)((chf + dir) * 36 + (dir ? jb : jf)) * 64 + lane]; }
      *(LAS u32x4*)(Qs + s * TS + c8) = qw; *(LAS u32x4*)(CF + s * TS + c8) = cf; *(LAS u32x4*)(CB + s * TS + c8) = cb;
      const unsigned kk[4] = {kw.x, kw.y, kw.z, kw.w}, vv[4] = {vw.x, vw.y, vw.z, vw.w}; u32x4 ks;
      ks.x = cvt_pk_bf16(bflo(kk[0]) * 0.125f, bfhi(kk[0]) * 0.125f); ks.y = cvt_pk_bf16(bflo(kk[1]) * 0.125f, bfhi(kk[1]) * 0.125f); ks.z = cvt_pk_bf16(bflo(kk[2]) * 0.125f, bfhi(kk[2]) * 0.125f); ks.w = cvt_pk_bf16(bflo(kk[3]) * 0.125f, bfhi(kk[3]) * 0.125f);
      *(LAS u32x4*)(Ks + s * TS + c8) = ks;
#pragma unroll
      for (int e = 0; e < 4; ++e) { VT[(c8 + 2 * e) * TS + s] = (bf16_t)(vv[e] & 0xffffu); VT[(c8 + 2 * e + 1) * TS + s] = (bf16_t)(vv[e] >> 16); } }
    __syncthreads();
    for (int t = C.wave; t < 16; t += 8) { const int mt = t >> 2, nt = t & 3; f32x4 acc = {0.f, 0.f, 0.f, 0.f};
        lds_mma<64>(acc, Qs + mt * 16 * TS, TS, Ks + nt * 16 * TS, TS, lane);
#pragma unroll
        for (int r = 0; r < 4; ++r) QK[(mt * 16 + 4 * (lane >> 4) + r) * 68 + nt * 16 + (lane & 15)] = acc[r]; }
    __syncthreads();
    { const int t = tid >> 3, s0 = 8 * (tid & 7);
      const float rtf = sc[t], wf = sc[128 + t], emf = sc[192 + t], rtb = sc[256 + t], wb = sc[256 + 128 + t], emb = sc[256 + 192 + t];
      float sf[8], sb[8], rsf = 0.f, rsb = 0.f, qnf = 0.f, qnb = 0.f;
      const u32x4 qw = *(const LAS u32x4*)(Qs + t * TS + s0); const unsigned qq[4] = {qw.x, qw.y, qw.z, qw.w}; float qv[8];
#pragma unroll
      for (int e = 0; e < 4; ++e) { qv[2 * e] = bflo(qq[e]); qv[2 * e + 1] = bfhi(qq[e]); }
#pragma unroll
      for (int e = 0; e < 8; ++e) { const int ss = s0 + e; const float qk = QK[t * 68 + ss];
        sf[e] = (ss <= t) ? qk * expf(rtf + sc[64 + ss]) : 0.f; sb[e] = (ss >= t) ? qk * expf(rtb + sc[256 + 64 + ss]) : 0.f; rsf += sf[e]; rsb += sb[e];
        qnf += qv[e] * sc[512 + ss]; qnb += qv[e] * sc[576 + ss]; }
#pragma unroll
      for (int o = 1; o < 8; o <<= 1) { rsf += __shfl_xor(rsf, o); rsb += __shfl_xor(rsb, o); qnf += __shfl_xor(qnf, o); qnb += __shfl_xor(qnb, o); }
      const float idf = 1.0f / fmaxf(fabsf(rsf + wf * qnf), emf), idb = 1.0f / fmaxf(fabsf(rsb + wb * qnb), emb), qf = wf * idf, qb = wb * idb;
      u32x4 pw, fw, bw;
      pw.x = cvt_pk_bf16(sf[0] * idf + sb[0] * idb, sf[1] * idf + sb[1] * idb); pw.y = cvt_pk_bf16(sf[2] * idf + sb[2] * idb, sf[3] * idf + sb[3] * idb);
      pw.z = cvt_pk_bf16(sf[4] * idf + sb[4] * idb, sf[5] * idf + sb[5] * idb); pw.w = cvt_pk_bf16(sf[6] * idf + sb[6] * idb, sf[7] * idf + sb[7] * idb);
      fw.x = cvt_pk_bf16(qv[0] * qf, qv[1] * qf); fw.y = cvt_pk_bf16(qv[2] * qf, qv[3] * qf); fw.z = cvt_pk_bf16(qv[4] * qf, qv[5] * qf); fw.w = cvt_pk_bf16(qv[6] * qf, qv[7] * qf);
      bw.x = cvt_pk_bf16(qv[0] * qb, qv[1] * qb); bw.y = cvt_pk_bf16(qv[2] * qb, qv[3] * qb); bw.z = cvt_pk_bf16(qv[4] * qb, qv[5] * qb); bw.w = cvt_pk_bf16(qv[6] * qb, qv[7] * qb);
      *(LAS u32x4*)(AP + t * 200 + s0) = pw; *(LAS u32x4*)(AP + t * 200 + 64 + s0) = fw; *(LAS u32x4*)(AP + t * 200 + 128 + s0) = bw; }
    __syncthreads();
    for (int t = C.wave; t < 16; t += 8) { const int mt = t >> 2, nt = t & 3; f32x4 acc = {0.f, 0.f, 0.f, 0.f};
        lds_mma<64>(acc, AP + mt * 16 * 200, 200, VT + nt * 16 * TS, TS, lane);
        lds_mma<64>(acc, AP + mt * 16 * 200 + 64, 200, CF + nt * 16 * TS, TS, lane);
        lds_mma<64>(acc, AP + mt * 16 * 200 + 128, 200, CB + nt * 16 * TS, TS, lane);
#pragma unroll
        for (int r = 0; r < 4; ++r) QK[(mt * 16 + 4 * (lane >> 4) + r) * 68 + nt * 16 + (lane & 15)] = acc[r]; }
    __syncthreads();
    { const int t = tid >> 3, v0 = 8 * (tid & 7); float h[8]; float sm = 0.f;
#pragma unroll
      for (int e = 0; e < 8; ++e) { h[e] = QK[t * 68 + v0 + e]; sm += h[e]; }
      sm += __shfl_xor(sm, 1); sm += __shfl_xor(sm, 2); sm += __shfl_xor(sm, 4); const float mu = sm * (1.0f / 64.0f); float q = 0.f;
#pragma unroll
      for (int e = 0; e < 8; ++e) { h[e] -= mu; q += h[e] * h[e]; }
      q += __shfl_xor(q, 1); q += __shfl_xor(q, 2); q += __shfl_xor(q, 4); const float rstd = 1.0f / sqrtf(q * (1.0f / 64.0f) + LN_EPS);
      const float* nw = C.in[I_MNORM] + l * 256 + hd * 64 + v0; const u32x4 ow = *(const u32x4*)(Z + (size_t)(r0 + t) * ZLD + 768 + hd * 64 + v0); const unsigned oo[4] = {ow.x, ow.y, ow.z, ow.w};
      float y[8];
#pragma unroll
      for (int e = 0; e < 4; ++e) { y[2 * e] = h[2 * e] * rstd * nw[2 * e] * sigm(bflo(oo[e])); y[2 * e + 1] = h[2 * e + 1] * rstd * nw[2 * e + 1] * sigm(bfhi(oo[e])); }
      u32x4 w; w.x = cvt_pk_bf16(y[0], y[1]); w.y = cvt_pk_bf16(y[2], y[3]); w.z = cvt_pk_bf16(y[4], y[5]); w.w = cvt_pk_bf16(y[6], y[7]);
      *(u32x4*)(Y + (size_t)(r0 + t) * D + hd * 64 + v0) = w; }
    __syncthreads();
}
__device__ __forceinline__ const bf16_t* wt_ptr(const Ctx& C, int l, size_t off) { return (const bf16_t*)(C.ws + WS_WT + (size_t)l * WT_LAYER + off); }
template <class Epi> __device__ __forceinline__ void run_gemm(const Ctx& C, const Gemm& g, const Epi& E) {
    StaticOrder S; S.init(g.M, g.N, C.G, C.bid);
    gemm_phase<Epi, StaticOrder, true, true>(C.lds, g, S, E);
}
__device__ __forceinline__ void p_inproj(const Ctx& C, int l) {
    Gemm g{(const bf16_t*)(C.ws + WS_HY), wt_ptr(C, l, WT_IN), NROWS, 2304, D, D, D, 0, 0};
    EpiInProj E{(bf16_t*)(C.ws + WS_Z), (bf16_t*)(C.ws + WS_UH)}; run_gemm(C, g, E);
}
__device__ __forceinline__ void p_outproj(const Ctx& C, int l) {
    Gemm g{(const bf16_t*)(C.ws + WS_HY), wt_ptr(C, l, WT_OUT), l == 0 ? NROWS : NLAT, D, D, D, D, 0, 0};
    float* XC = (float*)(C.ws + WS_XC);
    EpiResGate E{l == 0 ? C.in[I_X] : C.out, l == 0 ? C.in[I_CTX] : XC, C.out, XC, (const float*)(C.ws + WS_MOD) + (size_t)l * 17 * 6144 + 2048, ALPHA}; run_gemm(C, g, E);
}
__device__ __forceinline__ void p_ffnin(const Ctx& C, int l) {
    Gemm g{(const bf16_t*)(C.ws + WS_HY), wt_ptr(C, l, WT_FFIN), l == 0 ? NROWS : NLAT, 2 * DFF, D, D, D, 0, 0};
    EpiSwiGlu E{(bf16_t*)(C.ws + WS_ACT), DFF}; run_gemm(C, g, E);
}
__device__ __forceinline__ void p_ffnout(const Ctx& C, int l) {
    Gemm g{(const bf16_t*)(C.ws + WS_ACT), wt_ptr(C, l, WT_FFOUT), l == 0 ? NROWS : NLAT, D, DFF, DFF, DFF, 0, 0};
    float* XC = (float*)(C.ws + WS_XC);
    EpiResGate E{C.out, XC, C.out, XC, (const float*)(C.ws + WS_MOD) + (size_t)l * 17 * 6144 + 5120, ALPHA}; run_gemm(C, g, E);
}
__device__ __forceinline__ void s5_table_item(const Ctx& C, int l, int g, int part) {
    LAS float* APW = (LAS float*)C.lds;
    LAS float* BB = APW + 4352;
    LAS float* CC = BB + 4096;
    LAS float* KT = CC + 2048;
    const int tid = C.tid;
    if (tid < 128) { const int d = tid >> 6, n = tid & 63, ix = ((l * 2 + d) * 16 + g) * 64 + n;
        const double are = C.in[I_ARE][ix], aim = C.in[I_AIM][ix], dt = exp((double)C.in[I_LDT][(l * 2 + d) * 16 + g]);
        const double mag = exp(are * dt), abr = mag * cos(aim * dt), abi = mag * sin(aim * dt), d2 = are * are + aim * aim;
        const double cr = ((abr - 1.0) * are + abi * aim) / d2, ci = (abi * are - (abr - 1.0) * aim) / d2;
        double pr = 1.0, pi = 0.0;
        for (int k = 0; k < 17; ++k) { APW[((d * 17 + k) * 64 + n) * 2] = (float)pr; APW[((d * 17 + k) * 64 + n) * 2 + 1] = (float)pi; const double t = pr * abr - pi * abi; pi = pr * abi + pi * abr; pr = t; }
        for (int q = 0; q < 16; ++q) { const double re = C.in[I_BRE][((size_t)(l * 16 + g) * 64 + n) * 16 + q], im = C.in[I_BIM][((size_t)(l * 16 + g) * 64 + n) * 16 + q];
            BB[((d * 64 + n) * 16 + q) * 2] = (float)(cr * re - ci * im); BB[((d * 64 + n) * 16 + q) * 2 + 1] = (float)(cr * im + ci * re); } }
    for (int idx = tid; idx < 1024; idx += 512) { const int p = idx >> 6, n = idx & 63; CC[idx * 2] = C.in[I_CRE][((size_t)(l * 16 + g) * 16 + p) * 64 + n]; CC[idx * 2 + 1] = C.in[I_CIM][((size_t)(l * 16 + g) * 16 + p) * 64 + n]; }
    __syncthreads();
    { const int d = tid >> 8, k = (tid >> 4) & 15, p = tid & 15; float acc[16];
#pragma unroll
      for (int q = 0; q < 16; ++q) acc[q] = 0.f;
      for (int n = 0; n < 64; ++n) { const float cr = CC[(p * 64 + n) * 2], ci = CC[(p * 64 + n) * 2 + 1], ar = APW[((d * 17 + k) * 64 + n) * 2], ai = APW[((d * 17 + k) * 64 + n) * 2 + 1];
          const float zr = cr * ar - ci * ai, zi = cr * ai + ci * ar;
#pragma unroll
          for (int q = 0; q < 16; ++q) acc[q] += zr * BB[((d * 64 + n) * 16 + q) * 2] - zi * BB[((d * 64 + n) * 16 + q) * 2 + 1]; }
#pragma unroll
      for (int q = 0; q < 16; ++q) KT[((d * 16 + k) * 16 + p) * 16 + q] = acc[q]; }
    __syncthreads();
    bf16_t* BtY = (bf16_t*)(C.ws + WS_WT + (size_t)l * WT_LAYER + WT_BTY) + (size_t)g * 256 * 512; bf16_t* BtS = (bf16_t*)(C.ws + WS_WT + (size_t)l * WT_LAYER + WT_BTS) + (size_t)g * 256 * 256;
    for (int i = 0; i < 4; ++i) { const int idx = tid + 512 * i, row = part * 32 + (idx >> 6), col0 = (idx & 63) * 8, t = row >> 4, p = row & 15; float v[8];
        if (col0 < 256) { const int s = col0 >> 4, q0 = col0 & 15;
#pragma unroll
            for (int e = 0; e < 8; ++e) v[e] = s < t ? KT[((0 * 16 + (t - s)) * 16 + p) * 16 + q0 + e] : (s > t ? KT[((1 * 16 + (s - t)) * 16 + p) * 16 + q0 + e] : KT[(p) * 16 + q0 + e] + KT[((16) * 16 + p) * 16 + q0 + e]); }
        else { const int h0 = col0 - 256, ds = h0 >> 7, im = (h0 >> 6) & 1, n0 = h0 & 63, kp = ds ? 16 - t : t + 1;
#pragma unroll
            for (int e = 0; e < 8; ++e) { const int n = n0 + e; const float cr = CC[(p * 64 + n) * 2], ci = CC[(p * 64 + n) * 2 + 1], ar = APW[((ds * 17 + kp) * 64 + n) * 2], ai = APW[((ds * 17 + kp) * 64 + n) * 2 + 1];
                v[e] = im ? -(cr * ai + ci * ar) : (cr * ar - ci * ai); } }
        u32x4 w; w.x = cvt_pk_bf16(v[0], v[1]); w.y = cvt_pk_bf16(v[2], v[3]); w.z = cvt_pk_bf16(v[4], v[5]); w.w = cvt_pk_bf16(v[6], v[7]);
        *(u32x4*)(BtY + (size_t)row * 512 + col0) = w; }
    for (int i = 0; i < 2; ++i) { const int idx = tid + 512 * i, row = part * 32 + (idx >> 5), col0 = (idx & 31) * 8, s = col0 >> 4, q0 = col0 & 15, ds = row >> 7, im = (row >> 6) & 1, n = row & 63, kp = ds ? s : 15 - s;
        const float ar = APW[((ds * 17 + kp) * 64 + n) * 2], ai = APW[((ds * 17 + kp) * 64 + n) * 2 + 1]; float v[8];
#pragma unroll
        for (int e = 0; e < 8; ++e) { const float br = BB[((ds * 64 + n) * 16 + q0 + e) * 2], bi = BB[((ds * 64 + n) * 16 + q0 + e) * 2 + 1]; v[e] = im ? (ar * bi + ai * br) : (ar * br - ai * bi); }
        u32x4 w; w.x = cvt_pk_bf16(v[0], v[1]); w.y = cvt_pk_bf16(v[2], v[3]); w.z = cvt_pk_bf16(v[4], v[5]); w.w = cvt_pk_bf16(v[6], v[7]);
        *(u32x4*)(BtS + (size_t)row * 256 + col0) = w; }
    __syncthreads();
}
__device__ __forceinline__ int s5_chunk_id(int b, int dir, int j) { if (j < 16) return 2048 + b * 16 + (dir ? 15 - j : j); const int jl = j - 16; return b * 128 + (dir ? 127 - jl : jl); }
__device__ __forceinline__ void s5_carry_item(const Ctx& C, int l, int item) {
    const int gid = item * 512 + C.tid, n = gid & 63, dir = (gid >> 6) & 1, g = (gid >> 7) & 15, b = gid >> 11;
    const float* S = (const float*)(C.ws + WS_S5S) + (size_t)g * NCH_S5 * 256 + dir * 128 + n; bf16_t* Hh = (bf16_t*)(C.ws + WS_UH) + (size_t)g * NCH_S5 * 512 + 256 + dir * 128 + n;
    const int ix = ((l * 2 + dir) * 16 + g) * 64 + n;
    const double are = C.in[I_ARE][ix], aim = C.in[I_AIM][ix], dt = exp((double)C.in[I_LDT][(l * 2 + dir) * 16 + g]), mag = exp(16.0 * are * dt);
    const float a_r = (float)(mag * cos(16.0 * aim * dt)), a_i = (float)(mag * sin(16.0 * aim * dt));
    float cr = 0.f, ci = 0.f;
    for (int j0 = 0; j0 < 144; j0 += 16) { float sr[16], si[16];
#pragma unroll
        for (int jj = 0; jj < 16; ++jj) { const int ch = s5_chunk_id(b, dir, j0 + jj); sr[jj] = S[(size_t)ch * 256]; si[jj] = S[(size_t)ch * 256 + 64]; }
#pragma unroll
        for (int jj = 0; jj < 16; ++jj) { const int ch = s5_chunk_id(b, dir, j0 + jj); Hh[(size_t)ch * 512] = (bf16_t)f2bf(cr); Hh[(size_t)ch * 512 + 64] = (bf16_t)f2bf(ci);
            const float nr = a_r * cr - a_i * ci + sr[jj], ni = a_r * ci + a_i * cr + si[jj]; cr = nr; ci = ni; } }
}
__device__ __forceinline__ void p_s5_gemmS(const Ctx& C, int l) {
    Gemm g{(const bf16_t*)(C.ws + WS_UH), wt_ptr(C, l, WT_BTS), 16 * NCH_S5, 256, 256, 512, 256, 9, (size_t)256 * 256 * 2};
    EpiF32 E{(float*)(C.ws + WS_S5S), 256}; run_gemm(C, g, E);
}
__device__ __forceinline__ void p_s5_gemmY(const Ctx& C, int l) {
    Gemm g{(const bf16_t*)(C.ws + WS_UH), wt_ptr(C, l, WT_BTY), 16 * NCH_S5, 256, 512, 512, 512, 9, (size_t)256 * 512 * 2};
    EpiS5Y E{(const bf16_t*)(C.ws + WS_UH), C.in[I_DSK] + l * 256, (bf16_t*)(C.ws + WS_YS5)}; run_gemm(C, g, E);
}
__device__ __forceinline__ void p_s5_glu(const Ctx& C, int l) {
    Gemm g{(const bf16_t*)(C.ws + WS_YS5), wt_ptr(C, l, WT_GLU), l == 0 ? NROWS : NLAT, 256, 256, 256, 256, 0, 0};
    EpiGlu E{(const bf16_t*)(C.ws + WS_YS5), C.in[I_GLUB] + l * 256, (bf16_t*)(C.ws + WS_HY)}; run_gemm(C, g, E);
}
__device__ __forceinline__ void p_mixA(const Ctx& C, int l) {
    p_s5_gemmS(C, l);
    __syncthreads();
    const int nsgu = l == 0 ? 288 : 256, ncv = l == 0 ? 576 : 512, total = 2304 + nsgu + ncv;
    for (int it = C.bid; it < total; it += C.G) {
        int r = it;
        if (r < 2304) { const int b = r / 144, q = r % 144; ml_state_item(C, b, q / 36, q % 36); continue; } r -= 2304;
        if (r < nsgu) { sgu_item(C, l, r); continue; } r -= nsgu;
        conv_item(C, l, r);
    }
}
__device__ __forceinline__ void p_mixB(const Ctx& C, int l) {
    for (int it = C.bid; it < 320; it += C.G) { if (it < 256) ml_carry_item(C, it); else s5_carry_item(C, l, it - 256); }
}
__device__ __forceinline__ void p_mixC(const Ctx& C, int l) {
    p_s5_gemmY(C, l);
    __syncthreads();
    const int ncs = l == 0 ? 36 : 32;
    for (int it = C.bid; it < 64 * ncs; it += C.G) { const int bh = it / ncs; ml_out_item(C, l, bh >> 2, bh & 3, it % ncs); }
}

__global__ void __launch_bounds__(512, 2) mk_fwd(Args a) {
    extern __shared__ __attribute__((aligned(16))) unsigned char lds_raw[];
    Ctx C; C.lds = (LAS unsigned char*)lds_raw; C.tid = threadIdx.x; C.lane = C.tid & 63; C.wave = __builtin_amdgcn_readfirstlane(C.tid >> 6); C.bid = blockIdx.x; C.G = gridDim.x;
    C.in = a.in; C.out = a.out; C.ws = a.ws;
    const int lo = a.ph_lo, hi = a.ph_hi;
#define PH(k, body) if (lo <= (k) && (k) < hi) { body; if ((k) + 1 < hi) { __threadfence(); cooperative_groups::this_grid().sync(); } }
    PH(0, p_prologue(C))
    PH(1, p_rowpass(C, 0, 0))
    PH(2, p_inproj(C, 0))
    PH(3, p_mixA(C, 0))
    PH(4, p_mixB(C, 0))
    PH(5, p_mixC(C, 0))
    PH(6, p_s5_glu(C, 0))
    PH(7, p_outproj(C, 0))
    PH(8, p_rowpass(C, 1, 0))
    PH(9, p_ffnin(C, 0))
    PH(10, p_ffnout(C, 0))
    PH(11, p_rowpass(C, 2, 0))
    PH(12, p_inproj(C, 1))
    PH(13, p_mixA(C, 1))
    PH(14, p_mixB(C, 1))
    PH(15, p_mixC(C, 1))
    PH(16, p_s5_glu(C, 1))
    PH(17, p_outproj(C, 1))
    PH(18, p_rowpass(C, 1, 1))
    PH(19, p_ffnin(C, 1))
    PH(20, p_ffnout(C, 1))
    PH(21, p_rowpass(C, 2, 1))
#undef PH
}
}

extern "C" void kernel_launch(void* const* d_in, const int* in_sizes, int n_in, void* d_out, int out_size, void* d_ws, size_t ws_size, hipStream_t stream) {
    static int ready = 0;
    if (!ready) {
        if (n_in != 34 || in_sizes[0] != mk::NLAT * mk::D || out_size != mk::NLAT * mk::D || ws_size < mk::WS_END) { fprintf(stderr, "kernel_launch: unexpected shapes (n_in %d, in0 %d, out %d, ws %zu)\n", n_in, n_in > 0 ? in_sizes[0] : -1, out_size, ws_size); ready = -1; return; }
        if (hipFuncSetAttribute((const void*)mk::mk_fwd, hipFuncAttributeMaxDynamicSharedMemorySize, mk::LDS_BYTES) != hipSuccess) { fprintf(stderr, "kernel_launch: hipFuncSetAttribute failed\n"); ready = -1; return; }
        ready = 1;
    }
    if (ready < 0) return;
    mk::Args a{};
    for (int i = 0; i < 34; ++i) a.in[i] = (const float*)d_in[i];
    a.out = (float*)d_out; a.ws = (unsigned char*)d_ws;
#if MK_ONE_LAUNCH
    a.ph_lo = 0; a.ph_hi = mk::NPH;
    void* args[] = {&a};
    hipError_t e = hipLaunchCooperativeKernel((const void*)mk::mk_fwd, dim3(256), dim3(512), args, mk::LDS_BYTES, stream);
    if (e != hipSuccess) fprintf(stderr, "cooperative launch failed: %s\n", hipGetErrorString(e));
#else
    for (int ph = 0; ph < mk::NPH; ++ph) {
        a.ph_lo = ph; a.ph_hi = ph + 1;
        hipLaunchKernelGGL(mk::mk_fwd, dim3(256), dim3(512), mk::LDS_BYTES, stream, a);
    }
#endif
}
```

```cpp
#include <hip/hip_runtime.h>
#include <hip/hip_cooperative_groups.h>
#include <cstdio>
#include <cstdint>
namespace pg8 {
#define PG8_LAS __attribute__((address_space(3)))
typedef unsigned short bf16_t;
typedef short bf16x8 __attribute__((ext_vector_type(8)));
typedef float f32x4 __attribute__((ext_vector_type(4)));
typedef unsigned u32x4 __attribute__((ext_vector_type(4)));
constexpr int BM = 256, BK = 64, HALF = 128, HTB = HALF * BK * 2  , STAGE_BYTES = 8 * HTB, NXCD = 8, WGM = 8;

__host__ __device__ __forceinline__ int lds_byte(int r, int c) { const int st = (r >> 4) * 2 + (c >> 5), rr = r & 15, cc = c & 31, ob = rr * 64 + cc * 2; return st * 1024 + (ob ^ (((ob >> 9) & 1) << 5)); }
__host__ __device__ __forceinline__ void stage_rc(int b, int& R, int& C) { const int st = b / 1024, sb = b % 1024, swz = sb ^ (((sb >> 9) & 1) << 5); R = (st >> 1) * 16 + swz / 64; C = (st & 1) * 32 + (swz % 64) / 2; }
__host__ __device__ __forceinline__ int perm32(int rho) { const int n = rho >> 4, i = rho & 15; return 8 * (i >> 2) + 4 * n + (i & 3); }

struct Unit { int pm, pn; };
struct Gemm { const bf16_t* A; const bf16_t* Bt; int M, N, K, lda, ldb, bgrp; size_t bgrp_stride; };

struct StaticOrder {
    int nM, nN, nwg, G, c;
    __host__ __device__ void init(int M, int N, int G_, int c_) { nM = M / BM; nN = N / BM; nwg = nM * nN; G = G_; c = c_; }
    __host__ __device__ bool next(int i, Unit& u) const {
        const long L = (long)i * G + c; if (L >= nwg) return false;
        int wgid = (int)L; { const int q = nwg / NXCD, r = nwg % NXCD, xcd = wgid % NXCD, off = wgid / NXCD; wgid = (xcd < r ? xcd * (q + 1) : r * (q + 1) + (xcd - r) * q) + off; }
        const int nig = WGM * nN, gid = wgid / nig, fm = gid * WGM, gsz = (nM - fm) < WGM ? (nM - fm) : WGM;
        u.pm = fm + ((wgid % nig) % gsz); u.pn = (wgid % nig) / gsz; return true;
    }
    __device__ __forceinline__ void a_ready(const Unit&) const {}
    __device__ __forceinline__ void done(const Unit&) const {}
};

__device__ __forceinline__ unsigned cvt_pk_bf16(float lo, float hi) { unsigned r; asm volatile("v_cvt_pk_bf16_f32 %0, %1, %2" : "=v"(r) : "v"(lo), "v"(hi)); return r; }
__device__ __forceinline__ float bflo(unsigned w) { return __uint_as_float(w << 16); }
__device__ __forceinline__ float bfhi(unsigned w) { return __uint_as_float(w & 0xffff0000u); }
__device__ __forceinline__ float sigm(float x) { return __builtin_amdgcn_rcpf(1.0f + __expf(-x)); }
__device__ __forceinline__ float gelu_t(float x) { const float u = 1.5957691216f * (x + 0.044715f * x * x * x); return x * sigm(u); }
__device__ __forceinline__ u32x4 pack8(const f32x4 a, const f32x4 b) { u32x4 w; w.x = cvt_pk_bf16(a[0], a[1]); w.y = cvt_pk_bf16(a[2], a[3]); w.z = cvt_pk_bf16(b[0], b[1]); w.w = cvt_pk_bf16(b[2], b[3]); return w; }

constexpr int NLAT = 32768, NROWS = 36864, ZLD = 2048, NCH_S5 = 2304;

struct EpiInProj {
    static constexpr bool PERM = true, AFTER_DRAIN = false;
    bf16_t* Z; bf16_t* UH;
    __device__ __forceinline__ void operator()(const f32x4 (&acc)[2][2][4][2], const Unit& u, int wr, int wc, int fr, int fq) const {
#pragma unroll
        for (int ai = 0; ai < 2; ++ai)
#pragma unroll
            for (int m = 0; m < 4; ++m) { const int row = u.pm * BM + ai * HALF + wr * 64 + m * 16 + fr;
#pragma unroll
                for (int bj = 0; bj < 2; ++bj) { const u32x4 w = pack8(acc[ai][bj][m][0], acc[ai][bj][m][1]); const int cc = bj * HALF + wc * 32 + 8 * fq;
                    if (u.pn < 8) *(u32x4*)(Z + (size_t)row * ZLD + u.pn * BM + cc) = w;
                    else { const int g = cc >> 4, q0 = cc & 15; *(u32x4*)(UH + ((size_t)(g * NCH_S5 + (row >> 4)) * 512 + (row & 15) * 16 + q0)) = w; } } }
    }
};
struct EpiResGate {
    static constexpr bool PERM = false, AFTER_DRAIN = false;
    const float* srcL; const float* srcC; float* dstL; float* dstC; const float* gate; float alpha;
    __device__ __forceinline__ void operator()(const f32x4 (&acc)[2][2][4][2], const Unit& u, int wr, int wc, int fr, int fq) const {
        const int row0 = u.pm * BM; const bool lat = row0 < NLAT; const int mi = lat ? (row0 >> 11) : 16;
        const float* src = lat ? srcL + (size_t)row0 * 1024 : srcC + (size_t)(row0 - NLAT) * 1024; float* dst = lat ? dstL + (size_t)row0 * 1024 : dstC + (size_t)(row0 - NLAT) * 1024;
        const float* gp = gate + (size_t)mi * 6144;
#pragma unroll
        for (int bj = 0; bj < 2; ++bj)
#pragma unroll
            for (int n = 0; n < 2; ++n) { const int col = u.pn * BM + bj * HALF + wc * 32 + n * 16 + 4 * fq; const f32x4 gv = *(const f32x4*)(gp + col);
#pragma unroll
                for (int ai = 0; ai < 2; ++ai)
#pragma unroll
                    for (int m = 0; m < 4; ++m) { const size_t off = (size_t)(ai * HALF + wr * 64 + m * 16 + fr) * 1024 + col; const f32x4 x = *(const f32x4*)(src + off); *(f32x4*)(dst + off) = x * alpha + gv * acc[ai][bj][m][n]; } }
    }
};
struct EpiSwiGlu {
    static constexpr bool PERM = true, AFTER_DRAIN = false;
    bf16_t* ACT; int ldc;
    __device__ __forceinline__ void operator()(const f32x4 (&acc)[2][2][4][2], const Unit& u, int wr, int wc, int fr, int fq) const {
#pragma unroll
        for (int ai = 0; ai < 2; ++ai)
#pragma unroll
            for (int m = 0; m < 4; ++m) { const int row = u.pm * BM + ai * HALF + wr * 64 + m * 16 + fr; f32x4 o[2];
#pragma unroll
                for (int n = 0; n < 2; ++n)
#pragma unroll
                    for (int e = 0; e < 4; ++e) { const float g = acc[ai][0][m][n][e]; o[n][e] = g * sigm(g) * acc[ai][1][m][n][e]; }
                *(u32x4*)(ACT + (size_t)row * ldc + u.pn * HALF + wc * 32 + 8 * fq) = pack8(o[0], o[1]); }
    }
};
struct EpiF32 {
    static constexpr bool PERM = false, AFTER_DRAIN = false;
    float* O; int ldc;
    __device__ __forceinline__ void operator()(const f32x4 (&acc)[2][2][4][2], const Unit& u, int wr, int wc, int fr, int fq) const {
#pragma unroll
        for (int ai = 0; ai < 2; ++ai)
#pragma unroll
            for (int m = 0; m < 4; ++m) { const size_t ro = (size_t)(u.pm * BM + ai * HALF + wr * 64 + m * 16 + fr) * ldc;
#pragma unroll
                for (int bj = 0; bj < 2; ++bj)
#pragma unroll
                    for (int n = 0; n < 2; ++n) *(f32x4*)(O + ro + u.pn * BM + bj * HALF + wc * 32 + n * 16 + 4 * fq) = acc[ai][bj][m][n]; }
    }
};
struct EpiS5Y {
    static constexpr bool PERM = true, AFTER_DRAIN = false;
    const bf16_t* UH; const float* dsk; bf16_t* YS5;
    __device__ __forceinline__ void operator()(const f32x4 (&acc)[2][2][4][2], const Unit& u, int wr, int wc, int fr, int fq) const {
        const int g = (u.pm * BM) / NCH_S5;
#pragma unroll
        for (int bj = 0; bj < 2; ++bj) { const int col = bj * HALF + wc * 32 + 8 * fq, t = col >> 4, p0 = col & 15;
            const f32x4 d0 = *(const f32x4*)(dsk + g * 16 + p0), d1 = *(const f32x4*)(dsk + g * 16 + p0 + 4);
#pragma unroll
            for (int ai = 0; ai < 2; ++ai)
#pragma unroll
                for (int m = 0; m < 4; ++m) { const int row = u.pm * BM + ai * HALF + wr * 64 + m * 16 + fr, chunk = row - g * NCH_S5;
                    const u32x4 uw = *(const u32x4*)(UH + (size_t)row * 512 + col); f32x4 a = acc[ai][bj][m][0], b = acc[ai][bj][m][1];
                    a[0] += d0[0] * bflo(uw.x); a[1] += d0[1] * bfhi(uw.x); a[2] += d0[2] * bflo(uw.y); a[3] += d0[3] * bfhi(uw.y);
                    b[0] += d1[0] * bflo(uw.z); b[1] += d1[1] * bfhi(uw.z); b[2] += d1[2] * bflo(uw.w); b[3] += d1[3] * bfhi(uw.w);
#pragma unroll
                    for (int e = 0; e < 4; ++e) { a[e] = gelu_t(a[e]); b[e] = gelu_t(b[e]); }
                    *(u32x4*)(YS5 + (size_t)(chunk * 16 + t) * 256 + g * 16 + p0) = pack8(a, b); } }
    }
};
struct EpiGlu {
    static constexpr bool PERM = true, AFTER_DRAIN = false;
    const bf16_t* YS5; const float* gb; bf16_t* Y;
    __device__ __forceinline__ void operator()(const f32x4 (&acc)[2][2][4][2], const Unit& u, int wr, int wc, int fr, int fq) const {
#pragma unroll
        for (int bj = 0; bj < 2; ++bj) { const int col = bj * HALF + wc * 32 + 8 * fq; const f32x4 b0 = *(const f32x4*)(gb + col), b1 = *(const f32x4*)(gb + col + 4);
#pragma unroll
            for (int ai = 0; ai < 2; ++ai)
#pragma unroll
                for (int m = 0; m < 4; ++m) { const int row = u.pm * BM + ai * HALF + wr * 64 + m * 16 + fr; const u32x4 yw = *(const u32x4*)(YS5 + (size_t)row * 256 + col);
                    f32x4 a = acc[ai][bj][m][0] + b0, b = acc[ai][bj][m][1] + b1;
                    a[0] = bflo(yw.x) * sigm(a[0]); a[1] = bfhi(yw.x) * sigm(a[1]); a[2] = bflo(yw.y) * sigm(a[2]); a[3] = bfhi(yw.y) * sigm(a[3]);
                    b[0] = bflo(yw.z) * sigm(b[0]); b[1] = bfhi(yw.z) * sigm(b[1]); b[2] = bflo(yw.w) * sigm(b[2]); b[3] = bfhi(yw.w) * sigm(b[3]);
                    *(u32x4*)(Y + (size_t)row * 1024 + 768 + col) = pack8(a, b); } }
    }
};

template <class Epi, class Sched, bool ALIGN_EPI = false, bool SP2 = false>
__device__ __forceinline__ void gemm_phase(PG8_LAS unsigned char* lds, const Gemm g, const Sched& S, const Epi& E) {
    const int tid = threadIdx.x, wid = __builtin_amdgcn_readfirstlane(tid >> 6), lane = tid & 63, wr = wid >> 2, wc = wid & 3, fr = lane & 15, fq = lane >> 4;
    const int K = g.K, nt = K / BK;
    unsigned voffA[2], voffB[2];
#pragma unroll
    for (int i = 0; i < 2; ++i) { int R, C; stage_rc(tid * 16 + i * 8192, R, C); const int Rb = Epi::PERM ? ((R & ~31) + perm32(R & 31)) : R;
        voffA[i] = (unsigned)(R * g.lda + C) * 2u; voffB[i] = (unsigned)(Rb * g.ldb + C) * 2u; }
    const size_t kstep = (size_t)(BK * 2);
    const size_t hstepA = (size_t)HALF * g.lda * 2, hstepB = (size_t)HALF * g.ldb * 2;
    const size_t tstepA = 2 * hstepA, tstepB = 2 * hstepB;
#define PG8_ABASE(u) ((const char*)g.A + (size_t)(u).pm * tstepA)
#define PG8_BBASE(u) ((const char*)g.Bt + (size_t)(u).pn * tstepB + (g.bgrp ? (size_t)((u).pm / g.bgrp) * g.bgrp_stride : (size_t)0))
    const unsigned ldsw = (unsigned)wid * 1024u;
    const int aoff = lds_byte(wr * 64 + fr, fq * 8), boff = lds_byte(wc * 32 + fr, fq * 8);
#define PG8_SA(b, h) (((b) * 2 + (h)) * HTB)
#define PG8_SB(b, h) ((4 + (b) * 2 + (h)) * HTB)
#define PG8_STAGE(bufoff, gbase, voff) do { _Pragma("unroll") for (int _i = 0; _i < 2; ++_i) \
        __builtin_amdgcn_global_load_lds((const unsigned*)((const char*)(gbase) + (voff)[_i]), (PG8_LAS unsigned*)(lds + (bufoff) + ldsw + _i * 8192), 16, 0, 0); } while (0)
#define PG8_LDA(dst, b, h) do { _Pragma("unroll") for (int m = 0; m < 4; ++m) _Pragma("unroll") for (int k = 0; k < 2; ++k) dst[m][k] = *(const PG8_LAS bf16x8*)(lds + PG8_SA(b, h) + aoff + m * 2048 + k * 1024); } while (0)
#define PG8_LDB(dst, b, h) do { _Pragma("unroll") for (int n = 0; n < 2; ++n) _Pragma("unroll") for (int k = 0; k < 2; ++k) dst[n][k] = *(const PG8_LAS bf16x8*)(lds + PG8_SB(b, h) + boff + n * 2048 + k * 1024); } while (0)
#define PG8_MMA(ai, bj, At, Bt) do { __builtin_amdgcn_s_setprio(1); _Pragma("unroll") for (int m = 0; m < 4; ++m) _Pragma("unroll") for (int n = 0; n < 2; ++n) _Pragma("unroll") for (int k = 0; k < 2; ++k) \
        acc[ai][bj][m][n] = __builtin_amdgcn_mfma_f32_16x16x32_bf16(Bt[n][k], At[m][k], acc[ai][bj][m][n], 0, 0, 0); __builtin_amdgcn_s_setprio(0); } while (0)
#define PG8_WAIT_V(n) asm volatile("s_waitcnt vmcnt(" #n ")" ::: "memory")
#define PG8_WAIT_L(n) asm volatile("s_waitcnt lgkmcnt(" #n ")" ::: "memory")
#define PG8_BAR __builtin_amdgcn_s_barrier()
#define PG8_SCHED __builtin_amdgcn_sched_barrier(0)
    Unit cur, nxt; int ui = 0;
    if (!S.next(0, cur)) return;
    f32x4 acc[2][2][4][2];
#pragma unroll
    for (int a = 0; a < 2; ++a)
#pragma unroll
        for (int b = 0; b < 2; ++b)
#pragma unroll
            for (int m = 0; m < 4; ++m)
#pragma unroll
                for (int n = 0; n < 2; ++n) acc[a][b][m][n] = (f32x4){0.f, 0.f, 0.f, 0.f};
    bf16x8 At[4][2], B0[2][2], B1[2][2];
    const char* cA = PG8_ABASE(cur); const char* cB = PG8_BBASE(cur);
    S.a_ready(cur);
    if constexpr (SP2) {
        PG8_STAGE(PG8_SB(0, 0), cB, voffB); PG8_STAGE(PG8_SB(0, 1), cB + hstepB, voffB); PG8_STAGE(PG8_SA(0, 0), cA, voffA); PG8_STAGE(PG8_SA(0, 1), cA + hstepA, voffA);
        if (wr == 1) PG8_BAR;
        PG8_WAIT_V(2); PG8_BAR;
        PG8_STAGE(PG8_SB(1, 0), cB + kstep, voffB); PG8_STAGE(PG8_SA(1, 0), cA + kstep, voffA); PG8_STAGE(PG8_SB(1, 1), cB + hstepB + kstep, voffB);
        PG8_WAIT_V(6); PG8_BAR;
    } else {
        PG8_STAGE(PG8_SB(0, 0), cB, voffB); PG8_STAGE(PG8_SA(0, 0), cA, voffA); PG8_STAGE(PG8_SB(0, 1), cB + hstepB, voffB); PG8_STAGE(PG8_SA(0, 1), cA + hstepA, voffA);
        if (wr == 1) PG8_BAR;
        PG8_WAIT_V(4); PG8_BAR;
        PG8_STAGE(PG8_SB(1, 0), cB + kstep, voffB); PG8_STAGE(PG8_SA(1, 0), cA + kstep, voffA); PG8_STAGE(PG8_SB(1, 1), cB + hstepB + kstep, voffB);
        PG8_WAIT_V(6); PG8_BAR;
    }
    for (;;) {
        const bool has_next = S.next(ui + 1, nxt);
        const char* nA = has_next ? PG8_ABASE(nxt) : cA; const char* nB = has_next ? PG8_BBASE(nxt) : cB;
        for (int t = 0; t < nt; t += 2) {
            const bool last = (t == nt - 2);
            const char* a1 = cA + (size_t)(t + 1) * kstep;
            const char* a2 = last ? nA : cA + (size_t)(t + 2) * kstep; const char* b2 = last ? nB : cB + (size_t)(t + 2) * kstep;
            const char* a3 = a2 + kstep; const char* b3 = b2 + kstep;
            if (last && has_next) S.a_ready(nxt);
            if constexpr (SP2) {
            PG8_LDB(B0, 0, 0); PG8_LDB(B1, 0, 1); PG8_SCHED; PG8_LDA(At, 0, 0); PG8_STAGE(PG8_SA(1, 1), a1 + hstepA, voffA);
            PG8_WAIT_V(8); PG8_WAIT_L(0); PG8_BAR; PG8_MMA(0, 0, At, B0); PG8_MMA(0, 1, At, B1); PG8_BAR; PG8_SCHED;
            PG8_LDA(At, 0, 1); PG8_STAGE(PG8_SB(0, 0), b2, voffB); PG8_STAGE(PG8_SB(0, 1), b2 + hstepB, voffB); PG8_STAGE(PG8_SA(0, 0), a2, voffA);
            PG8_WAIT_V(8); PG8_WAIT_L(0); PG8_BAR; PG8_MMA(1, 0, At, B0); PG8_MMA(1, 1, At, B1); PG8_BAR; PG8_SCHED;
            PG8_LDB(B0, 1, 0); PG8_LDB(B1, 1, 1); PG8_SCHED; PG8_LDA(At, 1, 0); PG8_STAGE(PG8_SA(0, 1), a2 + hstepA, voffA);
            PG8_WAIT_V(8); PG8_WAIT_L(0); PG8_BAR; PG8_MMA(0, 0, At, B0); PG8_MMA(0, 1, At, B1); PG8_BAR; PG8_SCHED;
            PG8_LDA(At, 1, 1); PG8_STAGE(PG8_SB(1, 0), b3, voffB); PG8_STAGE(PG8_SB(1, 1), b3 + hstepB, voffB); PG8_STAGE(PG8_SA(1, 0), a3, voffA);
            PG8_WAIT_V(8); PG8_WAIT_L(0); PG8_BAR; PG8_MMA(1, 0, At, B0); PG8_MMA(1, 1, At, B1); PG8_BAR; PG8_SCHED;
            } else {
            PG8_LDB(B0, 0, 0); PG8_SCHED; PG8_LDA(At, 0, 0); PG8_STAGE(PG8_SA(1, 1), a1 + hstepA, voffA);
            PG8_WAIT_L(8); PG8_BAR; PG8_WAIT_L(0); PG8_MMA(0, 0, At, B0); PG8_BAR; PG8_SCHED;
            PG8_LDB(B1, 0, 1); PG8_STAGE(PG8_SB(0, 0), b2, voffB);
            PG8_BAR; PG8_WAIT_L(0); PG8_MMA(0, 1, At, B1); PG8_BAR;
            PG8_LDA(At, 0, 1); PG8_STAGE(PG8_SA(0, 0), a2, voffA);
            PG8_BAR; PG8_WAIT_L(0); PG8_MMA(1, 0, At, B0); PG8_BAR; PG8_SCHED;
            PG8_STAGE(PG8_SB(0, 1), b2 + hstepB, voffB);
            PG8_WAIT_V(6); PG8_BAR; PG8_MMA(1, 1, At, B1); PG8_BAR;
            PG8_LDB(B0, 1, 0); PG8_SCHED; PG8_LDA(At, 1, 0); PG8_STAGE(PG8_SA(0, 1), a2 + hstepA, voffA);
            PG8_WAIT_L(8); PG8_BAR; PG8_WAIT_L(0); PG8_MMA(0, 0, At, B0); PG8_BAR; PG8_SCHED;
            PG8_LDB(B1, 1, 1); PG8_STAGE(PG8_SB(1, 0), b3, voffB);
            PG8_BAR; PG8_WAIT_L(0); PG8_MMA(0, 1, At, B1); PG8_BAR;
            PG8_LDA(At, 1, 1); PG8_STAGE(PG8_SA(1, 0), a3, voffA);
            PG8_BAR; PG8_WAIT_L(0); PG8_MMA(1, 0, At, B0); PG8_BAR; PG8_SCHED;
            PG8_STAGE(PG8_SB(1, 1), b3 + hstepB, voffB);
            PG8_WAIT_V(6); PG8_BAR; PG8_MMA(1, 1, At, B1); PG8_BAR;
            }
        }
        if constexpr (ALIGN_EPI) { if (wr == 0) PG8_BAR; }
        if constexpr (!Epi::AFTER_DRAIN) { E(acc, cur, wr, wc, fr, fq); S.done(cur); }
        if (!has_next) break;
#pragma unroll
        for (int a = 0; a < 2; ++a)
#pragma unroll
            for (int b = 0; b < 2; ++b)
#pragma unroll
                for (int m = 0; m < 4; ++m)
#pragma unroll
                    for (int n = 0; n < 2; ++n) acc[a][b][m][n] = (f32x4){0.f, 0.f, 0.f, 0.f};
        cur = nxt; cA = nA; cB = nB; ++ui;
        if constexpr (ALIGN_EPI) { if (wr == 1) PG8_BAR; }
    }
    PG8_WAIT_V(0);
    if constexpr (!ALIGN_EPI) { if (wr == 0) PG8_BAR; }
    PG8_BAR;
    if constexpr (Epi::AFTER_DRAIN) { E.fused(acc, cur, wr, wc, fr, fq, lds, wid, lane); S.done(cur); }
#undef PG8_ABASE
#undef PG8_BBASE
#undef PG8_SA
#undef PG8_SB
#undef PG8_STAGE
#undef PG8_LDA
#undef PG8_LDB
#undef PG8_MMA
#undef PG8_WAIT_V
#undef PG8_WAIT_L
#undef PG8_BAR
#undef PG8_SCHED
}
}

#ifndef MK_ONE_LAUNCH
#define MK_ONE_LAUNCH 1
#endif
namespace mk {
using namespace pg8;
#define LAS __attribute__((address_space(3)))
constexpr int D = 1024, NB = 16, SEQ = 2048, CTXL = 256, DFF = 2816, PIN = 2320, NPH = 22;
constexpr float ALPHA = 1.41421356237309515f, LN_EPS = 1e-5f;
constexpr size_t MiB = 1u << 20;
constexpr size_t WS_CTL = 0, WS_MOD = 1 * MiB, WS_WT = 2 * MiB, WT_LAYER = 30 * MiB;
constexpr size_t WT_IN = 0, WT_OUT = 9 * MiB / 2, WT_FFIN = 13 * MiB / 2, WT_FFOUT = 35 * MiB / 2, WT_GLU = 23 * MiB, WT_BTY = 93 * MiB / 4, WT_BTS = 109 * MiB / 4;
constexpr size_t WS_GATES = 62 * MiB, WS_XC = 65 * MiB, WS_HY = 81 * MiB, WS_Z = 153 * MiB, WS_ACT = 153 * MiB, WS_UH = 297 * MiB, WS_MST = 333 * MiB, WS_YS5 = 369 * MiB,
                 WS_S5S = 387 * MiB, WS_MISC = 423 * MiB, WS_HSUM = 427 * MiB, WS_Y32 = 463 * MiB, WS_END = 499 * MiB;
constexpr int LDS_BYTES = 147456;

struct Args { const float* in[34]; float* out; unsigned char* ws; int ph_lo, ph_hi; };
enum { I_X = 0, I_C, I_CTX, I_CCTX, I_WMOD, I_BMOD, I_WIN, I_GBIAS, I_MNORM, I_SLNW, I_SLNB, I_SW, I_SB, I_CW, I_CB, I_CLNW, I_CLNB, I_ARE, I_AIM, I_LDT, I_BRE, I_BIM, I_CRE, I_CIM, I_DSK, I_GLUW, I_GLUB,
       I_WOUT, I_LN1W, I_LN1B, I_WFFIN, I_WFFOUT, I_LN2W, I_LN2B };

struct Ctx { LAS unsigned char* lds; int tid, lane, wave, bid, G; const float* const* in; float* out; unsigned char* ws; };

__device__ __forceinline__ float bf2f(bf16_t h) { return __uint_as_float((unsigned)h << 16); }
__device__ __forceinline__ unsigned f2bf(float f) { unsigned u = __float_as_uint(f); return (u + 0x7fffu + ((u >> 16) & 1u)) >> 16; }
__device__ __forceinline__ unsigned pk2(float lo, float hi) { return f2bf(lo) | (f2bf(hi) << 16); }
__device__ __forceinline__ float wave_sum(float v) {
#pragma unroll
    for (int o = 1; o < 64; o <<= 1) v += __shfl_xor(v, o);
    return v;
}
__device__ __forceinline__ float logsig(float x) { return fminf(x, 0.f) - log1pf(expf(-fabsf(x))); }
__device__ __forceinline__ int chain_row(int b, int dir, int j) {
    if (j < CTXL) { const int t = dir ? CTXL - 1 - j : j; return NLAT + b * CTXL + t; }
    int t = j - CTXL; t = dir ? SEQ - 1 - t : t; return b * SEQ + t;
}
#define LDS_WAIT() asm volatile("s_waitcnt lgkmcnt(0)" ::: "memory")

__device__ __forceinline__ void s5_table_item(const Ctx& C, int l, int g, int part);
__device__ __forceinline__ void transpose_item(const float* W, int ldw, int col0, bf16_t* WT, int K, int drow0, int k0, LAS float* scr, int lane) {
#pragma unroll 8
    for (int i = 0; i < 32; ++i) { const int kk = 2 * i + (lane >> 5); scr[kk * 33 + (lane & 31)] = W[(size_t)(k0 + kk) * ldw + col0 + (lane & 31)]; }
    LDS_WAIT(); asm volatile("" ::: "memory");
    const int c = lane & 7;
#pragma unroll
    for (int j = 0; j < 4; ++j) { const int n = (lane >> 3) + 8 * j; const LAS float* s = scr + (8 * c) * 33 + n;
        u32x4 o; o.x = pk2(s[0 * 33], s[1 * 33]); o.y = pk2(s[2 * 33], s[3 * 33]); o.z = pk2(s[4 * 33], s[5 * 33]); o.w = pk2(s[6 * 33], s[7 * 33]);
        *(u32x4*)(WT + (size_t)(drow0 + n) * K + k0 + 8 * c) = o; }
    LDS_WAIT(); asm volatile("" ::: "memory");
}
__device__ __forceinline__ void p_prologue(const Ctx& C) {
    LAS float* scr = (LAS float*)(C.lds + C.wave * 8448);
    const int gw = C.bid * 8 + C.wave, NGW = C.G * 8;
    constexpr int N_IN = 16 * 72, N_OUT = 16 * 32, N_FI = 16 * 176, N_FO = 44 * 32, N_GL = 4 * 8, N_L = N_IN + N_OUT + N_FI + N_FO + N_GL;
    for (int it = gw; it < 2 * N_L; it += NGW) {
        const int l = it / N_L; int r = it % N_L; unsigned char* wt = C.ws + WS_WT + (size_t)l * WT_LAYER;
        if (r < N_IN) { const int kb = r / 72, nb = r % 72; transpose_item(C.in[I_WIN] + (size_t)l * D * PIN, PIN, nb * 32 + (nb >= 32 ? 16 : 0), (bf16_t*)(wt + WT_IN), D, nb * 32, kb * 64, scr, C.lane); continue; } r -= N_IN;
        if (r < N_OUT) { const int kb = r / 32, nb = r % 32; transpose_item(C.in[I_WOUT] + (size_t)l * D * D, D, nb * 32, (bf16_t*)(wt + WT_OUT), D, nb * 32, kb * 64, scr, C.lane); continue; } r -= N_OUT;
        if (r < N_FI) { const int kb = r / 176, nb = r % 176, dr = nb * 32, pn = dr >> 8, bj = (dr >> 7) & 1, jj = dr & 127;
            transpose_item(C.in[I_WFFIN] + (size_t)l * D * 2 * DFF, 2 * DFF, bj * DFF + pn * 128 + jj, (bf16_t*)(wt + WT_FFIN), D, dr, kb * 64, scr, C.lane); continue; } r -= N_FI;
        if (r < N_FO) { const int kb = r / 32, nb = r % 32; transpose_item(C.in[I_WFFOUT] + (size_t)l * DFF * D, D, nb * 32, (bf16_t*)(wt + WT_FFOUT), DFF, nb * 32, kb * 64, scr, C.lane); continue; } r -= N_FO;
        { const int kb = r / 8, nb = r % 8; transpose_item(C.in[I_GLUW] + (size_t)l * 65536, 256, nb * 32, (bf16_t*)(wt + WT_GLU), 256, nb * 32, kb * 64, scr, C.lane); }
    }
    __syncthreads();
    LAS float* sc = (LAS float*)C.lds; LAS float* red = (LAS float*)(C.lds + 69632);
    if (C.bid < 192) {
        for (int idx = C.tid; idx < 17 * 1024; idx += 512) { const int i = idx >> 10, k = idx & 1023; const float v = i < 16 ? C.in[I_C][i * 1024 + k] : C.in[I_CCTX][k]; sc[idx] = v / (1.0f + expf(-v)); }
        __syncthreads();
        float* MOD = (float*)(C.ws + WS_MOD);
        for (int item = C.bid; item < 192; item += C.G) {
            const int l = item / 96, j = (item % 96) * 64 + C.lane; const float* w = C.in[I_WMOD] + (size_t)l * D * 6144 + j;
            float acc[17];
#pragma unroll
            for (int i = 0; i < 17; ++i) acc[i] = 0.f;
            for (int k = C.wave * 128; k < C.wave * 128 + 128; ++k) { const float wv = w[(size_t)k * 6144];
#pragma unroll
                for (int i = 0; i < 17; ++i) acc[i] += sc[i * 1024 + k] * wv; }
#pragma unroll
            for (int i = 0; i < 17; ++i) red[(C.wave * 17 + i) * 64 + C.lane] = acc[i];
            __syncthreads();
            for (int i = C.wave; i < 17; i += 8) { float s = 0.f;
#pragma unroll
                for (int w8 = 0; w8 < 8; ++w8) s += red[(w8 * 17 + i) * 64 + C.lane];
                MOD[(size_t)(l * 17 + i) * 6144 + j] = s + C.in[I_BMOD][l * 6144 + j]; }
            __syncthreads();
        }
    }
    __syncthreads();
    for (int it = C.bid; it < 256; it += C.G) s5_table_item(C, it >> 7, (it >> 3) & 15, it & 7);
}

__device__ __forceinline__ void p_rowpass(const Ctx& C, int mode, int l) {
    const bool doLN = mode != 0, doH = !(mode == 2 && l == 1), doG = (mode == 0) || (mode == 2 && l == 0);
    const int nrows = (mode == 0 || l == 0) ? NROWS : NLAT;
    const int lm = (mode == 2) ? l + 1 : l;
    const float* MOD = (const float*)(C.ws + WS_MOD) + (size_t)(lm < 2 ? lm : 1) * 17 * 6144; const int osh = (mode == 1) ? 3072 : 0, osc = (mode == 1) ? 4096 : 1024;
    const float* lnw = C.in[mode == 1 ? I_LN1W : I_LN2W] + l * D; const float* lnb = C.in[mode == 1 ? I_LN1B : I_LN2B] + l * D;
    LAS float* wgT = (LAS float*)C.lds;
    if (doG) { const float* wg = C.in[I_WIN] + (size_t)lm * D * PIN + 1024;
        for (int idx = C.tid; idx < 16 * 1024; idx += 512) { const int k = idx >> 4, gi = idx & 15; wgT[gi * 1024 + k] = wg[(size_t)k * PIN + gi]; }
        __syncthreads(); }
    bf16_t* H = (bf16_t*)(C.ws + WS_HY); float* XC = (float*)(C.ws + WS_XC); float* GT = (float*)(C.ws + WS_GATES);
    for (int row = C.bid * 8 + C.wave; row < nrows; row += C.G * 8) {
        const bool lat = row < NLAT; const int mi = lat ? (row >> 11) : 16;
        float* xrow = lat ? C.out + (size_t)row * D : XC + (size_t)(row - NLAT) * D;
        const float* src = (mode == 0) ? (lat ? C.in[I_X] + (size_t)row * D : C.in[I_CTX] + (size_t)(row - NLAT) * D) : xrow;
        f32x4 v[4];
#pragma unroll
        for (int j = 0; j < 4; ++j) v[j] = *(const f32x4*)(src + 4 * C.lane + 256 * j);
        if (doLN) {
            float s = 0.f;
#pragma unroll
            for (int j = 0; j < 4; ++j) s += (v[j][0] + v[j][1]) + (v[j][2] + v[j][3]);
            const float mean = wave_sum(s) * (1.0f / D); float q = 0.f;
#pragma unroll
            for (int j = 0; j < 4; ++j) { v[j] = v[j] - mean; q += (v[j][0] * v[j][0] + v[j][1] * v[j][1]) + (v[j][2] * v[j][2] + v[j][3] * v[j][3]); }
            const float rstd = 1.0f / sqrtf(wave_sum(q) * (1.0f / D) + LN_EPS);
#pragma unroll
            for (int j = 0; j < 4; ++j) { const f32x4 w = *(const f32x4*)(lnw + 4 * C.lane + 256 * j), b = *(const f32x4*)(lnb + 4 * C.lane + 256 * j); v[j] = v[j] * rstd * w + b; *(f32x4*)(xrow + 4 * C.lane + 256 * j) = v[j]; }
        }
        if (doH) {
            const float* mp = MOD + (size_t)mi * 6144;
#pragma unroll
            for (int j = 0; j < 4; ++j) { const f32x4 sh = *(const f32x4*)(mp + osh + 4 * C.lane + 256 * j), scv = *(const f32x4*)(mp + osc + 4 * C.lane + 256 * j); v[j] = v[j] * (scv + 1.0f) + sh;
                unsigned long long o = (unsigned long long)pk2(v[j][0], v[j][1]) | ((unsigned long long)pk2(v[j][2], v[j][3]) << 32); *(unsigned long long*)(H + (size_t)row * D + 4 * C.lane + 256 * j) = o; }
            if (doG) {
                float keep = 0.f;
#pragma unroll 1
                for (int gi = 0; gi < 16; ++gi) { float p = 0.f;
#pragma unroll
                    for (int j = 0; j < 4; ++j) { const f32x4 w = *(const LAS f32x4*)(wgT + gi * 1024 + 4 * C.lane + 256 * j); p += (v[j][0] * w[0] + v[j][1] * w[1]) + (v[j][2] * w[2] + v[j][3] * w[3]); }
                    p = wave_sum(p); if (C.lane == gi) keep = p; }
                if (C.lane < 16) GT[(size_t)row * 16 + C.lane] = keep + C.in[I_GBIAS][lm * 16 + C.lane];
            }
        }
    }
}
#define XB_TMO      128
#define XB_XCNT(j)  (256  + 64 * (j))
#define XB_XSUB(j)  (1280 + 64 * (j))
#define XB_XGEN(j)  (2304 + 64 * (j))
#define XB_TOP      3328
#define XB_TOPGEN   3392
#define XCD_BAR_WORDS 3456
#define XB_SPIN_CAP (1u << 20)
__device__ __forceinline__ unsigned xb_ld(unsigned* p)              { return __hip_atomic_load(p, __ATOMIC_RELAXED, __HIP_MEMORY_SCOPE_AGENT); }
__device__ __forceinline__ unsigned xb_add(unsigned* p, unsigned v) { return __hip_atomic_fetch_add(p, v, __ATOMIC_RELAXED, __HIP_MEMORY_SCOPE_AGENT); }
__device__ __forceinline__ unsigned xb_xcc_id() { return (unsigned)__builtin_amdgcn_s_getreg((3 << 11) | 20) & 0xFu; }
#define XB_SPIN(cond, bar) do { unsigned _sp = 0; while (cond) { __builtin_amdgcn_s_sleep(1); \
    if ((++_sp & 255u) == 0u) { if (xb_ld(&(bar)[XB_TMO])) break; if (_sp > XB_SPIN_CAP) { atomicAdd(&(bar)[XB_TMO], 1u); break; } } } } while (0)
struct XcdBarrier { unsigned* bar; unsigned x; volatile LAS unsigned* st; };
__device__ __forceinline__ XcdBarrier xcd_barrier_post(unsigned* bar, volatile LAS unsigned* st) {
    XcdBarrier b; b.bar = bar; b.x = xb_xcc_id(); b.st = st;
    if (threadIdx.x == 0) (void)xb_add(&bar[XB_XCNT(b.x)], 1u);
    return b;
}
__device__ __forceinline__ void xcd_barrier_complete(unsigned* bar, unsigned x, unsigned& nloc, unsigned& nx) {
    const unsigned G = gridDim.x * gridDim.y * gridDim.z;
    unsigned sum, cnt, mine, sp = 0u;
    for (;;) {
        sum = 0u; cnt = 0u; mine = 0u;
#pragma unroll
        for (unsigned j = 0; j < 16; ++j) { const unsigned c = xb_ld(&bar[XB_XCNT(j)]); sum += c; cnt += (c > 0u) ? 1u : 0u; mine = (j == x) ? c : mine; }
        if (sum == G) break;
        __builtin_amdgcn_s_sleep(1);
        if ((++sp & 255u) == 0u) { if (xb_ld(&bar[XB_TMO])) break; if (sp > XB_SPIN_CAP) { atomicAdd(&bar[XB_TMO], 1u); break; } }
    }
    nloc = mine > 0u ? mine : 1u; nx = cnt > 0u ? cnt : 1u;
}
__device__ __forceinline__ void xcd_barrier(const XcdBarrier& b) {
    asm volatile("s_waitcnt vmcnt(0)" ::: "memory");
    __syncthreads();
    if (threadIdx.x == 0) {
        unsigned* bar = b.bar;
        __builtin_amdgcn_s_waitcnt(0);
        unsigned nloc = b.st[0], nx = b.st[1];
        if (nloc == 0u) { xcd_barrier_complete(bar, b.x, nloc, nx); b.st[0] = nloc; b.st[1] = nx; }
        const unsigned old = xb_add(&bar[XB_XSUB(b.x)], 1u);
        const unsigned gen = old / nloc;
        if (old + 1u == (gen + 1u) * nloc) {
            __builtin_amdgcn_fence(__ATOMIC_RELEASE, "agent");
            asm volatile("s_waitcnt vmcnt(0)" ::: "memory");
            const unsigned og = xb_add(&bar[XB_TOP], 1u);
            const unsigned tg = og / nx;
            if (og + 1u == (tg + 1u) * nx) xb_add(&bar[XB_TOPGEN], 1u);
            else XB_SPIN(xb_ld(&bar[XB_TOPGEN]) == tg, bar);
            __builtin_amdgcn_fence(__ATOMIC_ACQUIRE, "agent");
            xb_add(&bar[XB_XGEN(b.x)], 1u);
            asm volatile("s_waitcnt vmcnt(0)" ::: "memory");
        } else {
            XB_SPIN(xb_ld(&bar[XB_XGEN(b.x)]) == gen, bar);
            __builtin_amdgcn_fence(__ATOMIC_ACQUIRE, "agent");
            asm volatile("s_waitcnt vmcnt(0)" ::: "memory");
        }
    }
    __syncthreads();
}
__device__ __forceinline__ void nv_mlstm_chain(const Ctx& C, int b, int hd, int dir) {
    const bf16_t* Z = (const bf16_t*)(C.ws + WS_Z); const float* GT = (const float*)(C.ws + WS_GATES); float* HS = (float*)(C.ws + WS_HSUM);
    LAS float* qkv = (LAS float*)C.lds; LAS float* red = qkv + 192;
    const int tid = C.tid, vrow = tid >> 3, k0 = (tid & 7) * 8;
    float Cst[8]; for (int e = 0; e < 8; ++e) Cst[e] = 0.f;
    float nk = 0.f, m = 0.f, r0 = 0.f, ig_n, fg_n; int row_n;
#define NV_LOAD(j) do { const int row_ = chain_row(b, dir, (j)); row_n = row_; const bf16_t* zr = Z + (size_t)row_ * ZLD + hd * 64; \
        if (tid < 64) r0 = bf2f(zr[tid]); else if (tid < 128) r0 = bf2f(zr[256 + tid - 64]) * 0.125f; else if (tid < 192) r0 = bf2f(zr[512 + tid - 128]); \
        ig_n = GT[(size_t)row_ * 16 + dir * 8 + hd]; fg_n = GT[(size_t)row_ * 16 + dir * 8 + 4 + hd]; } while (0)
    NV_LOAD(0);
    for (int j = 0; j < CTXL + SEQ; ++j) {
        if (tid < 192) qkv[tid] = r0;
        const float ig = ig_n, lf = logsig(fg_n); const int row = row_n;
        __syncthreads();
        if (j + 1 < CTXL + SEQ) NV_LOAD(j + 1);
        const float mn = fmaxf(lf + m, ig), fdec = expf(lf + m - mn), iw = expf(ig - mn);
        if (tid < 64) { nk = fdec * nk + iw * qkv[64 + tid]; const float d = wave_sum(nk * qkv[tid]); if (tid == 0) red[0] = d; }
        const float vv = qkv[128 + vrow] * iw; float part = 0.f;
#pragma unroll
        for (int e = 0; e < 8; ++e) { Cst[e] = fdec * Cst[e] + vv * qkv[64 + k0 + e]; part += Cst[e] * qkv[k0 + e]; }
        part += __shfl_xor(part, 1); part += __shfl_xor(part, 2); part += __shfl_xor(part, 4);
        __syncthreads();
        const float den = red[0], h = part / fmaxf(fabsf(den), expf(-mn));
        if ((tid & 7) == 0) { float* hp = HS + (size_t)row * 256 + hd * 64 + vrow; if (dir) *hp += h; else *hp = h; }
        m = mn;
    }
#undef NV_LOAD
    __syncthreads();
}
__device__ __forceinline__ void nv_s5_item(const Ctx& C, int l, int b, int gh, int dir) {
    const bf16_t* UH = (const bf16_t*)(C.ws + WS_UH); float* Y32 = (float*)(C.ws + WS_Y32);
    const int g = gh * 8 + C.wave, n = C.lane;
    LAS float* base = (LAS float*)(C.lds + C.wave * 17920);
    LAS float* xr = base; LAS float* xi = base + 16 * 65; LAS float* cre = base + 2 * 16 * 65; LAS float* cim = cre + 1024; LAS float* us = cim + 1024;
    const float are = C.in[I_ARE][((l * 2 + dir) * 16 + g) * 64 + n], aim = C.in[I_AIM][((l * 2 + dir) * 16 + g) * 64 + n], dt = expf(C.in[I_LDT][(l * 2 + dir) * 16 + g]);
    const float mag = expf(are * dt), abr = mag * cosf(aim * dt), abi = mag * sinf(aim * dt), d2 = are * are + aim * aim;
    const float cr = ((abr - 1.f) * are + abi * aim) / d2, ci = (abi * are - (abr - 1.f) * aim) / d2;
    float br[16], bi[16];
#pragma unroll
    for (int q = 0; q < 16; ++q) { const float re = C.in[I_BRE][((size_t)(l * 16 + g) * 64 + n) * 16 + q], im = C.in[I_BIM][((size_t)(l * 16 + g) * 64 + n) * 16 + q]; br[q] = cr * re - ci * im; bi[q] = cr * im + ci * re; }
    for (int p = 0; p < 16; ++p) { cre[n * 16 + p] = C.in[I_CRE][((size_t)(l * 16 + g) * 16 + p) * 64 + n]; cim[n * 16 + p] = C.in[I_CIM][((size_t)(l * 16 + g) * 16 + p) * 64 + n]; }
    float sr = 0.f, si = 0.f;
    const int t_ = n >> 2, p0 = (n & 3) * 4;
    const f32x4 dv = *(const f32x4*)(C.in[I_DSK] + l * 256 + g * 16 + p0);
    for (int j0 = 0; j0 < CTXL + SEQ; j0 += 16) {
        { const int s = n >> 2, q0 = (n & 3) * 4, row = chain_row(b, dir, j0 + s); const bf16_t* up = UH + ((size_t)(g * NCH_S5 + (row >> 4)) * 512 + (row & 15) * 16 + q0);
#pragma unroll
          for (int e = 0; e < 4; ++e) us[s * 16 + q0 + e] = bf2f(up[e]); }
        __syncthreads();
        for (int s = 0; s < 16; ++s) { float bur = 0.f, bui = 0.f;
#pragma unroll
            for (int q = 0; q < 16; ++q) { const float uv = us[s * 16 + q]; bur += br[q] * uv; bui += bi[q] * uv; }
            const float nr = abr * sr - abi * si + bur, ni = abr * si + abi * sr + bui; sr = nr; si = ni; xr[s * 65 + n] = sr; xi[s * 65 + n] = si; }
        __syncthreads();
        f32x4 acc = {0.f, 0.f, 0.f, 0.f};
        for (int nn = 0; nn < 64; ++nn) { const float a = xr[t_ * 65 + nn], bq = xi[t_ * 65 + nn]; const f32x4 c1 = *(const LAS f32x4*)(cre + nn * 16 + p0), c2 = *(const LAS f32x4*)(cim + nn * 16 + p0); acc += c1 * a - c2 * bq; }
        const int row = chain_row(b, dir, j0 + t_); float* yp = Y32 + (size_t)row * 256 + g * 16 + p0;
        if (dir == 0) { f32x4 uu; uu[0] = us[t_ * 16 + p0]; uu[1] = us[t_ * 16 + p0 + 1]; uu[2] = us[t_ * 16 + p0 + 2]; uu[3] = us[t_ * 16 + p0 + 3]; *(f32x4*)yp = acc + dv * uu; }
        else { const f32x4 o = *(const f32x4*)yp; *(f32x4*)yp = o + acc; }
        __syncthreads();
    }
}
__device__ __forceinline__ void nv_glu_item(const Ctx& C, int l, int item) {
    const float* Y32 = (const float*)(C.ws + WS_Y32); bf16_t* Y = (bf16_t*)(C.ws + WS_HY); LAS float* ys = (LAS float*)C.lds;
    const int r0 = item * 32;
    for (int idx = C.tid; idx < 32 * 256; idx += 512) ys[idx] = gelu_t(Y32[(size_t)r0 * 256 + idx]);
    __syncthreads();
    const int c = C.tid & 255, th = C.tid >> 8; const float* w = C.in[I_GLUW] + (size_t)l * 65536 + c;
    float acc[16];
#pragma unroll
    for (int t = 0; t < 16; ++t) acc[t] = 0.f;
    for (int k = 0; k < 256; ++k) { const float wv = w[k * 256];
#pragma unroll
        for (int t = 0; t < 16; ++t) acc[t] += ys[(th * 16 + t) * 256 + k] * wv; }
    const float gb = C.in[I_GLUB][l * 256 + c];
#pragma unroll
    for (int t = 0; t < 16; ++t) { const int rr = th * 16 + t; Y[(size_t)(r0 + rr) * D + 768 + c] = (bf16_t)f2bf(ys[rr * 256 + c] * sigm(acc[t] + gb)); }
    __syncthreads();
}
__device__ __forceinline__ void nv_readout_row(const Ctx& C, int l, int row) {
    const float* HS = (const float*)(C.ws + WS_HSUM); const bf16_t* Z = (const bf16_t*)(C.ws + WS_Z); bf16_t* Y = (bf16_t*)(C.ws + WS_HY);
    const int ch = 4 * C.lane; f32x4 h = *(const f32x4*)(HS + (size_t)row * 256 + ch);
    float s = (h[0] + h[1]) + (h[2] + h[3]); s += __shfl_xor(s, 1); s += __shfl_xor(s, 2); s += __shfl_xor(s, 4); s += __shfl_xor(s, 8);
    const float mu = s * (1.0f / 64.0f); h = h - mu; float q = (h[0] * h[0] + h[1] * h[1]) + (h[2] * h[2] + h[3] * h[3]); q += __shfl_xor(q, 1); q += __shfl_xor(q, 2); q += __shfl_xor(q, 4); q += __shfl_xor(q, 8);
    const float rstd = 1.0f / sqrtf(q * (1.0f / 64.0f) + LN_EPS); const f32x4 nw = *(const f32x4*)(C.in[I_MNORM] + l * 256 + ch);
    const unsigned long long ow = *(const unsigned long long*)(Z + (size_t)row * ZLD + 768 + ch); const unsigned o0 = (unsigned)ow, o1 = (unsigned)(ow >> 32);
    const float y0 = h[0] * rstd * nw[0] * sigm(bflo(o0)), y1 = h[1] * rstd * nw[1] * sigm(bfhi(o0)), y2 = h[2] * rstd * nw[2] * sigm(bflo(o1)), y3 = h[3] * rstd * nw[3] * sigm(bfhi(o1));
    *(unsigned long long*)(Y + (size_t)row * D + ch) = (unsigned long long)pk2(y0, y1) | ((unsigned long long)pk2(y2, y3) << 32);
}
__device__ __forceinline__ void sgu_item(const Ctx& C, int l, int ci) {
    const bf16_t* Z = (const bf16_t*)(C.ws + WS_Z); bf16_t* Y = (bf16_t*)(C.ws + WS_HY); LAS float* V = (LAS float*)C.lds;
    const int r0 = ci < 256 ? ci * 128 : NLAT + (ci - 256) * 128;
    { const int ch = 4 * C.lane; const f32x4 lw = *(const f32x4*)(C.in[I_SLNW] + l * 256 + ch), lb = *(const f32x4*)(C.in[I_SLNB] + l * 256 + ch);
      for (int s = C.wave; s < 128; s += 8) {
        const unsigned long long zw = *(const unsigned long long*)(Z + (size_t)(r0 + s) * ZLD + 1280 + ch); const unsigned z0 = (unsigned)zw, z1 = (unsigned)(zw >> 32);
        f32x4 v = {gelu_t(bflo(z0)), gelu_t(bfhi(z0)), gelu_t(bflo(z1)), gelu_t(bfhi(z1))};
        const float mu = wave_sum((v[0] + v[1]) + (v[2] + v[3])) * (1.0f / 256.0f); v = v - mu;
        const float rstd = 1.0f / sqrtf(wave_sum((v[0] * v[0] + v[1] * v[1]) + (v[2] * v[2] + v[3] * v[3])) * (1.0f / 256.0f) + LN_EPS);
        *(LAS f32x4*)(V + s * 256 + ch) = v * rstd * lw + lb; } }
    __syncthreads();
    const int ch = C.tid & 255, g = __builtin_amdgcn_readfirstlane(C.wave & 3), th = __builtin_amdgcn_readfirstlane(C.wave >> 2);
    const float* ws = C.in[I_SW] + (size_t)(l * 4 + g) * 128 * 128; const float* bs = C.in[I_SB] + (l * 4 + g) * 128;
    for (int tb = 0; tb < 4; ++tb) { const int t0 = th * 64 + tb * 16; float acc[16];
#pragma unroll
        for (int t = 0; t < 16; ++t) acc[t] = 0.f;
        for (int s = 0; s < 128; s += 4) { const float v0 = V[s * 256 + ch], v1 = V[(s + 1) * 256 + ch], v2 = V[(s + 2) * 256 + ch], v3 = V[(s + 3) * 256 + ch];
#pragma unroll
            for (int t = 0; t < 16; ++t) { const f32x4 w = *(const f32x4*)(ws + (t0 + t) * 128 + s); acc[t] += (w[0] * v0 + w[1] * v1) + (w[2] * v2 + w[3] * v3); } }
#pragma unroll
        for (int t = 0; t < 16; ++t) { const int row = r0 + t0 + t; const float u = gelu_t(bf2f(Z[(size_t)row * ZLD + 1024 + ch])); Y[(size_t)row * D + 256 + ch] = (bf16_t)f2bf(u * (acc[t] + bs[t0 + t])); } }
    __syncthreads();
}
__device__ __forceinline__ void conv_item(const Ctx& C, int l, int ti) {
    const bf16_t* Z = (const bf16_t*)(C.ws + WS_Z); bf16_t* Y = (bf16_t*)(C.ws + WS_HY); LAS float* A = (LAS float*)C.lds;
    int r0, seg_lo, seg_len; if (ti < 512) { r0 = ti * 64; seg_lo = 0; seg_len = 64; } else { const int b = (ti - 512) >> 2, tq = (ti - 512) & 3; r0 = NLAT + b * 256 + tq * 64; seg_lo = tq * 64; seg_len = 256; }
    { const int ch = 4 * (C.tid & 63);
      for (int a = C.tid >> 6; a < 94; a += 8) { const int ts = seg_lo + a - 15; f32x4 v = {0.f, 0.f, 0.f, 0.f};
        if (ts >= 0 && ts < seg_len) { const bf16_t* zr = Z + (size_t)(r0 + a - 15) * ZLD + 1536 + ch; const unsigned long long vw = *(const unsigned long long*)zr, gw = *(const unsigned long long*)(zr + 256);
            const unsigned v0 = (unsigned)vw, v1 = (unsigned)(vw >> 32), g0 = (unsigned)gw, g1 = (unsigned)(gw >> 32);
            v[0] = bflo(v0) * sigm(bflo(g0)); v[1] = bfhi(v0) * sigm(bfhi(g0)); v[2] = bflo(v1) * sigm(bflo(g1)); v[3] = bfhi(v1) * sigm(bfhi(g1)); }
        *(LAS f32x4*)(A + a * 256 + ch) = v; } }
    __syncthreads();
    const int ch = C.tid & 255, th = C.tid >> 8; float o[32];
    { const float* cw = C.in[I_CW] + (size_t)l * 31 * 256 + ch; const float cb = C.in[I_CB][l * 256 + ch];
#pragma unroll
      for (int t = 0; t < 32; ++t) o[t] = cb;
      for (int j = 0; j < 31; ++j) { const float w = cw[j * 256];
#pragma unroll
        for (int t = 0; t < 32; ++t) o[t] += w * A[(th * 32 + t + j) * 256 + ch]; } }
    __syncthreads();
#pragma unroll
    for (int t = 0; t < 32; ++t) A[(th * 32 + t) * 256 + ch] = o[t];
    __syncthreads();
    { const int c4 = 4 * C.lane; const f32x4 lw = *(const f32x4*)(C.in[I_CLNW] + l * 256 + c4), lb = *(const f32x4*)(C.in[I_CLNB] + l * 256 + c4);
      for (int t = C.wave; t < 64; t += 8) { f32x4 v = *(const LAS f32x4*)(A + t * 256 + c4);
        const float mu = wave_sum((v[0] + v[1]) + (v[2] + v[3])) * (1.0f / 256.0f); v = v - mu;
        const float rstd = 1.0f / sqrtf(wave_sum((v[0] * v[0] + v[1] * v[1]) + (v[2] * v[2] + v[3] * v[3])) * (1.0f / 256.0f) + LN_EPS);
        v = v * rstd * lw + lb; const float y0 = v[0] * sigm(v[0]), y1 = v[1] * sigm(v[1]), y2 = v[2] * sigm(v[2]), y3 = v[3] * sigm(v[3]);
        *(unsigned long long*)(Y + (size_t)(r0 + t) * D + 512 + c4) = (unsigned long long)pk2(y0, y1) | ((unsigned long long)pk2(y2, y3) << 32); } }
    __syncthreads();
}
constexpr size_t MSN_OFF = 0, MSS_OFF = 2 * MiB, MSM_OFF = 3 * MiB;
__device__ __forceinline__ int ml_row0(int b, int c) { return c < 32 ? b * SEQ + 64 * c : NLAT + b * CTXL + 64 * (c - 32); }
__device__ __forceinline__ int ml_jf(int c) { return c < 32 ? 4 + c : c - 32; }
__device__ __forceinline__ int ml_jb(int c) { return c < 32 ? 35 - c : 35 - c; }
template <int K> __device__ __forceinline__ void lds_mma(f32x4& acc, const LAS bf16_t* A, int lda, const LAS bf16_t* B, int ldb, int lane) {
    const LAS bf16_t* ap = A + (lane & 15) * lda + 8 * (lane >> 4); const LAS bf16_t* bp = B + (lane & 15) * ldb + 8 * (lane >> 4);
#pragma unroll
    for (int k = 0; k < K; k += 32) { const bf16x8 a = *(const LAS bf16x8*)(ap + k), b = *(const LAS bf16x8*)(bp + k); acc = __builtin_amdgcn_mfma_f32_16x16x32_bf16(a, b, acc, 0, 0, 0); }
}
__device__ __forceinline__ float scan_add(float v, int lane) {
#pragma unroll
    for (int o = 1; o < 64; o <<= 1) { const float t = __shfl_up(v, o); if (lane >= o) v += t; }
    return v;
}
__device__ __forceinline__ float scan_max(float v, int lane) {
#pragma unroll
    for (int o = 1; o < 64; o <<= 1) { const float t = __shfl_up(v, o); if (lane >= o) v = fmaxf(v, t); }
    return v;
}
__device__ __forceinline__ float wave_max(float v) {
#pragma unroll
    for (int o = 1; o < 64; o <<= 1) v = fmaxf(v, __shfl_xor(v, o));
    return v;
}
constexpr int TS = 72;

__device__ __forceinline__ void ml_state_item(const Ctx& C, int b, int hd, int c) {
    const bf16_t* Z = (const bf16_t*)(C.ws + WS_Z); const float* GT = (const float*)(C.ws + WS_GATES);
    bf16_t* MST = (bf16_t*)(C.ws + WS_MST); float* MSN = (float*)(C.ws + WS_MISC + MSN_OFF); float* MSS = (float*)(C.ws + WS_MISC + MSS_OFF);
    LAS bf16_t* KT = (LAS bf16_t*)C.lds;
    LAS bf16_t* VE = KT + 64 * TS;
    LAS float* ef = (LAS float*)(VE + 144 * TS); LAS float* eb = ef + 64;
    const int r0 = ml_row0(b, c), tid = C.tid, lane = C.lane;
    const int s = tid >> 3, c8 = 8 * (tid & 7);
    const u32x4 kw = *(const u32x4*)(Z + (size_t)(r0 + s) * ZLD + 256 + hd * 64 + c8), vw = *(const u32x4*)(Z + (size_t)(r0 + s) * ZLD + 512 + hd * 64 + c8);
    if (C.wave < 2) { const int dir = C.wave, tok = dir ? 63 - lane : lane;
        const float ig = GT[(size_t)(r0 + tok) * 16 + dir * 8 + hd], lf = logsig(GT[(size_t)(r0 + tok) * 16 + dir * 8 + 4 + hd]);
        const float bb = scan_add(lf, lane), bend = __shfl(bb, 63), lu = bend - bb + ig, ml = wave_max(lu);
        (dir ? eb : ef)[tok] = expf(lu - ml);
        if (lane == 0) { const int chain = (b * 4 + hd) * 2 + dir, j = dir ? ml_jb(c) : ml_jf(c); MSS[(chain * 36 + j) * 2] = ml; MSS[(chain * 36 + j) * 2 + 1] = bend; } }
    for (int idx = tid; idx < 14 * TS; idx += 512) VE[130 * TS + idx] = 0;
    __syncthreads();
    { const float e0 = ef[s], e1 = eb[s]; const unsigned kk[4] = {kw.x, kw.y, kw.z, kw.w}, vv[4] = {vw.x, vw.y, vw.z, vw.w};
#pragma unroll
      for (int e = 0; e < 4; ++e) { const float k0 = bflo(kk[e]) * 0.125f, k1 = bfhi(kk[e]) * 0.125f, v0 = bflo(vv[e]), v1 = bfhi(vv[e]);
        KT[(c8 + 2 * e) * TS + s] = (bf16_t)f2bf(k0); KT[(c8 + 2 * e + 1) * TS + s] = (bf16_t)f2bf(k1);
        VE[(c8 + 2 * e) * TS + s] = (bf16_t)f2bf(v0 * e0); VE[(c8 + 2 * e + 1) * TS + s] = (bf16_t)f2bf(v1 * e0);
        VE[(64 + c8 + 2 * e) * TS + s] = (bf16_t)f2bf(v0 * e1); VE[(64 + c8 + 2 * e + 1) * TS + s] = (bf16_t)f2bf(v1 * e1); }
      if (tid < 64) { VE[128 * TS + tid] = (bf16_t)f2bf(ef[tid]); VE[129 * TS + tid] = (bf16_t)f2bf(eb[tid]); } }
    __syncthreads();
    const int chf = (b * 4 + hd) * 2, jf = ml_jf(c), jb = ml_jb(c);
    for (int t = C.wave; t < 36; t += 8) { const int mt = t & 3, nt = t >> 2; f32x4 acc = {0.f, 0.f, 0.f, 0.f};
        lds_mma<64>(acc, KT + mt * 16 * TS, TS, VE + nt * 16 * TS, TS, lane);
        const int k = mt * 16 + 4 * (lane >> 4), n = nt * 16 + (lane & 15);
        if (n < 128) { const int dir = n >> 6, v = n & 63; bf16_t* dst = MST + ((size_t)((chf + dir) * 36 + (dir ? jb : jf)) * 4096 + v * 64 + k);
            *(unsigned long long*)dst = (unsigned long long)cvt_pk_bf16(acc[0], acc[1]) | ((unsigned long long)cvt_pk_bf16(acc[2], acc[3]) << 32); }
        else if (n < 130) { const int dir = n - 128; *(f32x4*)(MSN + ((size_t)((chf + dir) * 36 + (dir ? jb : jf)) * 64 + k)) = acc; } }
    __syncthreads();
}
__device__ __forceinline__ void ml_carry_item(const Ctx& C, int item) {
    const int chain = item >> 1, half = item & 1, tid = C.tid;
    bf16_t* base = (bf16_t*)(C.ws + WS_MST) + (size_t)chain * 36 * 4096 + half * 2048 + tid * 4;
    float* MSN = (float*)(C.ws + WS_MISC + MSN_OFF) + (size_t)chain * 36 * 64; const float* MSS = (const float*)(C.ws + WS_MISC + MSS_OFF) + chain * 72; float* MSM = (float*)(C.ws + WS_MISC + MSM_OFF) + chain * 36;
    unsigned long long v[36]; float nn[36];
#pragma unroll
    for (int j = 0; j < 36; ++j) v[j] = *(const unsigned long long*)(base + (size_t)j * 4096);
    const bool don = (half == 0 && tid < 64);
    if (don) {
#pragma unroll
        for (int j = 0; j < 36; ++j) nn[j] = MSN[j * 64 + tid]; }
    float c0 = 0.f, c1 = 0.f, c2 = 0.f, c3 = 0.f, nk = 0.f, m = 0.f;
#pragma unroll
    for (int j = 0; j < 36; ++j) {
        const float ml = MSS[2 * j], be = MSS[2 * j + 1], mn = fmaxf(be + m, ml), dec = expf(be + m - mn), sc = expf(ml - mn);
        *(unsigned long long*)(base + (size_t)j * 4096) = (unsigned long long)cvt_pk_bf16(c0, c1) | ((unsigned long long)cvt_pk_bf16(c2, c3) << 32);
        if (half == 0 && tid == 0) MSM[j] = m;
        const unsigned lo = (unsigned)v[j], hi = (unsigned)(v[j] >> 32);
        c0 = dec * c0 + sc * bflo(lo); c1 = dec * c1 + sc * bfhi(lo); c2 = dec * c2 + sc * bflo(hi); c3 = dec * c3 + sc * bfhi(hi);
        if (don) { MSN[j * 64 + tid] = nk; nk = dec * nk + sc * nn[j]; }
        m = mn;
    }
}
__device__ __forceinline__ void ml_out_item(const Ctx& C, int l, int b, int hd, int c) {
    const bf16_t* Z = (const bf16_t*)(C.ws + WS_Z); const float* GT = (const float*)(C.ws + WS_GATES); bf16_t* Y = (bf16_t*)(C.ws + WS_HY);
    const bf16_t* MST = (const bf16_t*)(C.ws + WS_MST); const float* MSN = (const float*)(C.ws + WS_MISC + MSN_OFF); const float* MSM = (const float*)(C.ws + WS_MISC + MSM_OFF);
    LAS bf16_t* Qs = (LAS bf16_t*)C.lds; LAS bf16_t* Ks = Qs + 64 * TS; LAS bf16_t* VT = Ks + 64 * TS; LAS bf16_t* CF = VT + 64 * TS; LAS bf16_t* CB = CF + 64 * TS;
    LAS float* QK = (LAS float*)(C.lds + 46080);
    LAS bf16_t* AP = (LAS bf16_t*)(C.lds + 63488);
    LAS float* sc = (LAS float*)(C.lds + 89088);
    const int r0 = ml_row0(b, c), tid = C.tid, lane = C.lane, chf = (b * 4 + hd) * 2, jf = ml_jf(c), jb = ml_jb(c);
    const int s = tid >> 3, c8 = 8 * (tid & 7);
    { const bf16_t* zr = Z + (size_t)(r0 + s) * ZLD + hd * 64 + c8;
      const u32x4 qw = *(const u32x4*)zr, kw = *(const u32x4*)(zr + 256), vw = *(const u32x4*)(zr + 512);
      const u32x4 cf = *(const u32x4*)(MST + (size_t)((chf) * 36 + jf) * 4096 + s * 64 + c8), cb = *(const u32x4*)(MST + (size_t)((chf + 1) * 36 + jb) * 4096 + s * 64 + c8);
      if (C.wave < 2) { const int dir = C.wave, tok = dir ? 63 - lane : lane; LAS float* sd = sc + dir * 256;
        const float ig = GT[(size_t)(r0 + tok) * 16 + dir * 8 + hd], lf = logsig(GT[(size_t)(r0 + tok) * 16 + dir * 8 + 4 + hd]), min_ = MSM[(chf + dir) * 36 + (dir ? jb : jf)];
        const float bb = scan_add(lf, lane), a = ig - bb, pm = scan_max(a, lane), mx = fmaxf(min_, pm);
        sd[tok] = -mx; sd[64 + tok] = a; sd[128 + tok] = expf(min_ - mx); sd[192 + tok] = expf(-(bb + mx));
        sc[512 + dir * 64 + lane] = MSN[(size_t)((chf + dir) * 36 + (dir ? jb : jf)) * 64 + lane]; }
      *(LAS u32x4*)(Qs + s * TS + c8) = qw; *(LAS u32x4*)(CF + s * TS + c8) = cf; *(LAS u32x4*)(CB + s * TS + c8) = cb;
      const unsigned kk[4] = {kw.x, kw.y, kw.z, kw.w}, vv[4] = {vw.x, vw.y, vw.z, vw.w}; u32x4 ks;
      ks.x = cvt_pk_bf16(bflo(kk[0]) * 0.125f, bfhi(kk[0]) * 0.125f); ks.y = cvt_pk_bf16(bflo(kk[1]) * 0.125f, bfhi(kk[1]) * 0.125f); ks.z = cvt_pk_bf16(bflo(kk[2]) * 0.125f, bfhi(kk[2]) * 0.125f); ks.w = cvt_pk_bf16(bflo(kk[3]) * 0.125f, bfhi(kk[3]) * 0.125f);
      *(LAS u32x4*)(Ks + s * TS + c8) = ks;
#pragma unroll
      for (int e = 0; e < 4; ++e) { VT[(c8 + 2 * e) * TS + s] = (bf16_t)(vv[e] & 0xffffu); VT[(c8 + 2 * e + 1) * TS + s] = (bf16_t)(vv[e] >> 16); } }
    __syncthreads();
    for (int t = C.wave; t < 16; t += 8) { const int mt = t >> 2, nt = t & 3; f32x4 acc = {0.f, 0.f, 0.f, 0.f};
        lds_mma<64>(acc, Qs + mt * 16 * TS, TS, Ks + nt * 16 * TS, TS, lane);
#pragma unroll
        for (int r = 0; r < 4; ++r) QK[(mt * 16 + 4 * (lane >> 4) + r) * 68 + nt * 16 + (lane & 15)] = acc[r]; }
    __syncthreads();
    { const int t = tid >> 3, s0 = 8 * (tid & 7);
      const float rtf = sc[t], wf = sc[128 + t], emf = sc[192 + t], rtb = sc[256 + t], wb = sc[256 + 128 + t], emb = sc[256 + 192 + t];
      float sf[8], sb[8], rsf = 0.f, rsb = 0.f, qnf = 0.f, qnb = 0.f;
      const u32x4 qw = *(const LAS u32x4*)(Qs + t * TS + s0); const unsigned qq[4] = {qw.x, qw.y, qw.z, qw.w}; float qv[8];
#pragma unroll
      for (int e = 0; e < 4; ++e) { qv[2 * e] = bflo(qq[e]); qv[2 * e + 1] = bfhi(qq[e]); }
#pragma unroll
      for (int e = 0; e < 8; ++e) { const int ss = s0 + e; const float qk = QK[t * 68 + ss];
        sf[e] = (ss <= t) ? qk * expf(rtf + sc[64 + ss]) : 0.f; sb[e] = (ss >= t) ? qk * expf(rtb + sc[256 + 64 + ss]) : 0.f; rsf += sf[e]; rsb += sb[e];
        qnf += qv[e] * sc[512 + ss]; qnb += qv[e] * sc[576 + ss]; }
#pragma unroll
      for (int o = 1; o < 8; o <<= 1) { rsf += __shfl_xor(rsf, o); rsb += __shfl_xor(rsb, o); qnf += __shfl_xor(qnf, o); qnb += __shfl_xor(qnb, o); }
      const float idf = 1.0f / fmaxf(fabsf(rsf + wf * qnf), emf), idb = 1.0f / fmaxf(fabsf(rsb + wb * qnb), emb), qf = wf * idf, qb = wb * idb;
      u32x4 pw, fw, bw;
      pw.x = cvt_pk_bf16(sf[0] * idf + sb[0] * idb, sf[1] * idf + sb[1] * idb); pw.y = cvt_pk_bf16(sf[2] * idf + sb[2] * idb, sf[3] * idf + sb[3] * idb);
      pw.z = cvt_pk_bf16(sf[4] * idf + sb[4] * idb, sf[5] * idf + sb[5] * idb); pw.w = cvt_pk_bf16(sf[6] * idf + sb[6] * idb, sf[7] * idf + sb[7] * idb);
      fw.x = cvt_pk_bf16(qv[0] * qf, qv[1] * qf); fw.y = cvt_pk_bf16(qv[2] * qf, qv[3] * qf); fw.z = cvt_pk_bf16(qv[4] * qf, qv[5] * qf); fw.w = cvt_pk_bf16(qv[6] * qf, qv[7] * qf);
      bw.x = cvt_pk_bf16(qv[0] * qb, qv[1] * qb); bw.y = cvt_pk_bf16(qv[2] * qb, qv[3] * qb); bw.z = cvt_pk_bf16(qv[4] * qb, qv[5] * qb); bw.w = cvt_pk_bf16(qv[6] * qb, qv[7] * qb);
      *(LAS u32x4*)(AP + t * 200 + s0) = pw; *(LAS u32x4*)(AP + t * 200 + 64 + s0) = fw; *(LAS u32x4*)(AP + t * 200 + 128 + s0) = bw; }
    __syncthreads();
    for (int t = C.wave; t < 16; t += 8) { const int mt = t >> 2, nt = t & 3; f32x4 acc = {0.f, 0.f, 0.f, 0.f};
        lds_mma<64>(acc, AP + mt * 16 * 200, 200, VT + nt * 16 * TS, TS, lane);
        lds_mma<64>(acc, AP + mt * 16 * 200 + 64, 200, CF + nt * 16 * TS, TS, lane);
        lds_mma<64>(acc, AP + mt * 16 * 200 + 128, 200, CB + nt * 16 * TS, TS, lane);
#pragma unroll
        for (int r = 0; r < 4; ++r) QK[(mt * 16 + 4 * (lane >> 4) + r) * 68 + nt * 16 + (lane & 15)] = acc[r]; }
    __syncthreads();
    { const int t = tid >> 3, v0 = 8 * (tid & 7); float h[8]; float sm = 0.f;
#pragma unroll
      for (int e = 0; e < 8; ++e) { h[e] = QK[t * 68 + v0 + e]; sm += h[e]; }
      sm += __shfl_xor(sm, 1); sm += __shfl_xor(sm, 2); sm += __shfl_xor(sm, 4); const float mu = sm * (1.0f / 64.0f); float q = 0.f;
#pragma unroll
      for (int e = 0; e < 8; ++e) { h[e] -= mu; q += h[e] * h[e]; }
      q += __shfl_xor(q, 1); q += __shfl_xor(q, 2); q += __shfl_xor(q, 4); const float rstd = 1.0f / sqrtf(q * (1.0f / 64.0f) + LN_EPS);
      const float* nw = C.in[I_MNORM] + l * 256 + hd * 64 + v0; const u32x4 ow = *(const u32x4*)(Z + (size_t)(r0 + t) * ZLD + 768 + hd * 64 + v0); const unsigned oo[4] = {ow.x, ow.y, ow.z, ow.w};
      float y[8];
#pragma unroll
      for (int e = 0; e < 4; ++e) { y[2 * e] = h[2 * e] * rstd * nw[2 * e] * sigm(bflo(oo[e])); y[2 * e + 1] = h[2 * e + 1] * rstd * nw[2 * e + 1] * sigm(bfhi(oo[e])); }
      u32x4 w; w.x = cvt_pk_bf16(y[0], y[1]); w.y = cvt_pk_bf16(y[2], y[3]); w.z = cvt_pk_bf16(y[4], y[5]); w.w = cvt_pk_bf16(y[6], y[7]);
      *(u32x4*)(Y + (size_t)(r0 + t) * D + hd * 64 + v0) = w; }
    __syncthreads();
}
__device__ __forceinline__ const bf16_t* wt_ptr(const Ctx& C, int l, size_t off) { return (const bf16_t*)(C.ws + WS_WT + (size_t)l * WT_LAYER + off); }
template <class Epi> __device__ __forceinline__ void run_gemm(const Ctx& C, const Gemm& g, const Epi& E) {
    StaticOrder S; S.init(g.M, g.N, C.G, C.bid);
    gemm_phase<Epi, StaticOrder, true, true>(C.lds, g, S, E);
}
__device__ __forceinline__ void p_inproj(const Ctx& C, int l) {
    Gemm g{(const bf16_t*)(C.ws + WS_HY), wt_ptr(C, l, WT_IN), NROWS, 2304, D, D, D, 0, 0};
    EpiInProj E{(bf16_t*)(C.ws + WS_Z), (bf16_t*)(C.ws + WS_UH)}; run_gemm(C, g, E);
}
__device__ __forceinline__ void p_outproj(const Ctx& C, int l) {
    Gemm g{(const bf16_t*)(C.ws + WS_HY), wt_ptr(C, l, WT_OUT), l == 0 ? NROWS : NLAT, D, D, D, D, 0, 0};
    float* XC = (float*)(C.ws + WS_XC);
    EpiResGate E{l == 0 ? C.in[I_X] : C.out, l == 0 ? C.in[I_CTX] : XC, C.out, XC, (const float*)(C.ws + WS_MOD) + (size_t)l * 17 * 6144 + 2048, ALPHA}; run_gemm(C, g, E);
}
__device__ __forceinline__ void p_ffnin(const Ctx& C, int l) {
    Gemm g{(const bf16_t*)(C.ws + WS_HY), wt_ptr(C, l, WT_FFIN), l == 0 ? NROWS : NLAT, 2 * DFF, D, D, D, 0, 0};
    EpiSwiGlu E{(bf16_t*)(C.ws + WS_ACT), DFF}; run_gemm(C, g, E);
}
__device__ __forceinline__ void p_ffnout(const Ctx& C, int l) {
    Gemm g{(const bf16_t*)(C.ws + WS_ACT), wt_ptr(C, l, WT_FFOUT), l == 0 ? NROWS : NLAT, D, DFF, DFF, DFF, 0, 0};
    float* XC = (float*)(C.ws + WS_XC);
    EpiResGate E{C.out, XC, C.out, XC, (const float*)(C.ws + WS_MOD) + (size_t)l * 17 * 6144 + 5120, ALPHA}; run_gemm(C, g, E);
}
__device__ __forceinline__ void s5_table_item(const Ctx& C, int l, int g, int part) {
    LAS float* APW = (LAS float*)C.lds;
    LAS float* BB = APW + 4352;
    LAS float* CC = BB + 4096;
    LAS float* KT = CC + 2048;
    const int tid = C.tid;
    if (tid < 128) { const int d = tid >> 6, n = tid & 63, ix = ((l * 2 + d) * 16 + g) * 64 + n;
        const double are = C.in[I_ARE][ix], aim = C.in[I_AIM][ix], dt = exp((double)C.in[I_LDT][(l * 2 + d) * 16 + g]);
        const double mag = exp(are * dt), abr = mag * cos(aim * dt), abi = mag * sin(aim * dt), d2 = are * are + aim * aim;
        const double cr = ((abr - 1.0) * are + abi * aim) / d2, ci = (abi * are - (abr - 1.0) * aim) / d2;
        double pr = 1.0, pi = 0.0;
        for (int k = 0; k < 17; ++k) { APW[((d * 17 + k) * 64 + n) * 2] = (float)pr; APW[((d * 17 + k) * 64 + n) * 2 + 1] = (float)pi; const double t = pr * abr - pi * abi; pi = pr * abi + pi * abr; pr = t; }
        for (int q = 0; q < 16; ++q) { const double re = C.in[I_BRE][((size_t)(l * 16 + g) * 64 + n) * 16 + q], im = C.in[I_BIM][((size_t)(l * 16 + g) * 64 + n) * 16 + q];
            BB[((d * 64 + n) * 16 + q) * 2] = (float)(cr * re - ci * im); BB[((d * 64 + n) * 16 + q) * 2 + 1] = (float)(cr * im + ci * re); } }
    for (int idx = tid; idx < 1024; idx += 512) { const int p = idx >> 6, n = idx & 63; CC[idx * 2] = C.in[I_CRE][((size_t)(l * 16 + g) * 16 + p) * 64 + n]; CC[idx * 2 + 1] = C.in[I_CIM][((size_t)(l * 16 + g) * 16 + p) * 64 + n]; }
    __syncthreads();
    { const int d = tid >> 8, k = (tid >> 4) & 15, p = tid & 15; float acc[16];
#pragma unroll
      for (int q = 0; q < 16; ++q) acc[q] = 0.f;
      for (int n = 0; n < 64; ++n) { const float cr = CC[(p * 64 + n) * 2], ci = CC[(p * 64 + n) * 2 + 1], ar = APW[((d * 17 + k) * 64 + n) * 2], ai = APW[((d * 17 + k) * 64 + n) * 2 + 1];
          const float zr = cr * ar - ci * ai, zi = cr * ai + ci * ar;
#pragma unroll
          for (int q = 0; q < 16; ++q) acc[q] += zr * BB[((d * 64 + n) * 16 + q) * 2] - zi * BB[((d * 64 + n) * 16 + q) * 2 + 1]; }
#pragma unroll
      for (int q = 0; q < 16; ++q) KT[((d * 16 + k) * 16 + p) * 16 + q] = acc[q]; }
    __syncthreads();
    bf16_t* BtY = (bf16_t*)(C.ws + WS_WT + (size_t)l * WT_LAYER + WT_BTY) + (size_t)g * 256 * 512; bf16_t* BtS = (bf16_t*)(C.ws + WS_WT + (size_t)l * WT_LAYER + WT_BTS) + (size_t)g * 256 * 256;
    for (int i = 0; i < 4; ++i) { const int idx = tid + 512 * i, row = part * 32 + (idx >> 6), col0 = (idx & 63) * 8, t = row >> 4, p = row & 15; float v[8];
        if (col0 < 256) { const int s = col0 >> 4, q0 = col0 & 15;
#pragma unroll
            for (int e = 0; e < 8; ++e) v[e] = s < t ? KT[((0 * 16 + (t - s)) * 16 + p) * 16 + q0 + e] : (s > t ? KT[((1 * 16 + (s - t)) * 16 + p) * 16 + q0 + e] : KT[(p) * 16 + q0 + e] + KT[((16) * 16 + p) * 16 + q0 + e]); }
        else { const int h0 = col0 - 256, ds = h0 >> 7, im = (h0 >> 6) & 1, n0 = h0 & 63, kp = ds ? 16 - t : t + 1;
#pragma unroll
            for (int e = 0; e < 8; ++e) { const int n = n0 + e; const float cr = CC[(p * 64 + n) * 2], ci = CC[(p * 64 + n) * 2 + 1], ar = APW[((ds * 17 + kp) * 64 + n) * 2], ai = APW[((ds * 17 + kp) * 64 + n) * 2 + 1];
                v[e] = im ? -(cr * ai + ci * ar) : (cr * ar - ci * ai); } }
        u32x4 w; w.x = cvt_pk_bf16(v[0], v[1]); w.y = cvt_pk_bf16(v[2], v[3]); w.z = cvt_pk_bf16(v[4], v[5]); w.w = cvt_pk_bf16(v[6], v[7]);
        *(u32x4*)(BtY + (size_t)row * 512 + col0) = w; }
    for (int i = 0; i < 2; ++i) { const int idx = tid + 512 * i, row = part * 32 + (idx >> 5), col0 = (idx & 31) * 8, s = col0 >> 4, q0 = col0 & 15, ds = row >> 7, im = (row >> 6) & 1, n = row & 63, kp = ds ? s : 15 - s;
        const float ar = APW[((ds * 17 + kp) * 64 + n) * 2], ai = APW[((ds * 17 + kp) * 64 + n) * 2 + 1]; float v[8];
#pragma unroll
        for (int e = 0; e < 8; ++e) { const float br = BB[((ds * 64 + n) * 16 + q0 + e) * 2], bi = BB[((ds * 64 + n) * 16 + q0 + e) * 2 + 1]; v[e] = im ? (ar * bi + ai * br) : (ar * br - ai * bi); }
        u32x4 w; w.x = cvt_pk_bf16(v[0], v[1]); w.y = cvt_pk_bf16(v[2], v[3]); w.z = cvt_pk_bf16(v[4], v[5]); w.w = cvt_pk_bf16(v[6], v[7]);
        *(u32x4*)(BtS + (size_t)row * 256 + col0) = w; }
    __syncthreads();
}
__device__ __forceinline__ int s5_chunk_id(int b, int dir, int j) { if (j < 16) return 2048 + b * 16 + (dir ? 15 - j : j); const int jl = j - 16; return b * 128 + (dir ? 127 - jl : jl); }
__device__ __forceinline__ void s5_carry_item(const Ctx& C, int l, int item) {
    const int gid = item * 512 + C.tid, n = gid & 63, dir = (gid >> 6) & 1, g = (gid >> 7) & 15, b = gid >> 11;
    const float* S = (const float*)(C.ws + WS_S5S) + (size_t)g * NCH_S5 * 256 + dir * 128 + n; bf16_t* Hh = (bf16_t*)(C.ws + WS_UH) + (size_t)g * NCH_S5 * 512 + 256 + dir * 128 + n;
    const int ix = ((l * 2 + dir) * 16 + g) * 64 + n;
    const double are = C.in[I_ARE][ix], aim = C.in[I_AIM][ix], dt = exp((double)C.in[I_LDT][(l * 2 + dir) * 16 + g]), mag = exp(16.0 * are * dt);
    const float a_r = (float)(mag * cos(16.0 * aim * dt)), a_i = (float)(mag * sin(16.0 * aim * dt));
    float cr = 0.f, ci = 0.f;
    for (int j0 = 0; j0 < 144; j0 += 16) { float sr[16], si[16];
#pragma unroll
        for (int jj = 0; jj < 16; ++jj) { const int ch = s5_chunk_id(b, dir, j0 + jj); sr[jj] = S[(size_t)ch * 256]; si[jj] = S[(size_t)ch * 256 + 64]; }
#pragma unroll
        for (int jj = 0; jj < 16; ++jj) { const int ch = s5_chunk_id(b, dir, j0 + jj); Hh[(size_t)ch * 512] = (bf16_t)f2bf(cr); Hh[(size_t)ch * 512 + 64] = (bf16_t)f2bf(ci);
            const float nr = a_r * cr - a_i * ci + sr[jj], ni = a_r * ci + a_i * cr + si[jj]; cr = nr; ci = ni; } }
}
__device__ __forceinline__ void p_s5_gemmS(const Ctx& C, int l) {
    Gemm g{(const bf16_t*)(C.ws + WS_UH), wt_ptr(C, l, WT_BTS), 16 * NCH_S5, 256, 256, 512, 256, 9, (size_t)256 * 256 * 2};
    EpiF32 E{(float*)(C.ws + WS_S5S), 256}; run_gemm(C, g, E);
}
__device__ __forceinline__ void p_s5_gemmY(const Ctx& C, int l) {
    Gemm g{(const bf16_t*)(C.ws + WS_UH), wt_ptr(C, l, WT_BTY), 16 * NCH_S5, 256, 512, 512, 512, 9, (size_t)256 * 512 * 2};
    EpiS5Y E{(const bf16_t*)(C.ws + WS_UH), C.in[I_DSK] + l * 256, (bf16_t*)(C.ws + WS_YS5)}; run_gemm(C, g, E);
}
__device__ __forceinline__ void p_s5_glu(const Ctx& C, int l) {
    Gemm g{(const bf16_t*)(C.ws + WS_YS5), wt_ptr(C, l, WT_GLU), l == 0 ? NROWS : NLAT, 256, 256, 256, 256, 0, 0};
    EpiGlu E{(const bf16_t*)(C.ws + WS_YS5), C.in[I_GLUB] + l * 256, (bf16_t*)(C.ws + WS_HY)}; run_gemm(C, g, E);
}
__device__ __forceinline__ void p_mixA(const Ctx& C, int l) {
    p_s5_gemmS(C, l);
    __syncthreads();
    const int nsgu = l == 0 ? 288 : 256, ncv = l == 0 ? 576 : 512, total = 2304 + nsgu + ncv;
    for (int it = C.bid; it < total; it += C.G) {
        int r = it;
        if (r < 2304) { const int b = r / 144, q = r % 144; ml_state_item(C, b, q / 36, q % 36); continue; } r -= 2304;
        if (r < nsgu) { sgu_item(C, l, r); continue; } r -= nsgu;
        conv_item(C, l, r);
    }
}
__device__ __forceinline__ void p_mixB(const Ctx& C, int l) {
    for (int it = C.bid; it < 320; it += C.G) { if (it < 256) ml_carry_item(C, it); else s5_carry_item(C, l, it - 256); }
}
__device__ __forceinline__ void p_mixC(const Ctx& C, int l) {
    p_s5_gemmY(C, l);
    __syncthreads();
    const int ncs = l == 0 ? 36 : 32;
    for (int it = C.bid; it < 64 * ncs; it += C.G) { const int bh = it / ncs; ml_out_item(C, l, bh >> 2, bh & 3, it % ncs); }
}

__global__ void __launch_bounds__(512, 2) mk_fwd(Args a) {
    extern __shared__ __attribute__((aligned(16))) unsigned char lds_raw[];
    Ctx C; C.lds = (LAS unsigned char*)lds_raw; C.tid = threadIdx.x; C.lane = C.tid & 63; C.wave = __builtin_amdgcn_readfirstlane(C.tid >> 6); C.bid = blockIdx.x; C.G = gridDim.x;
    C.in = a.in; C.out = a.out; C.ws = a.ws;
    const int lo = a.ph_lo, hi = a.ph_hi;
    volatile LAS unsigned* MISC = (volatile LAS unsigned*)(C.lds + LDS_BYTES - 64);
    if (C.tid < 16) MISC[C.tid] = 0u;
    __syncthreads();
    XcdBarrier bar = xcd_barrier_post((unsigned*)(a.ws + WS_CTL) + 4096, MISC);
#define PH(k, body) if (lo <= (k) && (k) < hi) { body; if ((k) + 1 < hi) { if ((k) == 0) { __threadfence(); cooperative_groups::this_grid().sync(); } else xcd_barrier(bar); } }
    PH(0, p_prologue(C))
    PH(1, p_rowpass(C, 0, 0))
    PH(2, p_inproj(C, 0))
    PH(3, p_mixA(C, 0))
    PH(4, p_mixB(C, 0))
    PH(5, p_mixC(C, 0))
    PH(6, p_s5_glu(C, 0))
    PH(7, p_outproj(C, 0))
    PH(8, p_rowpass(C, 1, 0))
    PH(9, p_ffnin(C, 0))
    PH(10, p_ffnout(C, 0))
    PH(11, p_rowpass(C, 2, 0))
    PH(12, p_inproj(C, 1))
    PH(13, p_mixA(C, 1))
    PH(14, p_mixB(C, 1))
    PH(15, p_mixC(C, 1))
    PH(16, p_s5_glu(C, 1))
    PH(17, p_outproj(C, 1))
    PH(18, p_rowpass(C, 1, 1))
    PH(19, p_ffnin(C, 1))
    PH(20, p_ffnout(C, 1))
    PH(21, p_rowpass(C, 2, 1))
#undef PH
}
}

extern "C" void kernel_launch(void* const* d_in, const int* in_sizes, int n_in, void* d_out, int out_size, void* d_ws, size_t ws_size, hipStream_t stream) {
    static int ready = 0;
    if (!ready) {
        if (n_in != 34 || in_sizes[0] != mk::NLAT * mk::D || out_size != mk::NLAT * mk::D || ws_size < mk::WS_END) { fprintf(stderr, "kernel_launch: unexpected shapes (n_in %d, in0 %d, out %d, ws %zu)\n", n_in, n_in > 0 ? in_sizes[0] : -1, out_size, ws_size); ready = -1; return; }
        if (hipFuncSetAttribute((const void*)mk::mk_fwd, hipFuncAttributeMaxDynamicSharedMemorySize, mk::LDS_BYTES) != hipSuccess) { fprintf(stderr, "kernel_launch: hipFuncSetAttribute failed\n"); ready = -1; return; }
        ready = 1;
    }
    if (ready < 0) return;
    if (hipMemsetAsync((char*)d_ws + mk::WS_CTL, 0, 65536, stream) != hipSuccess) { fprintf(stderr, "kernel_launch: hipMemsetAsync failed\n"); return; }
    mk::Args a{};
    for (int i = 0; i < 34; ++i) a.in[i] = (const float*)d_in[i];
    a.out = (float*)d_out; a.ws = (unsigned char*)d_ws;
#if MK_ONE_LAUNCH
    a.ph_lo = 0; a.ph_hi = mk::NPH;
    void* args[] = {&a};
    hipError_t e = hipLaunchCooperativeKernel((const void*)mk::mk_fwd, dim3(256), dim3(512), args, mk::LDS_BYTES, stream);
    if (e != hipSuccess) fprintf(stderr, "cooperative launch failed: %s\n", hipGetErrorString(e));
#else
    for (int ph = 0; ph < mk::NPH; ++ph) {
        a.ph_lo = ph; a.ph_hi = ph + 1;
        hipLaunchKernelGGL(mk::mk_fwd, dim3(256), dim3(512), mk::LDS_BYTES, stream, a);
    }
#endif
}
```

```cpp
#include <hip/hip_runtime.h>
#include <hip/hip_cooperative_groups.h>
#include <cstdio>
#include <cstdint>
namespace pg8 {
#define PG8_LAS __attribute__((address_space(3)))
typedef unsigned short bf16_t;
typedef short bf16x8 __attribute__((ext_vector_type(8)));
typedef float f32x4 __attribute__((ext_vector_type(4)));
typedef unsigned u32x4 __attribute__((ext_vector_type(4)));
constexpr int BM = 256, BK = 64, HALF = 128, HTB = HALF * BK * 2  , STAGE_BYTES = 8 * HTB, NXCD = 8, WGM = 8;

__host__ __device__ __forceinline__ int lds_byte(int r, int c) { const int st = (r >> 4) * 2 + (c >> 5), rr = r & 15, cc = c & 31, ob = rr * 64 + cc * 2; return st * 1024 + (ob ^ (((ob >> 9) & 1) << 5)); }
__host__ __device__ __forceinline__ void stage_rc(int b, int& R, int& C) { const int st = b / 1024, sb = b % 1024, swz = sb ^ (((sb >> 9) & 1) << 5); R = (st >> 1) * 16 + swz / 64; C = (st & 1) * 32 + (swz % 64) / 2; }
__host__ __device__ __forceinline__ int perm32(int rho) { const int n = rho >> 4, i = rho & 15; return 8 * (i >> 2) + 4 * n + (i & 3); }

struct Unit { int pm, pn; };
struct Gemm { const bf16_t* A; const bf16_t* Bt; int M, N, K, lda, ldb, bgrp; size_t bgrp_stride; };

struct StaticOrder {
    int nM, nN, nwg, G, c;
    __host__ __device__ void init(int M, int N, int G_, int c_) { nM = M / BM; nN = N / BM; nwg = nM * nN; G = G_; c = c_; }
    __host__ __device__ bool next(int i, Unit& u) const {
        const long L = (long)i * G + c; if (L >= nwg) return false;
        int wgid = (int)L; { const int q = nwg / NXCD, r = nwg % NXCD, xcd = wgid % NXCD, off = wgid / NXCD; wgid = (xcd < r ? xcd * (q + 1) : r * (q + 1) + (xcd - r) * q) + off; }
        const int nig = WGM * nN, gid = wgid / nig, fm = gid * WGM, gsz = (nM - fm) < WGM ? (nM - fm) : WGM;
        u.pm = fm + ((wgid % nig) % gsz); u.pn = (wgid % nig) / gsz; return true;
    }
    __device__ __forceinline__ void a_ready(const Unit&) const {}
    __device__ __forceinline__ void done(const Unit&) const {}
};

__device__ __forceinline__ unsigned cvt_pk_bf16(float lo, float hi) { unsigned r; asm volatile("v_cvt_pk_bf16_f32 %0, %1, %2" : "=v"(r) : "v"(lo), "v"(hi)); return r; }
__device__ __forceinline__ float bflo(unsigned w) { return __uint_as_float(w << 16); }
__device__ __forceinline__ float bfhi(unsigned w) { return __uint_as_float(w & 0xffff0000u); }
__device__ __forceinline__ float sigm(float x) { return __builtin_amdgcn_rcpf(1.0f + __expf(-x)); }
__device__ __forceinline__ float gelu_t(float x) { const float u = 1.5957691216f * (x + 0.044715f * x * x * x); return x * sigm(u); }
__device__ __forceinline__ u32x4 pack8(const f32x4 a, const f32x4 b) { u32x4 w; w.x = cvt_pk_bf16(a[0], a[1]); w.y = cvt_pk_bf16(a[2], a[3]); w.z = cvt_pk_bf16(b[0], b[1]); w.w = cvt_pk_bf16(b[2], b[3]); return w; }

constexpr int NLAT = 32768, NROWS = 36864, ZLD = 2048, NCH_S5 = 2304;

struct EpiInProj {
    static constexpr bool PERM = true, AFTER_DRAIN = false;
    bf16_t* Z; bf16_t* UH;
    __device__ __forceinline__ void operator()(const f32x4 (&acc)[2][2][4][2], const Unit& u, int wr, int wc, int fr, int fq) const {
#pragma unroll
        for (int ai = 0; ai < 2; ++ai)
#pragma unroll
            for (int m = 0; m < 4; ++m) { const int row = u.pm * BM + ai * HALF + wr * 64 + m * 16 + fr;
#pragma unroll
                for (int bj = 0; bj < 2; ++bj) { const u32x4 w = pack8(acc[ai][bj][m][0], acc[ai][bj][m][1]); const int cc = bj * HALF + wc * 32 + 8 * fq;
                    if (u.pn < 8) *(u32x4*)(Z + (size_t)row * ZLD + u.pn * BM + cc) = w;
                    else { const int g = cc >> 4, q0 = cc & 15; *(u32x4*)(UH + ((size_t)(g * NCH_S5 + (row >> 4)) * 512 + (row & 15) * 16 + q0)) = w; } } }
    }
};
struct EpiResGate {
    static constexpr bool PERM = false, AFTER_DRAIN = false;
    const float* srcL; const float* srcC; float* dstL; float* dstC; const float* gate; float alpha;
    __device__ __forceinline__ void operator()(const f32x4 (&acc)[2][2][4][2], const Unit& u, int wr, int wc, int fr, int fq) const {
        const int row0 = u.pm * BM; const bool lat = row0 < NLAT; const int mi = lat ? (row0 >> 11) : 16;
        const float* src = lat ? srcL + (size_t)row0 * 1024 : srcC + (size_t)(row0 - NLAT) * 1024; float* dst = lat ? dstL + (size_t)row0 * 1024 : dstC + (size_t)(row0 - NLAT) * 1024;
        const float* gp = gate + (size_t)mi * 6144;
#pragma unroll
        for (int bj = 0; bj < 2; ++bj)
#pragma unroll
            for (int n = 0; n < 2; ++n) { const int col = u.pn * BM + bj * HALF + wc * 32 + n * 16 + 4 * fq; const f32x4 gv = *(const f32x4*)(gp + col);
#pragma unroll
                for (int ai = 0; ai < 2; ++ai)
#pragma unroll
                    for (int m = 0; m < 4; ++m) { const size_t off = (size_t)(ai * HALF + wr * 64 + m * 16 + fr) * 1024 + col; const f32x4 x = *(const f32x4*)(src + off); *(f32x4*)(dst + off) = x * alpha + gv * acc[ai][bj][m][n]; } }
    }
};
struct EpiSwiGlu {
    static constexpr bool PERM = true, AFTER_DRAIN = false;
    bf16_t* ACT; int ldc;
    __device__ __forceinline__ void operator()(const f32x4 (&acc)[2][2][4][2], const Unit& u, int wr, int wc, int fr, int fq) const {
#pragma unroll
        for (int ai = 0; ai < 2; ++ai)
#pragma unroll
            for (int m = 0; m < 4; ++m) { const int row = u.pm * BM + ai * HALF + wr * 64 + m * 16 + fr; f32x4 o[2];
#pragma unroll
                for (int n = 0; n < 2; ++n)
#pragma unroll
                    for (int e = 0; e < 4; ++e) { const float g = acc[ai][0][m][n][e]; o[n][e] = g * sigm(g) * acc[ai][1][m][n][e]; }
                *(u32x4*)(ACT + (size_t)row * ldc + u.pn * HALF + wc * 32 + 8 * fq) = pack8(o[0], o[1]); }
    }
};
struct EpiF32 {
    static constexpr bool PERM = false, AFTER_DRAIN = false;
    float* O; int ldc;
    __device__ __forceinline__ void operator()(const f32x4 (&acc)[2][2][4][2], const Unit& u, int wr, int wc, int fr, int fq) const {
#pragma unroll
        for (int ai = 0; ai < 2; ++ai)
#pragma unroll
            for (int m = 0; m < 4; ++m) { const size_t ro = (size_t)(u.pm * BM + ai * HALF + wr * 64 + m * 16 + fr) * ldc;
#pragma unroll
                for (int bj = 0; bj < 2; ++bj)
#pragma unroll
                    for (int n = 0; n < 2; ++n) *(f32x4*)(O + ro + u.pn * BM + bj * HALF + wc * 32 + n * 16 + 4 * fq) = acc[ai][bj][m][n]; }
    }
};
struct EpiS5Y {
    static constexpr bool PERM = true, AFTER_DRAIN = false;
    const bf16_t* UH; const float* dsk; bf16_t* YS5;
    __device__ __forceinline__ void operator()(const f32x4 (&acc)[2][2][4][2], const Unit& u, int wr, int wc, int fr, int fq) const {
        const int g = (u.pm * BM) / NCH_S5;
#pragma unroll
        for (int bj = 0; bj < 2; ++bj) { const int col = bj * HALF + wc * 32 + 8 * fq, t = col >> 4, p0 = col & 15;
            const f32x4 d0 = *(const f32x4*)(dsk + g * 16 + p0), d1 = *(const f32x4*)(dsk + g * 16 + p0 + 4);
#pragma unroll
            for (int ai = 0; ai < 2; ++ai)
#pragma unroll
                for (int m = 0; m < 4; ++m) { const int row = u.pm * BM + ai * HALF + wr * 64 + m * 16 + fr, chunk = row - g * NCH_S5;
                    const u32x4 uw = *(const u32x4*)(UH + (size_t)row * 512 + col); f32x4 a = acc[ai][bj][m][0], b = acc[ai][bj][m][1];
                    a[0] += d0[0] * bflo(uw.x); a[1] += d0[1] * bfhi(uw.x); a[2] += d0[2] * bflo(uw.y); a[3] += d0[3] * bfhi(uw.y);
                    b[0] += d1[0] * bflo(uw.z); b[1] += d1[1] * bfhi(uw.z); b[2] += d1[2] * bflo(uw.w); b[3] += d1[3] * bfhi(uw.w);
#pragma unroll
                    for (int e = 0; e < 4; ++e) { a[e] = gelu_t(a[e]); b[e] = gelu_t(b[e]); }
                    *(u32x4*)(YS5 + (size_t)(chunk * 16 + t) * 256 + g * 16 + p0) = pack8(a, b); } }
    }
};
struct EpiGlu {
    static constexpr bool PERM = true, AFTER_DRAIN = false;
    const bf16_t* YS5; const float* gb; bf16_t* Y;
    __device__ __forceinline__ void operator()(const f32x4 (&acc)[2][2][4][2], const Unit& u, int wr, int wc, int fr, int fq) const {
#pragma unroll
        for (int bj = 0; bj < 2; ++bj) { const int col = bj * HALF + wc * 32 + 8 * fq; const f32x4 b0 = *(const f32x4*)(gb + col), b1 = *(const f32x4*)(gb + col + 4);
#pragma unroll
            for (int ai = 0; ai < 2; ++ai)
#pragma unroll
                for (int m = 0; m < 4; ++m) { const int row = u.pm * BM + ai * HALF + wr * 64 + m * 16 + fr; const u32x4 yw = *(const u32x4*)(YS5 + (size_t)row * 256 + col);
                    f32x4 a = acc[ai][bj][m][0] + b0, b = acc[ai][bj][m][1] + b1;
                    a[0] = bflo(yw.x) * sigm(a[0]); a[1] = bfhi(yw.x) * sigm(a[1]); a[2] = bflo(yw.y) * sigm(a[2]); a[3] = bfhi(yw.y) * sigm(a[3]);
                    b[0] = bflo(yw.z) * sigm(b[0]); b[1] = bfhi(yw.z) * sigm(b[1]); b[2] = bflo(yw.w) * sigm(b[2]); b[3] = bfhi(yw.w) * sigm(b[3]);
                    *(u32x4*)(Y + (size_t)row * 1024 + 768 + col) = pack8(a, b); } }
    }
};

template <class Epi, class Sched, bool ALIGN_EPI = false, bool SP2 = false>
__device__ __forceinline__ void gemm_phase(PG8_LAS unsigned char* lds, const Gemm g, const Sched& S, const Epi& E) {
    const int tid = threadIdx.x, wid = __builtin_amdgcn_readfirstlane(tid >> 6), lane = tid & 63, wr = wid >> 2, wc = wid & 3, fr = lane & 15, fq = lane >> 4;
    const int K = g.K, nt = K / BK;
    unsigned voffA[2], voffB[2];
#pragma unroll
    for (int i = 0; i < 2; ++i) { int R, C; stage_rc(tid * 16 + i * 8192, R, C); const int Rb = Epi::PERM ? ((R & ~31) + perm32(R & 31)) : R;
        voffA[i] = (unsigned)(R * g.lda + C) * 2u; voffB[i] = (unsigned)(Rb * g.ldb + C) * 2u; }
    const size_t kstep = (size_t)(BK * 2);
    const size_t hstepA = (size_t)HALF * g.lda * 2, hstepB = (size_t)HALF * g.ldb * 2;
    const size_t tstepA = 2 * hstepA, tstepB = 2 * hstepB;
#define PG8_ABASE(u) ((const char*)g.A + (size_t)(u).pm * tstepA)
#define PG8_BBASE(u) ((const char*)g.Bt + (size_t)(u).pn * tstepB + (g.bgrp ? (size_t)((u).pm / g.bgrp) * g.bgrp_stride : (size_t)0))
    const unsigned ldsw = (unsigned)wid * 1024u;
    const int aoff = lds_byte(wr * 64 + fr, fq * 8), boff = lds_byte(wc * 32 + fr, fq * 8);
#define PG8_SA(b, h) (((b) * 2 + (h)) * HTB)
#define PG8_SB(b, h) ((4 + (b) * 2 + (h)) * HTB)
#define PG8_STAGE(bufoff, gbase, voff) do { _Pragma("unroll") for (int _i = 0; _i < 2; ++_i) \
        __builtin_amdgcn_global_load_lds((const unsigned*)((const char*)(gbase) + (voff)[_i]), (PG8_LAS unsigned*)(lds + (bufoff) + ldsw + _i * 8192), 16, 0, 0); } while (0)
#define PG8_LDA(dst, b, h) do { _Pragma("unroll") for (int m = 0; m < 4; ++m) _Pragma("unroll") for (int k = 0; k < 2; ++k) dst[m][k] = *(const PG8_LAS bf16x8*)(lds + PG8_SA(b, h) + aoff + m * 2048 + k * 1024); } while (0)
#define PG8_LDB(dst, b, h) do { _Pragma("unroll") for (int n = 0; n < 2; ++n) _Pragma("unroll") for (int k = 0; k < 2; ++k) dst[n][k] = *(const PG8_LAS bf16x8*)(lds + PG8_SB(b, h) + boff + n * 2048 + k * 1024); } while (0)
#define PG8_MMA(ai, bj, At, Bt) do { __builtin_amdgcn_s_setprio(1); _Pragma("unroll") for (int m = 0; m < 4; ++m) _Pragma("unroll") for (int n = 0; n < 2; ++n) _Pragma("unroll") for (int k = 0; k < 2; ++k) \
        acc[ai][bj][m][n] = __builtin_amdgcn_mfma_f32_16x16x32_bf16(Bt[n][k], At[m][k], acc[ai][bj][m][n], 0, 0, 0); __builtin_amdgcn_s_setprio(0); } while (0)
#define PG8_WAIT_V(n) asm volatile("s_waitcnt vmcnt(" #n ")" ::: "memory")
#define PG8_WAIT_L(n) asm volatile("s_waitcnt lgkmcnt(" #n ")" ::: "memory")
#define PG8_BAR __builtin_amdgcn_s_barrier()
#define PG8_SCHED __builtin_amdgcn_sched_barrier(0)
    Unit cur, nxt; int ui = 0;
    if (!S.next(0, cur)) return;
    f32x4 acc[2][2][4][2];
#pragma unroll
    for (int a = 0; a < 2; ++a)
#pragma unroll
        for (int b = 0; b < 2; ++b)
#pragma unroll
            for (int m = 0; m < 4; ++m)
#pragma unroll
                for (int n = 0; n < 2; ++n) acc[a][b][m][n] = (f32x4){0.f, 0.f, 0.f, 0.f};
    bf16x8 At[4][2], B0[2][2], B1[2][2];
    const char* cA = PG8_ABASE(cur); const char* cB = PG8_BBASE(cur);
    S.a_ready(cur);
    if constexpr (SP2) {
        PG8_STAGE(PG8_SB(0, 0), cB, voffB); PG8_STAGE(PG8_SB(0, 1), cB + hstepB, voffB); PG8_STAGE(PG8_SA(0, 0), cA, voffA); PG8_STAGE(PG8_SA(0, 1), cA + hstepA, voffA);
        if (wr == 1) PG8_BAR;
        PG8_WAIT_V(2); PG8_BAR;
        PG8_STAGE(PG8_SB(1, 0), cB + kstep, voffB); PG8_STAGE(PG8_SA(1, 0), cA + kstep, voffA); PG8_STAGE(PG8_SB(1, 1), cB + hstepB + kstep, voffB);
        PG8_WAIT_V(6); PG8_BAR;
    } else {
        PG8_STAGE(PG8_SB(0, 0), cB, voffB); PG8_STAGE(PG8_SA(0, 0), cA, voffA); PG8_STAGE(PG8_SB(0, 1), cB + hstepB, voffB); PG8_STAGE(PG8_SA(0, 1), cA + hstepA, voffA);
        if (wr == 1) PG8_BAR;
        PG8_WAIT_V(4); PG8_BAR;
        PG8_STAGE(PG8_SB(1, 0), cB + kstep, voffB); PG8_STAGE(PG8_SA(1, 0), cA + kstep, voffA); PG8_STAGE(PG8_SB(1, 1), cB + hstepB + kstep, voffB);
        PG8_WAIT_V(6); PG8_BAR;
    }
    for (;;) {
        const bool has_next = S.next(ui + 1, nxt);
        const char* nA = has_next ? PG8_ABASE(nxt) : cA; const char* nB = has_next ? PG8_BBASE(nxt) : cB;
        for (int t = 0; t < nt; t += 2) {
            const bool last = (t == nt - 2);
            const char* a1 = cA + (size_t)(t + 1) * kstep;
            const char* a2 = last ? nA : cA + (size_t)(t + 2) * kstep; const char* b2 = last ? nB : cB + (size_t)(t + 2) * kstep;
            const char* a3 = a2 + kstep; const char* b3 = b2 + kstep;
            if (last && has_next) S.a_ready(nxt);
            if constexpr (SP2) {
            PG8_LDB(B0, 0, 0); PG8_LDB(B1, 0, 1); PG8_SCHED; PG8_LDA(At, 0, 0); PG8_STAGE(PG8_SA(1, 1), a1 + hstepA, voffA);
            PG8_WAIT_V(8); PG8_WAIT_L(0); PG8_BAR; PG8_MMA(0, 0, At, B0); PG8_MMA(0, 1, At, B1); PG8_BAR; PG8_SCHED;
            PG8_LDA(At, 0, 1); PG8_STAGE(PG8_SB(0, 0), b2, voffB); PG8_STAGE(PG8_SB(0, 1), b2 + hstepB, voffB); PG8_STAGE(PG8_SA(0, 0), a2, voffA);
            PG8_WAIT_V(8); PG8_WAIT_L(0); PG8_BAR; PG8_MMA(1, 0, At, B0); PG8_MMA(1, 1, At, B1); PG8_BAR; PG8_SCHED;
            PG8_LDB(B0, 1, 0); PG8_LDB(B1, 1, 1); PG8_SCHED; PG8_LDA(At, 1, 0); PG8_STAGE(PG8_SA(0, 1), a2 + hstepA, voffA);
            PG8_WAIT_V(8); PG8_WAIT_L(0); PG8_BAR; PG8_MMA(0, 0, At, B0); PG8_MMA(0, 1, At, B1); PG8_BAR; PG8_SCHED;
            PG8_LDA(At, 1, 1); PG8_STAGE(PG8_SB(1, 0), b3, voffB); PG8_STAGE(PG8_SB(1, 1), b3 + hstepB, voffB); PG8_STAGE(PG8_SA(1, 0), a3, voffA);
            PG8_WAIT_V(8); PG8_WAIT_L(0); PG8_BAR; PG8_MMA(1, 0, At, B0); PG8_MMA(1, 1, At, B1); PG8_BAR; PG8_SCHED;
            } else {
            PG8_LDB(B0, 0, 0); PG8_SCHED; PG8_LDA(At, 0, 0); PG8_STAGE(PG8_SA(1, 1), a1 + hstepA, voffA);
            PG8_WAIT_L(8); PG8_BAR; PG8_WAIT_L(0); PG8_MMA(0, 0, At, B0); PG8_BAR; PG8_SCHED;
            PG8_LDB(B1, 0, 1); PG8_STAGE(PG8_SB(0, 0), b2, voffB);
            PG8_BAR; PG8_WAIT_L(0); PG8_MMA(0, 1, At, B1); PG8_BAR;
            PG8_LDA(At, 0, 1); PG8_STAGE(PG8_SA(0, 0), a2, voffA);
            PG8_BAR; PG8_WAIT_L(0); PG8_MMA(1, 0, At, B0); PG8_BAR; PG8_SCHED;
            PG8_STAGE(PG8_SB(0, 1), b2 + hstepB, voffB);
            PG8_WAIT_V(6); PG8_BAR; PG8_MMA(1, 1, At, B1); PG8_BAR;
            PG8_LDB(B0, 1, 0); PG8_SCHED; PG8_LDA(At, 1, 0); PG8_STAGE(PG8_SA(0, 1), a2 + hstepA, voffA);
            PG8_WAIT_L(8); PG8_BAR; PG8_WAIT_L(0); PG8_MMA(0, 0, At, B0); PG8_BAR; PG8_SCHED;
            PG8_LDB(B1, 1, 1); PG8_STAGE(PG8_SB(1, 0), b3, voffB);
            PG8_BAR; PG8_WAIT_L(0); PG8_MMA(0, 1, At, B1); PG8_BAR;
            PG8_LDA(At, 1, 1); PG8_STAGE(PG8_SA(1, 0), a3, voffA);
            PG8_BAR; PG8_WAIT_L(0); PG8_MMA(1, 0, At, B0); PG8_BAR; PG8_SCHED;
            PG8_STAGE(PG8_SB(1, 1), b3 + hstepB, voffB);
            PG8_WAIT_V(6); PG8_BAR; PG8_MMA(1, 1, At, B1); PG8_BAR;
            }
        }
        if constexpr (ALIGN_EPI) { if (wr == 0) PG8_BAR; }
        if constexpr (!Epi::AFTER_DRAIN) { E(acc, cur, wr, wc, fr, fq); S.done(cur); }
        if (!has_next) break;
#pragma unroll
        for (int a = 0; a < 2; ++a)
#pragma unroll
            for (int b = 0; b < 2; ++b)
#pragma unroll
                for (int m = 0; m < 4; ++m)
#pragma unroll
                    for (int n = 0; n < 2; ++n) acc[a][b][m][n] = (f32x4){0.f, 0.f, 0.f, 0.f};
        cur = nxt; cA = nA; cB = nB; ++ui;
        if constexpr (ALIGN_EPI) { if (wr == 1) PG8_BAR; }
    }
    PG8_WAIT_V(0);
    if constexpr (!ALIGN_EPI) { if (wr == 0) PG8_BAR; }
    PG8_BAR;
    if constexpr (Epi::AFTER_DRAIN) { E.fused(acc, cur, wr, wc, fr, fq, lds, wid, lane); S.done(cur); }
#undef PG8_ABASE
#undef PG8_BBASE
#undef PG8_SA
#undef PG8_SB
#undef PG8_STAGE
#undef PG8_LDA
#undef PG8_LDB
#undef PG8_MMA
#undef PG8_WAIT_V
#undef PG8_WAIT_L
#undef PG8_BAR
#undef PG8_SCHED
}
}

#ifndef MK_ONE_LAUNCH
#define MK_ONE_LAUNCH 1
#endif
#ifndef MK_REPEAT_PH
#define MK_REPEAT_PH -1
#endif
namespace mk {
using namespace pg8;
#define LAS __attribute__((address_space(3)))
constexpr int D = 1024, NB = 16, SEQ = 2048, CTXL = 256, DFF = 2816, PIN = 2320, NPH = 22;
constexpr float ALPHA = 1.41421356237309515f, LN_EPS = 1e-5f;
constexpr size_t MiB = 1u << 20;
constexpr size_t WS_CTL = 0, WS_MOD = 1 * MiB, WS_WT = 2 * MiB, WT_LAYER = 30 * MiB;
constexpr size_t WT_IN = 0, WT_OUT = 9 * MiB / 2, WT_FFIN = 13 * MiB / 2, WT_FFOUT = 35 * MiB / 2, WT_GLU = 23 * MiB, WT_BTY = 93 * MiB / 4, WT_BTS = 109 * MiB / 4, WT_SGUW = 117 * MiB / 4;
constexpr size_t WS_GATES = 62 * MiB, WS_XC = 65 * MiB, WS_HY = 81 * MiB, WS_Z = 153 * MiB, WS_ACT = 153 * MiB, WS_UH = 297 * MiB, WS_MST = 333 * MiB, WS_YS5 = 369 * MiB,
                 WS_S5S = 387 * MiB, WS_MISC = 423 * MiB, WS_HSUM = 427 * MiB, WS_Y32 = 463 * MiB, WS_END = 499 * MiB;
constexpr int LDS_BYTES = 147456;

struct Args { const float* in[34]; float* out; unsigned char* ws; int ph_lo, ph_hi; };
enum { I_X = 0, I_C, I_CTX, I_CCTX, I_WMOD, I_BMOD, I_WIN, I_GBIAS, I_MNORM, I_SLNW, I_SLNB, I_SW, I_SB, I_CW, I_CB, I_CLNW, I_CLNB, I_ARE, I_AIM, I_LDT, I_BRE, I_BIM, I_CRE, I_CIM, I_DSK, I_GLUW, I_GLUB,
       I_WOUT, I_LN1W, I_LN1B, I_WFFIN, I_WFFOUT, I_LN2W, I_LN2B };

struct Ctx { LAS unsigned char* lds; int tid, lane, wave, bid, G; const float* const* in; float* out; unsigned char* ws; };

__device__ __forceinline__ float bf2f(bf16_t h) { return __uint_as_float((unsigned)h << 16); }
__device__ __forceinline__ unsigned f2bf(float f) { unsigned u = __float_as_uint(f); return (u + 0x7fffu + ((u >> 16) & 1u)) >> 16; }
__device__ __forceinline__ unsigned pk2(float lo, float hi) { return f2bf(lo) | (f2bf(hi) << 16); }
__device__ __forceinline__ float wave_sum(float v) {
#pragma unroll
    for (int o = 1; o < 64; o <<= 1) v += __shfl_xor(v, o);
    return v;
}
__device__ __forceinline__ float logsig(float x) { return fminf(x, 0.f) - log1pf(expf(-fabsf(x))); }
__device__ __forceinline__ int chain_row(int b, int dir, int j) {
    if (j < CTXL) { const int t = dir ? CTXL - 1 - j : j; return NLAT + b * CTXL + t; }
    int t = j - CTXL; t = dir ? SEQ - 1 - t : t; return b * SEQ + t;
}
#define LDS_WAIT() asm volatile("s_waitcnt lgkmcnt(0)" ::: "memory")

__device__ __forceinline__ void s5_table_item(const Ctx& C, int l, int g, int part);
__device__ __forceinline__ void transpose_item(const float* W, int ldw, int col0, bf16_t* WT, int K, int drow0, int k0, LAS float* scr, int lane) {
#pragma unroll 8
    for (int i = 0; i < 32; ++i) { const int kk = 2 * i + (lane >> 5); scr[kk * 33 + (lane & 31)] = W[(size_t)(k0 + kk) * ldw + col0 + (lane & 31)]; }
    LDS_WAIT(); asm volatile("" ::: "memory");
    const int c = lane & 7;
#pragma unroll
    for (int j = 0; j < 4; ++j) { const int n = (lane >> 3) + 8 * j; const LAS float* s = scr + (8 * c) * 33 + n;
        u32x4 o; o.x = pk2(s[0 * 33], s[1 * 33]); o.y = pk2(s[2 * 33], s[3 * 33]); o.z = pk2(s[4 * 33], s[5 * 33]); o.w = pk2(s[6 * 33], s[7 * 33]);
        *(u32x4*)(WT + (size_t)(drow0 + n) * K + k0 + 8 * c) = o; }
    LDS_WAIT(); asm volatile("" ::: "memory");
}
__device__ __forceinline__ void p_prologue(const Ctx& C) {
    LAS float* scr = (LAS float*)(C.lds + C.wave * 8448);
    const int gw = C.bid * 8 + C.wave, NGW = C.G * 8;
    constexpr int N_IN = 16 * 72, N_OUT = 16 * 32, N_FI = 16 * 176, N_FO = 44 * 32, N_GL = 4 * 8, N_L = N_IN + N_OUT + N_FI + N_FO + N_GL;
    for (int it = gw; it < 2 * N_L; it += NGW) {
        const int l = it / N_L; int r = it % N_L; unsigned char* wt = C.ws + WS_WT + (size_t)l * WT_LAYER;
        if (r < N_IN) { const int kb = r / 72, nb = r % 72; transpose_item(C.in[I_WIN] + (size_t)l * D * PIN, PIN, nb * 32 + (nb >= 32 ? 16 : 0), (bf16_t*)(wt + WT_IN), D, nb * 32, kb * 64, scr, C.lane); continue; } r -= N_IN;
        if (r < N_OUT) { const int kb = r / 32, nb = r % 32; transpose_item(C.in[I_WOUT] + (size_t)l * D * D, D, nb * 32, (bf16_t*)(wt + WT_OUT), D, nb * 32, kb * 64, scr, C.lane); continue; } r -= N_OUT;
        if (r < N_FI) { const int kb = r / 176, nb = r % 176, dr = nb * 32, pn = dr >> 8, bj = (dr >> 7) & 1, jj = dr & 127;
            transpose_item(C.in[I_WFFIN] + (size_t)l * D * 2 * DFF, 2 * DFF, bj * DFF + pn * 128 + jj, (bf16_t*)(wt + WT_FFIN), D, dr, kb * 64, scr, C.lane); continue; } r -= N_FI;
        if (r < N_FO) { const int kb = r / 32, nb = r % 32; transpose_item(C.in[I_WFFOUT] + (size_t)l * DFF * D, D, nb * 32, (bf16_t*)(wt + WT_FFOUT), DFF, nb * 32, kb * 64, scr, C.lane); continue; } r -= N_FO;
        { const int kb = r / 8, nb = r % 8; transpose_item(C.in[I_GLUW] + (size_t)l * 65536, 256, nb * 32, (bf16_t*)(wt + WT_GLU), 256, nb * 32, kb * 64, scr, C.lane); }
    }
    __syncthreads();
    LAS float* sc = (LAS float*)C.lds; LAS float* red = (LAS float*)(C.lds + 69632);
    if (C.bid < 192) {
        for (int idx = C.tid; idx < 17 * 1024; idx += 512) { const int i = idx >> 10, k = idx & 1023; const float v = i < 16 ? C.in[I_C][i * 1024 + k] : C.in[I_CCTX][k]; sc[idx] = v / (1.0f + expf(-v)); }
        __syncthreads();
        float* MOD = (float*)(C.ws + WS_MOD);
        for (int item = C.bid; item < 192; item += C.G) {
            const int l = item / 96, j = (item % 96) * 64 + C.lane; const float* w = C.in[I_WMOD] + (size_t)l * D * 6144 + j;
            float acc[17];
#pragma unroll
            for (int i = 0; i < 17; ++i) acc[i] = 0.f;
            for (int k = C.wave * 128; k < C.wave * 128 + 128; ++k) { const float wv = w[(size_t)k * 6144];
#pragma unroll
                for (int i = 0; i < 17; ++i) acc[i] += sc[i * 1024 + k] * wv; }
#pragma unroll
            for (int i = 0; i < 17; ++i) red[(C.wave * 17 + i) * 64 + C.lane] = acc[i];
            __syncthreads();
            for (int i = C.wave; i < 17; i += 8) { float s = 0.f;
#pragma unroll
                for (int w8 = 0; w8 < 8; ++w8) s += red[(w8 * 17 + i) * 64 + C.lane];
                MOD[(size_t)(l * 17 + i) * 6144 + j] = s + C.in[I_BMOD][l * 6144 + j]; }
            __syncthreads();
        }
    }
    __syncthreads();
    for (int it = C.bid; it < 256; it += C.G) s5_table_item(C, it >> 7, (it >> 3) & 15, it & 7);
    for (int idx = C.bid * 512 + C.tid; idx < 2 * 16384; idx += C.G * 512) { const int l = idx >> 14, o = (idx & 16383) * 4; const f32x4 v = *(const f32x4*)(C.in[I_SW] + (size_t)l * 65536 + o);
        *(unsigned long long*)((bf16_t*)(C.ws + WS_WT + (size_t)l * WT_LAYER + WT_SGUW) + o) = (unsigned long long)pk2(v[0], v[1]) | ((unsigned long long)pk2(v[2], v[3]) << 32); }
}

__device__ __forceinline__ void p_rowpass(const Ctx& C, int mode, int l) {
    const bool doLN = mode != 0, doH = !(mode == 2 && l == 1), doG = (mode == 0) || (mode == 2 && l == 0);
    const int nrows = (mode == 0 || l == 0) ? NROWS : NLAT;
    const int lm = (mode == 2) ? l + 1 : l;
    const float* MOD = (const float*)(C.ws + WS_MOD) + (size_t)(lm < 2 ? lm : 1) * 17 * 6144; const int osh = (mode == 1) ? 3072 : 0, osc = (mode == 1) ? 4096 : 1024;
    const float* lnw = C.in[mode == 1 ? I_LN1W : I_LN2W] + l * D; const float* lnb = C.in[mode == 1 ? I_LN1B : I_LN2B] + l * D;
    LAS float* wgT = (LAS float*)C.lds;
    if (doG) { const float* wg = C.in[I_WIN] + (size_t)lm * D * PIN + 1024;
        for (int idx = C.tid; idx < 16 * 1024; idx += 512) { const int k = idx >> 4, gi = idx & 15; wgT[gi * 1024 + k] = wg[(size_t)k * PIN + gi]; }
        __syncthreads(); }
    bf16_t* H = (bf16_t*)(C.ws + WS_HY); float* XC = (float*)(C.ws + WS_XC); float* GT = (float*)(C.ws + WS_GATES);
    for (int row = C.bid * 8 + C.wave; row < nrows; row += C.G * 8) {
        const bool lat = row < NLAT; const int mi = lat ? (row >> 11) : 16;
        float* xrow = lat ? C.out + (size_t)row * D : XC + (size_t)(row - NLAT) * D;
        const float* src = (mode == 0) ? (lat ? C.in[I_X] + (size_t)row * D : C.in[I_CTX] + (size_t)(row - NLAT) * D) : xrow;
        f32x4 v[4];
#pragma unroll
        for (int j = 0; j < 4; ++j) v[j] = *(const f32x4*)(src + 4 * C.lane + 256 * j);
        if (doLN) {
            float s = 0.f;
#pragma unroll
            for (int j = 0; j < 4; ++j) s += (v[j][0] + v[j][1]) + (v[j][2] + v[j][3]);
            const float mean = wave_sum(s) * (1.0f / D); float q = 0.f;
#pragma unroll
            for (int j = 0; j < 4; ++j) { v[j] = v[j] - mean; q += (v[j][0] * v[j][0] + v[j][1] * v[j][1]) + (v[j][2] * v[j][2] + v[j][3] * v[j][3]); }
            const float rstd = 1.0f / sqrtf(wave_sum(q) * (1.0f / D) + LN_EPS);
#pragma unroll
            for (int j = 0; j < 4; ++j) { const f32x4 w = *(const f32x4*)(lnw + 4 * C.lane + 256 * j), b = *(const f32x4*)(lnb + 4 * C.lane + 256 * j); v[j] = v[j] * rstd * w + b; *(f32x4*)(xrow + 4 * C.lane + 256 * j) = v[j]; }
        }
        if (doH) {
            const float* mp = MOD + (size_t)mi * 6144;
#pragma unroll
            for (int j = 0; j < 4; ++j) { const f32x4 sh = *(const f32x4*)(mp + osh + 4 * C.lane + 256 * j), scv = *(const f32x4*)(mp + osc + 4 * C.lane + 256 * j); v[j] = v[j] * (scv + 1.0f) + sh;
                unsigned long long o = (unsigned long long)pk2(v[j][0], v[j][1]) | ((unsigned long long)pk2(v[j][2], v[j][3]) << 32); *(unsigned long long*)(H + (size_t)row * D + 4 * C.lane + 256 * j) = o; }
            if (doG) {
                float keep = 0.f;
#pragma unroll 1
                for (int gi = 0; gi < 16; ++gi) { float p = 0.f;
#pragma unroll
                    for (int j = 0; j < 4; ++j) { const f32x4 w = *(const LAS f32x4*)(wgT + gi * 1024 + 4 * C.lane + 256 * j); p += (v[j][0] * w[0] + v[j][1] * w[1]) + (v[j][2] * w[2] + v[j][3] * w[3]); }
                    p = wave_sum(p); if (C.lane == gi) keep = p; }
                if (C.lane < 16) GT[(size_t)row * 16 + C.lane] = keep + C.in[I_GBIAS][lm * 16 + C.lane];
            }
        }
    }
}
#define XB_TMO      128
#define XB_XCNT(j)  (256  + 64 * (j))
#define XB_XSUB(j)  (1280 + 64 * (j))
#define XB_XGEN(j)  (2304 + 64 * (j))
#define XB_TOP      3328
#define XB_TOPGEN   3392
#define XCD_BAR_WORDS 3456
#define XB_SPIN_CAP (1u << 20)
__device__ __forceinline__ unsigned xb_ld(unsigned* p)              { return __hip_atomic_load(p, __ATOMIC_RELAXED, __HIP_MEMORY_SCOPE_AGENT); }
__device__ __forceinline__ unsigned xb_add(unsigned* p, unsigned v) { return __hip_atomic_fetch_add(p, v, __ATOMIC_RELAXED, __HIP_MEMORY_SCOPE_AGENT); }
__device__ __forceinline__ unsigned xb_xcc_id() { return (unsigned)__builtin_amdgcn_s_getreg((3 << 11) | 20) & 0xFu; }
#define XB_SPIN(cond, bar) do { unsigned _sp = 0; while (cond) { __builtin_amdgcn_s_sleep(1); \
    if ((++_sp & 255u) == 0u) { if (xb_ld(&(bar)[XB_TMO])) break; if (_sp > XB_SPIN_CAP) { atomicAdd(&(bar)[XB_TMO], 1u); break; } } } } while (0)
struct XcdBarrier { unsigned* bar; unsigned x; volatile LAS unsigned* st; };
__device__ __forceinline__ XcdBarrier xcd_barrier_post(unsigned* bar, volatile LAS unsigned* st) {
    XcdBarrier b; b.bar = bar; b.x = xb_xcc_id(); b.st = st;
    if (threadIdx.x == 0) (void)xb_add(&bar[XB_XCNT(b.x)], 1u);
    return b;
}
__device__ __forceinline__ void xcd_barrier_complete(unsigned* bar, unsigned x, unsigned& nloc, unsigned& nx) {
    const unsigned G = gridDim.x * gridDim.y * gridDim.z;
    unsigned sum, cnt, mine, sp = 0u;
    for (;;) {
        sum = 0u; cnt = 0u; mine = 0u;
#pragma unroll
        for (unsigned j = 0; j < 16; ++j) { const unsigned c = xb_ld(&bar[XB_XCNT(j)]); sum += c; cnt += (c > 0u) ? 1u : 0u; mine = (j == x) ? c : mine; }
        if (sum == G) break;
        __builtin_amdgcn_s_sleep(1);
        if ((++sp & 255u) == 0u) { if (xb_ld(&bar[XB_TMO])) break; if (sp > XB_SPIN_CAP) { atomicAdd(&bar[XB_TMO], 1u); break; } }
    }
    nloc = mine > 0u ? mine : 1u; nx = cnt > 0u ? cnt : 1u;
}
__device__ __forceinline__ void xcd_barrier(const XcdBarrier& b) {
    asm volatile("s_waitcnt vmcnt(0)" ::: "memory");
    __syncthreads();
    if (threadIdx.x == 0) {
        unsigned* bar = b.bar;
        __builtin_amdgcn_s_waitcnt(0);
        unsigned nloc = b.st[0], nx = b.st[1];
        if (nloc == 0u) { xcd_barrier_complete(bar, b.x, nloc, nx); b.st[0] = nloc; b.st[1] = nx; }
        const unsigned old = xb_add(&bar[XB_XSUB(b.x)], 1u);
        const unsigned gen = old / nloc;
        if (old + 1u == (gen + 1u) * nloc) {
            __builtin_amdgcn_fence(__ATOMIC_RELEASE, "agent");
            asm volatile("s_waitcnt vmcnt(0)" ::: "memory");
            const unsigned og = xb_add(&bar[XB_TOP], 1u);
            const unsigned tg = og / nx;
            if (og + 1u == (tg + 1u) * nx) xb_add(&bar[XB_TOPGEN], 1u);
            else XB_SPIN(xb_ld(&bar[XB_TOPGEN]) == tg, bar);
            __builtin_amdgcn_fence(__ATOMIC_ACQUIRE, "agent");
            xb_add(&bar[XB_XGEN(b.x)], 1u);
            asm volatile("s_waitcnt vmcnt(0)" ::: "memory");
        } else {
            XB_SPIN(xb_ld(&bar[XB_XGEN(b.x)]) == gen, bar);
            __builtin_amdgcn_fence(__ATOMIC_ACQUIRE, "agent");
            asm volatile("s_waitcnt vmcnt(0)" ::: "memory");
        }
    }
    __syncthreads();
}
__device__ __forceinline__ void nv_mlstm_chain(const Ctx& C, int b, int hd, int dir) {
    const bf16_t* Z = (const bf16_t*)(C.ws + WS_Z); const float* GT = (const float*)(C.ws + WS_GATES); float* HS = (float*)(C.ws + WS_HSUM);
    LAS float* qkv = (LAS float*)C.lds; LAS float* red = qkv + 192;
    const int tid = C.tid, vrow = tid >> 3, k0 = (tid & 7) * 8;
    float Cst[8]; for (int e = 0; e < 8; ++e) Cst[e] = 0.f;
    float nk = 0.f, m = 0.f, r0 = 0.f, ig_n, fg_n; int row_n;
#define NV_LOAD(j) do { const int row_ = chain_row(b, dir, (j)); row_n = row_; const bf16_t* zr = Z + (size_t)row_ * ZLD + hd * 64; \
        if (tid < 64) r0 = bf2f(zr[tid]); else if (tid < 128) r0 = bf2f(zr[256 + tid - 64]) * 0.125f; else if (tid < 192) r0 = bf2f(zr[512 + tid - 128]); \
        ig_n = GT[(size_t)row_ * 16 + dir * 8 + hd]; fg_n = GT[(size_t)row_ * 16 + dir * 8 + 4 + hd]; } while (0)
    NV_LOAD(0);
    for (int j = 0; j < CTXL + SEQ; ++j) {
        if (tid < 192) qkv[tid] = r0;
        const float ig = ig_n, lf = logsig(fg_n); const int row = row_n;
        __syncthreads();
        if (j + 1 < CTXL + SEQ) NV_LOAD(j + 1);
        const float mn = fmaxf(lf + m, ig), fdec = expf(lf + m - mn), iw = expf(ig - mn);
        if (tid < 64) { nk = fdec * nk + iw * qkv[64 + tid]; const float d = wave_sum(nk * qkv[tid]); if (tid == 0) red[0] = d; }
        const float vv = qkv[128 + vrow] * iw; float part = 0.f;
#pragma unroll
        for (int e = 0; e < 8; ++e) { Cst[e] = fdec * Cst[e] + vv * qkv[64 + k0 + e]; part += Cst[e] * qkv[k0 + e]; }
        part += __shfl_xor(part, 1); part += __shfl_xor(part, 2); part += __shfl_xor(part, 4);
        __syncthreads();
        const float den = red[0], h = part / fmaxf(fabsf(den), expf(-mn));
        if ((tid & 7) == 0) { float* hp = HS + (size_t)row * 256 + hd * 64 + vrow; if (dir) *hp += h; else *hp = h; }
        m = mn;
    }
#undef NV_LOAD
    __syncthreads();
}
__device__ __forceinline__ void nv_s5_item(const Ctx& C, int l, int b, int gh, int dir) {
    const bf16_t* UH = (const bf16_t*)(C.ws + WS_UH); float* Y32 = (float*)(C.ws + WS_Y32);
    const int g = gh * 8 + C.wave, n = C.lane;
    LAS float* base = (LAS float*)(C.lds + C.wave * 17920);
    LAS float* xr = base; LAS float* xi = base + 16 * 65; LAS float* cre = base + 2 * 16 * 65; LAS float* cim = cre + 1024; LAS float* us = cim + 1024;
    const float are = C.in[I_ARE][((l * 2 + dir) * 16 + g) * 64 + n], aim = C.in[I_AIM][((l * 2 + dir) * 16 + g) * 64 + n], dt = expf(C.in[I_LDT][(l * 2 + dir) * 16 + g]);
    const float mag = expf(are * dt), abr = mag * cosf(aim * dt), abi = mag * sinf(aim * dt), d2 = are * are + aim * aim;
    const float cr = ((abr - 1.f) * are + abi * aim) / d2, ci = (abi * are - (abr - 1.f) * aim) / d2;
    float br[16], bi[16];
#pragma unroll
    for (int q = 0; q < 16; ++q) { const float re = C.in[I_BRE][((size_t)(l * 16 + g) * 64 + n) * 16 + q], im = C.in[I_BIM][((size_t)(l * 16 + g) * 64 + n) * 16 + q]; br[q] = cr * re - ci * im; bi[q] = cr * im + ci * re; }
    for (int p = 0; p < 16; ++p) { cre[n * 16 + p] = C.in[I_CRE][((size_t)(l * 16 + g) * 16 + p) * 64 + n]; cim[n * 16 + p] = C.in[I_CIM][((size_t)(l * 16 + g) * 16 + p) * 64 + n]; }
    float sr = 0.f, si = 0.f;
    const int t_ = n >> 2, p0 = (n & 3) * 4;
    const f32x4 dv = *(const f32x4*)(C.in[I_DSK] + l * 256 + g * 16 + p0);
    for (int j0 = 0; j0 < CTXL + SEQ; j0 += 16) {
        { const int s = n >> 2, q0 = (n & 3) * 4, row = chain_row(b, dir, j0 + s); const bf16_t* up = UH + ((size_t)(g * NCH_S5 + (row >> 4)) * 512 + (row & 15) * 16 + q0);
#pragma unroll
          for (int e = 0; e < 4; ++e) us[s * 16 + q0 + e] = bf2f(up[e]); }
        __syncthreads();
        for (int s = 0; s < 16; ++s) { float bur = 0.f, bui = 0.f;
#pragma unroll
            for (int q = 0; q < 16; ++q) { const float uv = us[s * 16 + q]; bur += br[q] * uv; bui += bi[q] * uv; }
            const float nr = abr * sr - abi * si + bur, ni = abr * si + abi * sr + bui; sr = nr; si = ni; xr[s * 65 + n] = sr; xi[s * 65 + n] = si; }
        __syncthreads();
        f32x4 acc = {0.f, 0.f, 0.f, 0.f};
        for (int nn = 0; nn < 64; ++nn) { const float a = xr[t_ * 65 + nn], bq = xi[t_ * 65 + nn]; const f32x4 c1 = *(const LAS f32x4*)(cre + nn * 16 + p0), c2 = *(const LAS f32x4*)(cim + nn * 16 + p0); acc += c1 * a - c2 * bq; }
        const int row = chain_row(b, dir, j0 + t_); float* yp = Y32 + (size_t)row * 256 + g * 16 + p0;
        if (dir == 0) { f32x4 uu; uu[0] = us[t_ * 16 + p0]; uu[1] = us[t_ * 16 + p0 + 1]; uu[2] = us[t_ * 16 + p0 + 2]; uu[3] = us[t_ * 16 + p0 + 3]; *(f32x4*)yp = acc + dv * uu; }
        else { const f32x4 o = *(const f32x4*)yp; *(f32x4*)yp = o + acc; }
        __syncthreads();
    }
}
__device__ __forceinline__ void nv_glu_item(const Ctx& C, int l, int item) {
    const float* Y32 = (const float*)(C.ws + WS_Y32); bf16_t* Y = (bf16_t*)(C.ws + WS_HY); LAS float* ys = (LAS float*)C.lds;
    const int r0 = item * 32;
    for (int idx = C.tid; idx < 32 * 256; idx += 512) ys[idx] = gelu_t(Y32[(size_t)r0 * 256 + idx]);
    __syncthreads();
    const int c = C.tid & 255, th = C.tid >> 8; const float* w = C.in[I_GLUW] + (size_t)l * 65536 + c;
    float acc[16];
#pragma unroll
    for (int t = 0; t < 16; ++t) acc[t] = 0.f;
    for (int k = 0; k < 256; ++k) { const float wv = w[k * 256];
#pragma unroll
        for (int t = 0; t < 16; ++t) acc[t] += ys[(th * 16 + t) * 256 + k] * wv; }
    const float gb = C.in[I_GLUB][l * 256 + c];
#pragma unroll
    for (int t = 0; t < 16; ++t) { const int rr = th * 16 + t; Y[(size_t)(r0 + rr) * D + 768 + c] = (bf16_t)f2bf(ys[rr * 256 + c] * sigm(acc[t] + gb)); }
    __syncthreads();
}
__device__ __forceinline__ void nv_readout_row(const Ctx& C, int l, int row) {
    const float* HS = (const float*)(C.ws + WS_HSUM); const bf16_t* Z = (const bf16_t*)(C.ws + WS_Z); bf16_t* Y = (bf16_t*)(C.ws + WS_HY);
    const int ch = 4 * C.lane; f32x4 h = *(const f32x4*)(HS + (size_t)row * 256 + ch);
    float s = (h[0] + h[1]) + (h[2] + h[3]); s += __shfl_xor(s, 1); s += __shfl_xor(s, 2); s += __shfl_xor(s, 4); s += __shfl_xor(s, 8);
    const float mu = s * (1.0f / 64.0f); h = h - mu; float q = (h[0] * h[0] + h[1] * h[1]) + (h[2] * h[2] + h[3] * h[3]); q += __shfl_xor(q, 1); q += __shfl_xor(q, 2); q += __shfl_xor(q, 4); q += __shfl_xor(q, 8);
    const float rstd = 1.0f / sqrtf(q * (1.0f / 64.0f) + LN_EPS); const f32x4 nw = *(const f32x4*)(C.in[I_MNORM] + l * 256 + ch);
    const unsigned long long ow = *(const unsigned long long*)(Z + (size_t)row * ZLD + 768 + ch); const unsigned o0 = (unsigned)ow, o1 = (unsigned)(ow >> 32);
    const float y0 = h[0] * rstd * nw[0] * sigm(bflo(o0)), y1 = h[1] * rstd * nw[1] * sigm(bfhi(o0)), y2 = h[2] * rstd * nw[2] * sigm(bflo(o1)), y3 = h[3] * rstd * nw[3] * sigm(bfhi(o1));
    *(unsigned long long*)(Y + (size_t)row * D + ch) = (unsigned long long)pk2(y0, y1) | ((unsigned long long)pk2(y2, y3) << 32);
}
typedef short s16x4 __attribute__((ext_vector_type(4)));
__device__ __forceinline__ s16x4 lds_tr16(const LAS bf16_t* p) { return __builtin_bit_cast(s16x4, __builtin_amdgcn_ds_read_tr16_b64_v4i16((LAS s16x4*)p)); }
__device__ __forceinline__ bf16x8 lds_frag_tr(const LAS bf16_t* X, int ld, int k0, int n0, int lane) {
    const int i = lane & 15, g = lane >> 4; const LAS bf16_t* p = X + (k0 + 8 * g + (i >> 2)) * ld + n0 + 4 * (i & 3);
    const s16x4 lo = lds_tr16(p), hi = lds_tr16(p + 4 * ld); bf16x8 r; r[0] = lo[0]; r[1] = lo[1]; r[2] = lo[2]; r[3] = lo[3]; r[4] = hi[0]; r[5] = hi[1]; r[6] = hi[2]; r[7] = hi[3]; return r;
}
constexpr int VP = 264;
__device__ __forceinline__ void sgu_item(const Ctx& C, int l, int ci) {
    const bf16_t* Z = (const bf16_t*)(C.ws + WS_Z); bf16_t* Y = (bf16_t*)(C.ws + WS_HY); LAS bf16_t* Vr = (LAS bf16_t*)C.lds;
    const int r0 = ci < 256 ? ci * 128 : NLAT + (ci - 256) * 128, lane = C.lane;
    { const int ch = 4 * lane; const f32x4 lw = *(const f32x4*)(C.in[I_SLNW] + l * 256 + ch), lb = *(const f32x4*)(C.in[I_SLNB] + l * 256 + ch);
      for (int s = C.wave; s < 128; s += 8) {
        const unsigned long long zw = *(const unsigned long long*)(Z + (size_t)(r0 + s) * ZLD + 1280 + ch); const unsigned z0 = (unsigned)zw, z1 = (unsigned)(zw >> 32);
        f32x4 v = {gelu_t(bflo(z0)), gelu_t(bfhi(z0)), gelu_t(bflo(z1)), gelu_t(bfhi(z1))};
        const float mu = wave_sum((v[0] + v[1]) + (v[2] + v[3])) * (1.0f / 256.0f); v = v - mu;
        const float rstd = 1.0f / sqrtf(wave_sum((v[0] * v[0] + v[1] * v[1]) + (v[2] * v[2] + v[3] * v[3])) * (1.0f / 256.0f) + LN_EPS);
        v = v * rstd * lw + lb;
        *(LAS unsigned long long*)(Vr + s * VP + ch) = (unsigned long long)cvt_pk_bf16(v[0], v[1]) | ((unsigned long long)cvt_pk_bf16(v[2], v[3]) << 32); } }
    __syncthreads();
    const int g = __builtin_amdgcn_readfirstlane(C.wave & 3), th = __builtin_amdgcn_readfirstlane(C.wave >> 2);
    const bf16_t* W = (const bf16_t*)(C.ws + WS_WT + (size_t)l * WT_LAYER + WT_SGUW) + (size_t)g * 16384; const float* bs = C.in[I_SB] + (l * 4 + g) * 128;
    bf16x8 afr[4][4];
#pragma unroll
    for (int ct = 0; ct < 4; ++ct)
#pragma unroll
        for (int ks = 0; ks < 4; ++ks) afr[ct][ks] = lds_frag_tr(Vr, VP, ks * 32, g * 64 + ct * 16, lane);
#pragma unroll 1
    for (int tt = 0; tt < 4; ++tt) { const int t = th * 64 + tt * 16 + (lane & 15), row = r0 + t; bf16x8 bfr[4];
#pragma unroll
        for (int ks = 0; ks < 4; ++ks) bfr[ks] = *(const bf16x8*)(W + t * 128 + ks * 32 + 8 * (lane >> 4));
        const float bst = bs[t];
#pragma unroll
        for (int ct = 0; ct < 4; ++ct) { f32x4 acc = {0.f, 0.f, 0.f, 0.f};
#pragma unroll
            for (int ks = 0; ks < 4; ++ks) acc = __builtin_amdgcn_mfma_f32_16x16x32_bf16(afr[ct][ks], bfr[ks], acc, 0, 0, 0);
            const int c = g * 64 + ct * 16 + 4 * (lane >> 4);
            const unsigned long long uw = *(const unsigned long long*)(Z + (size_t)row * ZLD + 1024 + c); const unsigned u0 = (unsigned)uw, u1 = (unsigned)(uw >> 32);
            const float y0 = gelu_t(bflo(u0)) * (acc[0] + bst), y1 = gelu_t(bfhi(u0)) * (acc[1] + bst), y2 = gelu_t(bflo(u1)) * (acc[2] + bst), y3 = gelu_t(bfhi(u1)) * (acc[3] + bst);
            *(unsigned long long*)(Y + (size_t)row * D + 256 + c) = (unsigned long long)cvt_pk_bf16(y0, y1) | ((unsigned long long)cvt_pk_bf16(y2, y3) << 32); } }
    __syncthreads();
}
__device__ __forceinline__ void conv_item(const Ctx& C, int l, int ti) {
    const bf16_t* Z = (const bf16_t*)(C.ws + WS_Z); bf16_t* Y = (bf16_t*)(C.ws + WS_HY); LAS float* A = (LAS float*)C.lds;
    int r0, seg_lo, seg_len; if (ti < 512) { r0 = ti * 64; seg_lo = 0; seg_len = 64; } else { const int b = (ti - 512) >> 2, tq = (ti - 512) & 3; r0 = NLAT + b * 256 + tq * 64; seg_lo = tq * 64; seg_len = 256; }
    { const int ch = 4 * (C.tid & 63);
      for (int a = C.tid >> 6; a < 94; a += 8) { const int ts = seg_lo + a - 15; f32x4 v = {0.f, 0.f, 0.f, 0.f};
        if (ts >= 0 && ts < seg_len) { const bf16_t* zr = Z + (size_t)(r0 + a - 15) * ZLD + 1536 + ch; const unsigned long long vw = *(const unsigned long long*)zr, gw = *(const unsigned long long*)(zr + 256);
            const unsigned v0 = (unsigned)vw, v1 = (unsigned)(vw >> 32), g0 = (unsigned)gw, g1 = (unsigned)(gw >> 32);
            v[0] = bflo(v0) * sigm(bflo(g0)); v[1] = bfhi(v0) * sigm(bfhi(g0)); v[2] = bflo(v1) * sigm(bflo(g1)); v[3] = bfhi(v1) * sigm(bfhi(g1)); }
        *(LAS f32x4*)(A + a * 256 + ch) = v; } }
    __syncthreads();
    const int ch = C.tid & 255, th = C.tid >> 8; float o[32];
    { const float* cw = C.in[I_CW] + (size_t)l * 31 * 256 + ch; const float cb = C.in[I_CB][l * 256 + ch];
#pragma unroll
      for (int t = 0; t < 32; ++t) o[t] = cb;
      for (int j = 0; j < 31; ++j) { const float w = cw[j * 256];
#pragma unroll
        for (int t = 0; t < 32; ++t) o[t] += w * A[(th * 32 + t + j) * 256 + ch]; } }
    __syncthreads();
#pragma unroll
    for (int t = 0; t < 32; ++t) A[(th * 32 + t) * 256 + ch] = o[t];
    __syncthreads();
    { const int c4 = 4 * C.lane; const f32x4 lw = *(const f32x4*)(C.in[I_CLNW] + l * 256 + c4), lb = *(const f32x4*)(C.in[I_CLNB] + l * 256 + c4);
      for (int t = C.wave; t < 64; t += 8) { f32x4 v = *(const LAS f32x4*)(A + t * 256 + c4);
        const float mu = wave_sum((v[0] + v[1]) + (v[2] + v[3])) * (1.0f / 256.0f); v = v - mu;
        const float rstd = 1.0f / sqrtf(wave_sum((v[0] * v[0] + v[1] * v[1]) + (v[2] * v[2] + v[3] * v[3])) * (1.0f / 256.0f) + LN_EPS);
        v = v * rstd * lw + lb; const float y0 = v[0] * sigm(v[0]), y1 = v[1] * sigm(v[1]), y2 = v[2] * sigm(v[2]), y3 = v[3] * sigm(v[3]);
        *(unsigned long long*)(Y + (size_t)(r0 + t) * D + 512 + c4) = (unsigned long long)pk2(y0, y1) | ((unsigned long long)pk2(y2, y3) << 32); } }
    __syncthreads();
}
constexpr size_t MSN_OFF = 0, MSS_OFF = 2 * MiB, MSM_OFF = 3 * MiB;
__device__ __forceinline__ int ml_row0(int b, int c) { return c < 32 ? b * SEQ + 64 * c : NLAT + b * CTXL + 64 * (c - 32); }
__device__ __forceinline__ int ml_jf(int c) { return c < 32 ? 4 + c : c - 32; }
__device__ __forceinline__ int ml_jb(int c) { return c < 32 ? 35 - c : 35 - c; }
template <int K> __device__ __forceinline__ void lds_mma(f32x4& acc, const LAS bf16_t* A, int lda, const LAS bf16_t* B, int ldb, int lane) {
    const LAS bf16_t* ap = A + (lane & 15) * lda + 8 * (lane >> 4); const LAS bf16_t* bp = B + (lane & 15) * ldb + 8 * (lane >> 4);
#pragma unroll
    for (int k = 0; k < K; k += 32) { const bf16x8 a = *(const LAS bf16x8*)(ap + k), b = *(const LAS bf16x8*)(bp + k); acc = __builtin_amdgcn_mfma_f32_16x16x32_bf16(a, b, acc, 0, 0, 0); }
}
__device__ __forceinline__ float scan_add(float v, int lane) {
#pragma unroll
    for (int o = 1; o < 64; o <<= 1) { const float t = __shfl_up(v, o); if (lane >= o) v += t; }
    return v;
}
__device__ __forceinline__ float scan_max(float v, int lane) {
#pragma unroll
    for (int o = 1; o < 64; o <<= 1) { const float t = __shfl_up(v, o); if (lane >= o) v = fmaxf(v, t); }
    return v;
}
__device__ __forceinline__ float wave_max(float v) {
#pragma unroll
    for (int o = 1; o < 64; o <<= 1) v = fmaxf(v, __shfl_xor(v, o));
    return v;
}
constexpr int TS = 72;

__device__ __forceinline__ void ml_state_item(const Ctx& C, int b, int hd, int c) {
    const bf16_t* Z = (const bf16_t*)(C.ws + WS_Z); const float* GT = (const float*)(C.ws + WS_GATES);
    bf16_t* MST = (bf16_t*)(C.ws + WS_MST); float* MSN = (float*)(C.ws + WS_MISC + MSN_OFF); float* MSS = (float*)(C.ws + WS_MISC + MSS_OFF);
    LAS bf16_t* KT = (LAS bf16_t*)C.lds;
    LAS bf16_t* VE = KT + 64 * TS;
    LAS float* ef = (LAS float*)(VE + 144 * TS); LAS float* eb = ef + 64;
    const int r0 = ml_row0(b, c), tid = C.tid, lane = C.lane;
    const int s = tid >> 3, c8 = 8 * (tid & 7);
    const u32x4 kw = *(const u32x4*)(Z + (size_t)(r0 + s) * ZLD + 256 + hd * 64 + c8), vw = *(const u32x4*)(Z + (size_t)(r0 + s) * ZLD + 512 + hd * 64 + c8);
    if (C.wave < 2) { const int dir = C.wave, tok = dir ? 63 - lane : lane;
        const float ig = GT[(size_t)(r0 + tok) * 16 + dir * 8 + hd], lf = logsig(GT[(size_t)(r0 + tok) * 16 + dir * 8 + 4 + hd]);
        const float bb = scan_add(lf, lane), bend = __shfl(bb, 63), lu = bend - bb + ig, ml = wave_max(lu);
        (dir ? eb : ef)[tok] = expf(lu - ml);
        if (lane == 0) { const int chain = (b * 4 + hd) * 2 + dir, j = dir ? ml_jb(c) : ml_jf(c); MSS[(chain * 36 + j) * 2] = ml; MSS[(chain * 36 + j) * 2 + 1] = bend; } }
    for (int idx = tid; idx < 14 * TS; idx += 512) VE[130 * TS + idx] = 0;
    __syncthreads();
    { const float e0 = ef[s], e1 = eb[s]; const unsigned kk[4] = {kw.x, kw.y, kw.z, kw.w}, vv[4] = {vw.x, vw.y, vw.z, vw.w};
#pragma unroll
      for (int e = 0; e < 4; ++e) { const float k0 = bflo(kk[e]) * 0.125f, k1 = bfhi(kk[e]) * 0.125f, v0 = bflo(vv[e]), v1 = bfhi(vv[e]);
        KT[(c8 + 2 * e) * TS + s] = (bf16_t)f2bf(k0); KT[(c8 + 2 * e + 1) * TS + s] = (bf16_t)f2bf(k1);
        VE[(c8 + 2 * e) * TS + s] = (bf16_t)f2bf(v0 * e0); VE[(c8 + 2 * e + 1) * TS + s] = (bf16_t)f2bf(v1 * e0);
        VE[(64 + c8 + 2 * e) * TS + s] = (bf16_t)f2bf(v0 * e1); VE[(64 + c8 + 2 * e + 1) * TS + s] = (bf16_t)f2bf(v1 * e1); }
      if (tid < 64) { VE[128 * TS + tid] = (bf16_t)f2bf(ef[tid]); VE[129 * TS + tid] = (bf16_t)f2bf(eb[tid]); } }
    __syncthreads();
    const int chf = (b * 4 + hd) * 2, jf = ml_jf(c), jb = ml_jb(c);
    for (int t = C.wave; t < 36; t += 8) { const int mt = t & 3, nt = t >> 2; f32x4 acc = {0.f, 0.f, 0.f, 0.f};
        lds_mma<64>(acc, KT + mt * 16 * TS, TS, VE + nt * 16 * TS, TS, lane);
        const int k = mt * 16 + 4 * (lane >> 4), n = nt * 16 + (lane & 15);
        if (n < 128) { const int dir = n >> 6, v = n & 63; bf16_t* dst = MST + ((size_t)((chf + dir) * 36 + (dir ? jb : jf)) * 4096 + v * 64 + k);
            *(unsigned long long*)dst = (unsigned long long)cvt_pk_bf16(acc[0], acc[1]) | ((unsigned long long)cvt_pk_bf16(acc[2], acc[3]) << 32); }
        else if (n < 130) { const int dir = n - 128; *(f32x4*)(MSN + ((size_t)((chf + dir) * 36 + (dir ? jb : jf)) * 64 + k)) = acc; } }
    __syncthreads();
}
__device__ __forceinline__ void ml_carry_item(const Ctx& C, int item) {
    const int chain = item >> 1, half = item & 1, tid = C.tid;
    bf16_t* base = (bf16_t*)(C.ws + WS_MST) + (size_t)chain * 36 * 4096 + half * 2048 + tid * 4;
    float* MSN = (float*)(C.ws + WS_MISC + MSN_OFF) + (size_t)chain * 36 * 64; const float* MSS = (const float*)(C.ws + WS_MISC + MSS_OFF) + chain * 72; float* MSM = (float*)(C.ws + WS_MISC + MSM_OFF) + chain * 36;
    unsigned long long v[36]; float nn[36];
#pragma unroll
    for (int j = 0; j < 36; ++j) v[j] = *(const unsigned long long*)(base + (size_t)j * 4096);
    const bool don = (half == 0 && tid < 64);
    if (don) {
#pragma unroll
        for (int j = 0; j < 36; ++j) nn[j] = MSN[j * 64 + tid]; }
    float c0 = 0.f, c1 = 0.f, c2 = 0.f, c3 = 0.f, nk = 0.f, m = 0.f;
#pragma unroll
    for (int j = 0; j < 36; ++j) {
        const float ml = MSS[2 * j], be = MSS[2 * j + 1], mn = fmaxf(be + m, ml), dec = expf(be + m - mn), sc = expf(ml - mn);
        *(unsigned long long*)(base + (size_t)j * 4096) = (unsigned long long)cvt_pk_bf16(c0, c1) | ((unsigned long long)cvt_pk_bf16(c2, c3) << 32);
        if (half == 0 && tid == 0) MSM[j] = m;
        const unsigned lo = (unsigned)v[j], hi = (unsigned)(v[j] >> 32);
        c0 = dec * c0 + sc * bflo(lo); c1 = dec * c1 + sc * bfhi(lo); c2 = dec * c2 + sc * bflo(hi); c3 = dec * c3 + sc * bfhi(hi);
        if (don) { MSN[j * 64 + tid] = nk; nk = dec * nk + sc * nn[j]; }
        m = mn;
    }
}
__device__ __forceinline__ void ml_out_item(const Ctx& C, int l, int b, int hd, int c) {
    const bf16_t* Z = (const bf16_t*)(C.ws + WS_Z); const float* GT = (const float*)(C.ws + WS_GATES); bf16_t* Y = (bf16_t*)(C.ws + WS_HY);
    const bf16_t* MST = (const bf16_t*)(C.ws + WS_MST); const float* MSN = (const float*)(C.ws + WS_MISC + MSN_OFF); const float* MSM = (const float*)(C.ws + WS_MISC + MSM_OFF);
    LAS bf16_t* Qs = (LAS bf16_t*)C.lds; LAS bf16_t* Ks = Qs + 64 * TS; LAS bf16_t* VT = Ks + 64 * TS; LAS bf16_t* CF = VT + 64 * TS; LAS bf16_t* CB = CF + 64 * TS;
    LAS float* QK = (LAS float*)(C.lds + 46080);
    LAS bf16_t* AP = (LAS bf16_t*)(C.lds + 63488);
    LAS float* sc = (LAS float*)(C.lds + 89088);
    const int r0 = ml_row0(b, c), tid = C.tid, lane = C.lane, chf = (b * 4 + hd) * 2, jf = ml_jf(c), jb = ml_jb(c);
    const int s = tid >> 3, c8 = 8 * (tid & 7);
    { const bf16_t* zr = Z + (size_t)(r0 + s) * ZLD + hd * 64 + c8;
      const u32x4 qw = *(const u32x4*)zr, kw = *(const u32x4*)(zr + 256), vw = *(const u32x4*)(zr + 512);
      const u32x4 cf = *(const u32x4*)(MST + (size_t)((chf) * 36 + jf) * 4096 + s * 64 + c8), cb = *(const u32x4*)(MST + (size_t)((chf + 1) * 36 + jb) * 4096 + s * 64 + c8);
      if (C.wave < 2) { const int dir = C.wave, tok = dir ? 63 - lane : lane; LAS float* sd = sc + dir * 256;
        const float ig = GT[(size_t)(r0 + tok) * 16 + dir * 8 + hd], lf = logsig(GT[(size_t)(r0 + tok) * 16 + dir * 8 + 4 + hd]), min_ = MSM[(chf + dir) * 36 + (dir ? jb : jf)];
        const float bb = scan_add(lf, lane), a = ig - bb, pm = scan_max(a, lane), mx = fmaxf(min_, pm);
        sd[tok] = -mx; sd[64 + tok] = a; sd[128 + tok] = expf(min_ - mx); sd[192 + tok] = expf(-(bb + mx));
        sc[512 + dir * 64 + lane] = MSN[(size_t)((chf + dir) * 36 + (dir ? jb : jf)) * 64 + lane]; }
      *(LAS u32x4*)(Qs + s * TS + c8) = qw; *(LAS u32x4*)(CF + s * TS + c8) = cf; *(LAS u32x4*)(CB + s * TS + c8) = cb;
      const unsigned kk[4] = {kw.x, kw.y, kw.z, kw.w}, vv[4] = {vw.x, vw.y, vw.z, vw.w}; u32x4 ks;
      ks.x = cvt_pk_bf16(bflo(kk[0]) * 0.125f, bfhi(kk[0]) * 0.125f); ks.y = cvt_pk_bf16(bflo(kk[1]) * 0.125f, bfhi(kk[1]) * 0.125f); ks.z = cvt_pk_bf16(bflo(kk[2]) * 0.125f, bfhi(kk[2]) * 0.125f); ks.w = cvt_pk_bf16(bflo(kk[3]) * 0.125f, bfhi(kk[3]) * 0.125f);
      *(LAS u32x4*)(Ks + s * TS + c8) = ks;
#pragma unroll
      for (int e = 0; e < 4; ++e) { VT[(c8 + 2 * e) * TS + s] = (bf16_t)(vv[e] & 0xffffu); VT[(c8 + 2 * e + 1) * TS + s] = (bf16_t)(vv[e] >> 16); } }
    __syncthreads();
    for (int t = C.wave; t < 16; t += 8) { const int mt = t >> 2, nt = t & 3; f32x4 acc = {0.f, 0.f, 0.f, 0.f};
        lds_mma<64>(acc, Qs + mt * 16 * TS, TS, Ks + nt * 16 * TS, TS, lane);
#pragma unroll
        for (int r = 0; r < 4; ++r) QK[(mt * 16 + 4 * (lane >> 4) + r) * 68 + nt * 16 + (lane & 15)] = acc[r]; }
    __syncthreads();
    { const int t = tid >> 3, s0 = 8 * (tid & 7);
      const float rtf = sc[t], wf = sc[128 + t], emf = sc[192 + t], rtb = sc[256 + t], wb = sc[256 + 128 + t], emb = sc[256 + 192 + t];
      float sf[8], sb[8], rsf = 0.f, rsb = 0.f, qnf = 0.f, qnb = 0.f;
      const u32x4 qw = *(const LAS u32x4*)(Qs + t * TS + s0); const unsigned qq[4] = {qw.x, qw.y, qw.z, qw.w}; float qv[8];
#pragma unroll
      for (int e = 0; e < 4; ++e) { qv[2 * e] = bflo(qq[e]); qv[2 * e + 1] = bfhi(qq[e]); }
#pragma unroll
      for (int e = 0; e < 8; ++e) { const int ss = s0 + e; const float qk = QK[t * 68 + ss];
        sf[e] = (ss <= t) ? qk * expf(rtf + sc[64 + ss]) : 0.f; sb[e] = (ss >= t) ? qk * expf(rtb + sc[256 + 64 + ss]) : 0.f; rsf += sf[e]; rsb += sb[e];
        qnf += qv[e] * sc[512 + ss]; qnb += qv[e] * sc[576 + ss]; }
#pragma unroll
      for (int o = 1; o < 8; o <<= 1) { rsf += __shfl_xor(rsf, o); rsb += __shfl_xor(rsb, o); qnf += __shfl_xor(qnf, o); qnb += __shfl_xor(qnb, o); }
      const float idf = 1.0f / fmaxf(fabsf(rsf + wf * qnf), emf), idb = 1.0f / fmaxf(fabsf(rsb + wb * qnb), emb), qf = wf * idf, qb = wb * idb;
      u32x4 pw, fw, bw;
      pw.x = cvt_pk_bf16(sf[0] * idf + sb[0] * idb, sf[1] * idf + sb[1] * idb); pw.y = cvt_pk_bf16(sf[2] * idf + sb[2] * idb, sf[3] * idf + sb[3] * idb);
      pw.z = cvt_pk_bf16(sf[4] * idf + sb[4] * idb, sf[5] * idf + sb[5] * idb); pw.w = cvt_pk_bf16(sf[6] * idf + sb[6] * idb, sf[7] * idf + sb[7] * idb);
      fw.x = cvt_pk_bf16(qv[0] * qf, qv[1] * qf); fw.y = cvt_pk_bf16(qv[2] * qf, qv[3] * qf); fw.z = cvt_pk_bf16(qv[4] * qf, qv[5] * qf); fw.w = cvt_pk_bf16(qv[6] * qf, qv[7] * qf);
      bw.x = cvt_pk_bf16(qv[0] * qb, qv[1] * qb); bw.y = cvt_pk_bf16(qv[2] * qb, qv[3] * qb); bw.z = cvt_pk_bf16(qv[4] * qb, qv[5] * qb); bw.w = cvt_pk_bf16(qv[6] * qb, qv[7] * qb);
      *(LAS u32x4*)(AP + t * 200 + s0) = pw; *(LAS u32x4*)(AP + t * 200 + 64 + s0) = fw; *(LAS u32x4*)(AP + t * 200 + 128 + s0) = bw; }
    __syncthreads();
    for (int t = C.wave; t < 16; t += 8) { const int mt = t >> 2, nt = t & 3; f32x4 acc = {0.f, 0.f, 0.f, 0.f};
        lds_mma<64>(acc, AP + mt * 16 * 200, 200, VT + nt * 16 * TS, TS, lane);
        lds_mma<64>(acc, AP + mt * 16 * 200 + 64, 200, CF + nt * 16 * TS, TS, lane);
        lds_mma<64>(acc, AP + mt * 16 * 200 + 128, 200, CB + nt * 16 * TS, TS, lane);
#pragma unroll
        for (int r = 0; r < 4; ++r) QK[(mt * 16 + 4 * (lane >> 4) + r) * 68 + nt * 16 + (lane & 15)] = acc[r]; }
    __syncthreads();
    { const int t = tid >> 3, v0 = 8 * (tid & 7); float h[8]; float sm = 0.f;
#pragma unroll
      for (int e = 0; e < 8; ++e) { h[e] = QK[t * 68 + v0 + e]; sm += h[e]; }
      sm += __shfl_xor(sm, 1); sm += __shfl_xor(sm, 2); sm += __shfl_xor(sm, 4); const float mu = sm * (1.0f / 64.0f); float q = 0.f;
#pragma unroll
      for (int e = 0; e < 8; ++e) { h[e] -= mu; q += h[e] * h[e]; }
      q += __shfl_xor(q, 1); q += __shfl_xor(q, 2); q += __shfl_xor(q, 4); const float rstd = 1.0f / sqrtf(q * (1.0f / 64.0f) + LN_EPS);
      const float* nw = C.in[I_MNORM] + l * 256 + hd * 64 + v0; const u32x4 ow = *(const u32x4*)(Z + (size_t)(r0 + t) * ZLD + 768 + hd * 64 + v0); const unsigned oo[4] = {ow.x, ow.y, ow.z, ow.w};
      float y[8];
#pragma unroll
      for (int e = 0; e < 4; ++e) { y[2 * e] = h[2 * e] * rstd * nw[2 * e] * sigm(bflo(oo[e])); y[2 * e + 1] = h[2 * e + 1] * rstd * nw[2 * e + 1] * sigm(bfhi(oo[e])); }
      u32x4 w; w.x = cvt_pk_bf16(y[0], y[1]); w.y = cvt_pk_bf16(y[2], y[3]); w.z = cvt_pk_bf16(y[4], y[5]); w.w = cvt_pk_bf16(y[6], y[7]);
      *(u32x4*)(Y + (size_t)(r0 + t) * D + hd * 64 + v0) = w; }
    __syncthreads();
}
__device__ __forceinline__ const bf16_t* wt_ptr(const Ctx& C, int l, size_t off) { return (const bf16_t*)(C.ws + WS_WT + (size_t)l * WT_LAYER + off); }
template <class Epi> __device__ __forceinline__ void run_gemm(const Ctx& C, const Gemm& g, const Epi& E) {
    StaticOrder S; S.init(g.M, g.N, C.G, C.bid);
    gemm_phase<Epi, StaticOrder, true, true>(C.lds, g, S, E);
}
__device__ __forceinline__ void p_inproj(const Ctx& C, int l) {
    Gemm g{(const bf16_t*)(C.ws + WS_HY), wt_ptr(C, l, WT_IN), NROWS, 2304, D, D, D, 0, 0};
    EpiInProj E{(bf16_t*)(C.ws + WS_Z), (bf16_t*)(C.ws + WS_UH)}; run_gemm(C, g, E);
}
__device__ __forceinline__ void p_outproj(const Ctx& C, int l) {
    Gemm g{(const bf16_t*)(C.ws + WS_HY), wt_ptr(C, l, WT_OUT), l == 0 ? NROWS : NLAT, D, D, D, D, 0, 0};
    float* XC = (float*)(C.ws + WS_XC);
    EpiResGate E{l == 0 ? C.in[I_X] : C.out, l == 0 ? C.in[I_CTX] : XC, C.out, XC, (const float*)(C.ws + WS_MOD) + (size_t)l * 17 * 6144 + 2048, ALPHA}; run_gemm(C, g, E);
}
__device__ __forceinline__ void p_ffnin(const Ctx& C, int l) {
    Gemm g{(const bf16_t*)(C.ws + WS_HY), wt_ptr(C, l, WT_FFIN), l == 0 ? NROWS : NLAT, 2 * DFF, D, D, D, 0, 0};
    EpiSwiGlu E{(bf16_t*)(C.ws + WS_ACT), DFF}; run_gemm(C, g, E);
}
__device__ __forceinline__ void p_ffnout(const Ctx& C, int l) {
    Gemm g{(const bf16_t*)(C.ws + WS_ACT), wt_ptr(C, l, WT_FFOUT), l == 0 ? NROWS : NLAT, D, DFF, DFF, DFF, 0, 0};
    float* XC = (float*)(C.ws + WS_XC);
    EpiResGate E{C.out, XC, C.out, XC, (const float*)(C.ws + WS_MOD) + (size_t)l * 17 * 6144 + 5120, ALPHA}; run_gemm(C, g, E);
}
__device__ __forceinline__ void s5_table_item(const Ctx& C, int l, int g, int part) {
    LAS float* APW = (LAS float*)C.lds;
    LAS float* BB = APW + 4352;
    LAS float* CC = BB + 4096;
    LAS float* KT = CC + 2048;
    const int tid = C.tid;
    if (tid < 128) { const int d = tid >> 6, n = tid & 63, ix = ((l * 2 + d) * 16 + g) * 64 + n;
        const double are = C.in[I_ARE][ix], aim = C.in[I_AIM][ix], dt = exp((double)C.in[I_LDT][(l * 2 + d) * 16 + g]);
        const double mag = exp(are * dt), abr = mag * cos(aim * dt), abi = mag * sin(aim * dt), d2 = are * are + aim * aim;
        const double cr = ((abr - 1.0) * are + abi * aim) / d2, ci = (abi * are - (abr - 1.0) * aim) / d2;
        double pr = 1.0, pi = 0.0;
        for (int k = 0; k < 17; ++k) { APW[((d * 17 + k) * 64 + n) * 2] = (float)pr; APW[((d * 17 + k) * 64 + n) * 2 + 1] = (float)pi; const double t = pr * abr - pi * abi; pi = pr * abi + pi * abr; pr = t; }
        for (int q = 0; q < 16; ++q) { const double re = C.in[I_BRE][((size_t)(l * 16 + g) * 64 + n) * 16 + q], im = C.in[I_BIM][((size_t)(l * 16 + g) * 64 + n) * 16 + q];
            BB[((d * 64 + n) * 16 + q) * 2] = (float)(cr * re - ci * im); BB[((d * 64 + n) * 16 + q) * 2 + 1] = (float)(cr * im + ci * re); } }
    for (int idx = tid; idx < 1024; idx += 512) { const int p = idx >> 6, n = idx & 63; CC[idx * 2] = C.in[I_CRE][((size_t)(l * 16 + g) * 16 + p) * 64 + n]; CC[idx * 2 + 1] = C.in[I_CIM][((size_t)(l * 16 + g) * 16 + p) * 64 + n]; }
    __syncthreads();
    { const int d = tid >> 8, k = (tid >> 4) & 15, p = tid & 15; float acc[16];
#pragma unroll
      for (int q = 0; q < 16; ++q) acc[q] = 0.f;
      for (int n = 0; n < 64; ++n) { const float cr = CC[(p * 64 + n) * 2], ci = CC[(p * 64 + n) * 2 + 1], ar = APW[((d * 17 + k) * 64 + n) * 2], ai = APW[((d * 17 + k) * 64 + n) * 2 + 1];
          const float zr = cr * ar - ci * ai, zi = cr * ai + ci * ar;
#pragma unroll
          for (int q = 0; q < 16; ++q) acc[q] += zr * BB[((d * 64 + n) * 16 + q) * 2] - zi * BB[((d * 64 + n) * 16 + q) * 2 + 1]; }
#pragma unroll
      for (int q = 0; q < 16; ++q) KT[((d * 16 + k) * 16 + p) * 16 + q] = acc[q]; }
    __syncthreads();
    bf16_t* BtY = (bf16_t*)(C.ws + WS_WT + (size_t)l * WT_LAYER + WT_BTY) + (size_t)g * 256 * 512; bf16_t* BtS = (bf16_t*)(C.ws + WS_WT + (size_t)l * WT_LAYER + WT_BTS) + (size_t)g * 256 * 256;
    for (int i = 0; i < 4; ++i) { const int idx = tid + 512 * i, row = part * 32 + (idx >> 6), col0 = (idx & 63) * 8, t = row >> 4, p = row & 15; float v[8];
        if (col0 < 256) { const int s = col0 >> 4, q0 = col0 & 15;
#pragma unroll
            for (int e = 0; e < 8; ++e) v[e] = s < t ? KT[((0 * 16 + (t - s)) * 16 + p) * 16 + q0 + e] : (s > t ? KT[((1 * 16 + (s - t)) * 16 + p) * 16 + q0 + e] : KT[(p) * 16 + q0 + e] + KT[((16) * 16 + p) * 16 + q0 + e]); }
        else { const int h0 = col0 - 256, ds = h0 >> 7, im = (h0 >> 6) & 1, n0 = h0 & 63, kp = ds ? 16 - t : t + 1;
#pragma unroll
            for (int e = 0; e < 8; ++e) { const int n = n0 + e; const float cr = CC[(p * 64 + n) * 2], ci = CC[(p * 64 + n) * 2 + 1], ar = APW[((ds * 17 + kp) * 64 + n) * 2], ai = APW[((ds * 17 + kp) * 64 + n) * 2 + 1];
                v[e] = im ? -(cr * ai + ci * ar) : (cr * ar - ci * ai); } }
        u32x4 w; w.x = cvt_pk_bf16(v[0], v[1]); w.y = cvt_pk_bf16(v[2], v[3]); w.z = cvt_pk_bf16(v[4], v[5]); w.w = cvt_pk_bf16(v[6], v[7]);
        *(u32x4*)(BtY + (size_t)row * 512 + col0) = w; }
    for (int i = 0; i < 2; ++i) { const int idx = tid + 512 * i, row = part * 32 + (idx >> 5), col0 = (idx & 31) * 8, s = col0 >> 4, q0 = col0 & 15, ds = row >> 7, im = (row >> 6) & 1, n = row & 63, kp = ds ? s : 15 - s;
        const float ar = APW[((ds * 17 + kp) * 64 + n) * 2], ai = APW[((ds * 17 + kp) * 64 + n) * 2 + 1]; float v[8];
#pragma unroll
        for (int e = 0; e < 8; ++e) { const float br = BB[((ds * 64 + n) * 16 + q0 + e) * 2], bi = BB[((ds * 64 + n) * 16 + q0 + e) * 2 + 1]; v[e] = im ? (ar * bi + ai * br) : (ar * br - ai * bi); }
        u32x4 w; w.x = cvt_pk_bf16(v[0], v[1]); w.y = cvt_pk_bf16(v[2], v[3]); w.z = cvt_pk_bf16(v[4], v[5]); w.w = cvt_pk_bf16(v[6], v[7]);
        *(u32x4*)(BtS + (size_t)row * 256 + col0) = w; }
    __syncthreads();
}
__device__ __forceinline__ int s5_chunk_id(int b, int dir, int j) { if (j < 16) return 2048 + b * 16 + (dir ? 15 - j : j); const int jl = j - 16; return b * 128 + (dir ? 127 - jl : jl); }
__device__ __forceinline__ void s5_carry_item(const Ctx& C, int l, int item) {
    const int gid = item * 512 + C.tid, n = gid & 63, dir = (gid >> 6) & 1, g = (gid >> 7) & 15, b = gid >> 11;
    const float* S = (const float*)(C.ws + WS_S5S) + (size_t)g * NCH_S5 * 256 + dir * 128 + n; bf16_t* Hh = (bf16_t*)(C.ws + WS_UH) + (size_t)g * NCH_S5 * 512 + 256 + dir * 128 + n;
    const int ix = ((l * 2 + dir) * 16 + g) * 64 + n;
    const double are = C.in[I_ARE][ix], aim = C.in[I_AIM][ix], dt = exp((double)C.in[I_LDT][(l * 2 + dir) * 16 + g]), mag = exp(16.0 * are * dt);
    const float a_r = (float)(mag * cos(16.0 * aim * dt)), a_i = (float)(mag * sin(16.0 * aim * dt));
    float cr = 0.f, ci = 0.f;
    for (int j0 = 0; j0 < 144; j0 += 16) { float sr[16], si[16];
#pragma unroll
        for (int jj = 0; jj < 16; ++jj) { const int ch = s5_chunk_id(b, dir, j0 + jj); sr[jj] = S[(size_t)ch * 256]; si[jj] = S[(size_t)ch * 256 + 64]; }
#pragma unroll
        for (int jj = 0; jj < 16; ++jj) { const int ch = s5_chunk_id(b, dir, j0 + jj); Hh[(size_t)ch * 512] = (bf16_t)f2bf(cr); Hh[(size_t)ch * 512 + 64] = (bf16_t)f2bf(ci);
            const float nr = a_r * cr - a_i * ci + sr[jj], ni = a_r * ci + a_i * cr + si[jj]; cr = nr; ci = ni; } }
}
__device__ __forceinline__ void p_s5_gemmS(const Ctx& C, int l) {
    Gemm g{(const bf16_t*)(C.ws + WS_UH), wt_ptr(C, l, WT_BTS), 16 * NCH_S5, 256, 256, 512, 256, 9, (size_t)256 * 256 * 2};
    EpiF32 E{(float*)(C.ws + WS_S5S), 256}; run_gemm(C, g, E);
}
__device__ __forceinline__ void p_s5_gemmY(const Ctx& C, int l) {
    Gemm g{(const bf16_t*)(C.ws + WS_UH), wt_ptr(C, l, WT_BTY), 16 * NCH_S5, 256, 512, 512, 512, 9, (size_t)256 * 512 * 2};
    EpiS5Y E{(const bf16_t*)(C.ws + WS_UH), C.in[I_DSK] + l * 256, (bf16_t*)(C.ws + WS_YS5)}; run_gemm(C, g, E);
}
__device__ __forceinline__ void p_s5_glu(const Ctx& C, int l) {
    Gemm g{(const bf16_t*)(C.ws + WS_YS5), wt_ptr(C, l, WT_GLU), l == 0 ? NROWS : NLAT, 256, 256, 256, 256, 0, 0};
    EpiGlu E{(const bf16_t*)(C.ws + WS_YS5), C.in[I_GLUB] + l * 256, (bf16_t*)(C.ws + WS_HY)}; run_gemm(C, g, E);
}
__device__ __forceinline__ void p_mixA(const Ctx& C, int l) {
    p_s5_gemmS(C, l);
    __syncthreads();
    const int nsgu = l == 0 ? 288 : 256, ncv = l == 0 ? 576 : 512, total = 2304 + nsgu + ncv;
    for (int it = C.bid; it < total; it += C.G) {
        int r = it;
        if (r < 2304) { const int b = r / 144, q = r % 144; ml_state_item(C, b, q / 36, q % 36); continue; } r -= 2304;
        if (r < nsgu) { sgu_item(C, l, r); continue; } r -= nsgu;
        conv_item(C, l, r);
    }
}
__device__ __forceinline__ void p_mixB(const Ctx& C, int l) {
    for (int it = C.bid; it < 320; it += C.G) { if (it < 256) ml_carry_item(C, it); else s5_carry_item(C, l, it - 256); }
}
__device__ __forceinline__ void p_mixC(const Ctx& C, int l) {
    p_s5_gemmY(C, l);
    __syncthreads();
    const int ncs = l == 0 ? 36 : 32;
    for (int it = C.bid; it < 64 * ncs; it += C.G) { const int bh = it / ncs; ml_out_item(C, l, bh >> 2, bh & 3, it % ncs); }
}

__global__ void __launch_bounds__(512, 2) mk_fwd(Args a) {
    extern __shared__ __attribute__((aligned(16))) unsigned char lds_raw[];
    Ctx C; C.lds = (LAS unsigned char*)lds_raw; C.tid = threadIdx.x; C.lane = C.tid & 63; C.wave = __builtin_amdgcn_readfirstlane(C.tid >> 6); C.bid = blockIdx.x; C.G = gridDim.x;
    C.in = a.in; C.out = a.out; C.ws = a.ws;
    const int lo = a.ph_lo, hi = a.ph_hi;
    volatile LAS unsigned* MISC = (volatile LAS unsigned*)(C.lds + LDS_BYTES - 64);
    if (C.tid < 16) MISC[C.tid] = 0u;
    __syncthreads();
    XcdBarrier bar = xcd_barrier_post((unsigned*)(a.ws + WS_CTL) + 4096, MISC);
#define PH(k, body) if (lo <= (k) && (k) < hi) { body; if ((k) == MK_REPEAT_PH) { xcd_barrier(bar); body; } if ((k) + 1 < hi) { if ((k) == 0) { __threadfence(); cooperative_groups::this_grid().sync(); } else xcd_barrier(bar); } }
    PH(0, p_prologue(C))
    PH(1, p_rowpass(C, 0, 0))
    PH(2, p_inproj(C, 0))
    PH(3, p_mixA(C, 0))
    PH(4, p_mixB(C, 0))
    PH(5, p_mixC(C, 0))
    PH(6, p_s5_glu(C, 0))
    PH(7, p_outproj(C, 0))
    PH(8, p_rowpass(C, 1, 0))
    PH(9, p_ffnin(C, 0))
    PH(10, p_ffnout(C, 0))
    PH(11, p_rowpass(C, 2, 0))
    PH(12, p_inproj(C, 1))
    PH(13, p_mixA(C, 1))
    PH(14, p_mixB(C, 1))
    PH(15, p_mixC(C, 1))
    PH(16, p_s5_glu(C, 1))
    PH(17, p_outproj(C, 1))
    PH(18, p_rowpass(C, 1, 1))
    PH(19, p_ffnin(C, 1))
    PH(20, p_ffnout(C, 1))
    PH(21, p_rowpass(C, 2, 1))
#undef PH
}
}

extern "C" void kernel_launch(void* const* d_in, const int* in_sizes, int n_in, void* d_out, int out_size, void* d_ws, size_t ws_size, hipStream_t stream) {
    static int ready = 0;
    if (!ready) {
        if (n_in != 34 || in_sizes[0] != mk::NLAT * mk::D || out_size != mk::NLAT * mk::D || ws_size < mk::WS_END) { fprintf(stderr, "kernel_launch: unexpected shapes (n_in %d, in0 %d, out %d, ws %zu)\n", n_in, n_in > 0 ? in_sizes[0] : -1, out_size, ws_size); ready = -1; return; }
        if (hipFuncSetAttribute((const void*)mk::mk_fwd, hipFuncAttributeMaxDynamicSharedMemorySize, mk::LDS_BYTES) != hipSuccess) { fprintf(stderr, "kernel_launch: hipFuncSetAttribute failed\n"); ready = -1; return; }
        ready = 1;
    }
    if (ready < 0) return;
    if (hipMemsetAsync((char*)d_ws + mk::WS_CTL, 0, 65536, stream) != hipSuccess) { fprintf(stderr, "kernel_launch: hipMemsetAsync failed\n"); return; }
    mk::Args a{};
    for (int i = 0; i < 34; ++i) a.in[i] = (const float*)d_in[i];
    a.out = (float*)d_out; a.ws = (unsigned char*)d_ws;
#if MK_ONE_LAUNCH
    a.ph_lo = 0; a.ph_hi = mk::NPH;
    void* args[] = {&a};
    hipError_t e = hipLaunchCooperativeKernel((const void*)mk::mk_fwd, dim3(256), dim3(512), args, mk::LDS_BYTES, stream);
    if (e != hipSuccess) fprintf(stderr, "cooperative launch failed: %s\n", hipGetErrorString(e));
#else
    for (int ph = 0; ph < mk::NPH; ++ph) {
        a.ph_lo = ph; a.ph_hi = ph + 1;
        hipLaunchKernelGGL(mk::mk_fwd, dim3(256), dim3(512), mk::LDS_BYTES, stream, a);
    }
#endif
}
```

```cpp
#include <hip/hip_runtime.h>
#include <hip/hip_cooperative_groups.h>
#include <cstdio>
#include <cstdint>
namespace pg8 {
#define PG8_LAS __attribute__((address_space(3)))
typedef unsigned short bf16_t;
typedef short bf16x8 __attribute__((ext_vector_type(8)));
typedef float f32x4 __attribute__((ext_vector_type(4)));
typedef unsigned u32x4 __attribute__((ext_vector_type(4)));
constexpr int BM = 256, BK = 64, HALF = 128, HTB = HALF * BK * 2  , STAGE_BYTES = 8 * HTB, NXCD = 8, WGM = 8;

__host__ __device__ __forceinline__ int lds_byte(int r, int c) { const int st = (r >> 4) * 2 + (c >> 5), rr = r & 15, cc = c & 31, ob = rr * 64 + cc * 2; return st * 1024 + (ob ^ (((ob >> 9) & 1) << 5)); }
__host__ __device__ __forceinline__ void stage_rc(int b, int& R, int& C) { const int st = b / 1024, sb = b % 1024, swz = sb ^ (((sb >> 9) & 1) << 5); R = (st >> 1) * 16 + swz / 64; C = (st & 1) * 32 + (swz % 64) / 2; }
__host__ __device__ __forceinline__ int perm32(int rho) { const int n = rho >> 4, i = rho & 15; return 8 * (i >> 2) + 4 * n + (i & 3); }

struct Unit { int pm, pn; };
struct Gemm { const bf16_t* A; const bf16_t* Bt; int M, N, K, lda, ldb, bgrp; size_t bgrp_stride; };

struct StaticOrder {
    int nM, nN, nwg, G, c;
    __host__ __device__ void init(int M, int N, int G_, int c_) { nM = M / BM; nN = N / BM; nwg = nM * nN; G = G_; c = c_; }
    __host__ __device__ bool next(int i, Unit& u) const {
        const long L = (long)i * G + c; if (L >= nwg) return false;
        int wgid = (int)L; { const int q = nwg / NXCD, r = nwg % NXCD, xcd = wgid % NXCD, off = wgid / NXCD; wgid = (xcd < r ? xcd * (q + 1) : r * (q + 1) + (xcd - r) * q) + off; }
        const int nig = WGM * nN, gid = wgid / nig, fm = gid * WGM, gsz = (nM - fm) < WGM ? (nM - fm) : WGM;
        u.pm = fm + ((wgid % nig) % gsz); u.pn = (wgid % nig) / gsz; return true;
    }
    __device__ __forceinline__ void a_ready(const Unit&) const {}
    __device__ __forceinline__ void done(const Unit&) const {}
};

__device__ __forceinline__ unsigned cvt_pk_bf16(float lo, float hi) { unsigned r; asm volatile("v_cvt_pk_bf16_f32 %0, %1, %2" : "=v"(r) : "v"(lo), "v"(hi)); return r; }
__device__ __forceinline__ float bflo(unsigned w) { return __uint_as_float(w << 16); }
__device__ __forceinline__ float bfhi(unsigned w) { return __uint_as_float(w & 0xffff0000u); }
__device__ __forceinline__ float sigm(float x) { return __builtin_amdgcn_rcpf(1.0f + __expf(-x)); }
__device__ __forceinline__ float gelu_t(float x) { const float u = 1.5957691216f * (x + 0.044715f * x * x * x); return x * sigm(u); }
__device__ __forceinline__ u32x4 pack8(const f32x4 a, const f32x4 b) { u32x4 w; w.x = cvt_pk_bf16(a[0], a[1]); w.y = cvt_pk_bf16(a[2], a[3]); w.z = cvt_pk_bf16(b[0], b[1]); w.w = cvt_pk_bf16(b[2], b[3]); return w; }

constexpr int NLAT = 32768, NROWS = 36864, ZLD = 2048, NCH_S5 = 2304;

struct EpiInProj {
    static constexpr bool PERM = true, AFTER_DRAIN = false;
    bf16_t* Z; bf16_t* UH; float* GT; const float* gbias;
    __device__ __forceinline__ void operator()(const f32x4 (&acc)[2][2][4][2], const Unit& u, int wr, int wc, int fr, int fq) const {
#pragma unroll
        for (int ai = 0; ai < 2; ++ai)
#pragma unroll
            for (int m = 0; m < 4; ++m) { const int row = u.pm * BM + ai * HALF + wr * 64 + m * 16 + fr;
#pragma unroll
                for (int bj = 0; bj < 2; ++bj) { const u32x4 w = pack8(acc[ai][bj][m][0], acc[ai][bj][m][1]); const int cc = bj * HALF + wc * 32 + 8 * fq;
                    if (u.pn < 8) *(u32x4*)(Z + (size_t)row * ZLD + u.pn * BM + cc) = w;
                    else if (u.pn == 9) { if (cc < 16) { *(f32x4*)(GT + (size_t)row * 16 + cc) = acc[ai][bj][m][0] + *(const f32x4*)(gbias + cc); *(f32x4*)(GT + (size_t)row * 16 + cc + 4) = acc[ai][bj][m][1] + *(const f32x4*)(gbias + cc + 4); } }
                    else { const int g = cc >> 4, q0 = cc & 15; *(u32x4*)(UH + ((size_t)(g * NCH_S5 + (row >> 4)) * 512 + (row & 15) * 16 + q0)) = w; } } }
    }
};
struct EpiResGate {
    static constexpr bool PERM = false, AFTER_DRAIN = false;
    const float* srcL; const float* srcC; float* dstL; float* dstC; const float* gate; float alpha;
    __device__ __forceinline__ void operator()(const f32x4 (&acc)[2][2][4][2], const Unit& u, int wr, int wc, int fr, int fq) const {
        const int row0 = u.pm * BM; const bool lat = row0 < NLAT; const int mi = lat ? (row0 >> 11) : 16;
        const float* src = lat ? srcL + (size_t)row0 * 1024 : srcC + (size_t)(row0 - NLAT) * 1024; float* dst = lat ? dstL + (size_t)row0 * 1024 : dstC + (size_t)(row0 - NLAT) * 1024;
        const float* gp = gate + (size_t)mi * 6144;
#pragma unroll
        for (int bj = 0; bj < 2; ++bj)
#pragma unroll
            for (int n = 0; n < 2; ++n) { const int col = u.pn * BM + bj * HALF + wc * 32 + n * 16 + 4 * fq; const f32x4 gv = *(const f32x4*)(gp + col);
#pragma unroll
                for (int ai = 0; ai < 2; ++ai)
#pragma unroll
                    for (int m = 0; m < 4; ++m) { const size_t off = (size_t)(ai * HALF + wr * 64 + m * 16 + fr) * 1024 + col; const f32x4 x = *(const f32x4*)(src + off); *(f32x4*)(dst + off) = x * alpha + gv * acc[ai][bj][m][n]; } }
    }
};
struct EpiSwiGlu {
    static constexpr bool PERM = true, AFTER_DRAIN = false;
    bf16_t* ACT; int ldc;
    __device__ __forceinline__ void operator()(const f32x4 (&acc)[2][2][4][2], const Unit& u, int wr, int wc, int fr, int fq) const {
#pragma unroll
        for (int ai = 0; ai < 2; ++ai)
#pragma unroll
            for (int m = 0; m < 4; ++m) { const int row = u.pm * BM + ai * HALF + wr * 64 + m * 16 + fr; f32x4 o[2];
#pragma unroll
                for (int n = 0; n < 2; ++n)
#pragma unroll
                    for (int e = 0; e < 4; ++e) { const float g = acc[ai][0][m][n][e]; o[n][e] = g * sigm(g) * acc[ai][1][m][n][e]; }
                *(u32x4*)(ACT + (size_t)row * ldc + u.pn * HALF + wc * 32 + 8 * fq) = pack8(o[0], o[1]); }
    }
};
struct EpiF32 {
    static constexpr bool PERM = false, AFTER_DRAIN = false;
    float* O; int ldc;
    __device__ __forceinline__ void operator()(const f32x4 (&acc)[2][2][4][2], const Unit& u, int wr, int wc, int fr, int fq) const {
#pragma unroll
        for (int ai = 0; ai < 2; ++ai)
#pragma unroll
            for (int m = 0; m < 4; ++m) { const size_t ro = (size_t)(u.pm * BM + ai * HALF + wr * 64 + m * 16 + fr) * ldc;
#pragma unroll
                for (int bj = 0; bj < 2; ++bj)
#pragma unroll
                    for (int n = 0; n < 2; ++n) *(f32x4*)(O + ro + u.pn * BM + bj * HALF + wc * 32 + n * 16 + 4 * fq) = acc[ai][bj][m][n]; }
    }
};
struct EpiS5Y {
    static constexpr bool PERM = true, AFTER_DRAIN = false;
    const bf16_t* UH; const float* dsk; bf16_t* YS5;
    __device__ __forceinline__ void operator()(const f32x4 (&acc)[2][2][4][2], const Unit& u, int wr, int wc, int fr, int fq) const {
        const int g = (u.pm * BM) / NCH_S5;
#pragma unroll
        for (int bj = 0; bj < 2; ++bj) { const int col = bj * HALF + wc * 32 + 8 * fq, t = col >> 4, p0 = col & 15;
            const f32x4 d0 = *(const f32x4*)(dsk + g * 16 + p0), d1 = *(const f32x4*)(dsk + g * 16 + p0 + 4);
#pragma unroll
            for (int ai = 0; ai < 2; ++ai)
#pragma unroll
                for (int m = 0; m < 4; ++m) { const int row = u.pm * BM + ai * HALF + wr * 64 + m * 16 + fr, chunk = row - g * NCH_S5;
                    const u32x4 uw = *(const u32x4*)(UH + (size_t)row * 512 + col); f32x4 a = acc[ai][bj][m][0], b = acc[ai][bj][m][1];
                    a[0] += d0[0] * bflo(uw.x); a[1] += d0[1] * bfhi(uw.x); a[2] += d0[2] * bflo(uw.y); a[3] += d0[3] * bfhi(uw.y);
                    b[0] += d1[0] * bflo(uw.z); b[1] += d1[1] * bfhi(uw.z); b[2] += d1[2] * bflo(uw.w); b[3] += d1[3] * bfhi(uw.w);
#pragma unroll
                    for (int e = 0; e < 4; ++e) { a[e] = gelu_t(a[e]); b[e] = gelu_t(b[e]); }
                    *(u32x4*)(YS5 + (size_t)(chunk * 16 + t) * 256 + g * 16 + p0) = pack8(a, b); } }
    }
};
struct EpiGlu {
    static constexpr bool PERM = true, AFTER_DRAIN = false;
    const bf16_t* YS5; const float* gb; bf16_t* Y;
    __device__ __forceinline__ void operator()(const f32x4 (&acc)[2][2][4][2], const Unit& u, int wr, int wc, int fr, int fq) const {
#pragma unroll
        for (int bj = 0; bj < 2; ++bj) { const int col = bj * HALF + wc * 32 + 8 * fq; const f32x4 b0 = *(const f32x4*)(gb + col), b1 = *(const f32x4*)(gb + col + 4);
#pragma unroll
            for (int ai = 0; ai < 2; ++ai)
#pragma unroll
                for (int m = 0; m < 4; ++m) { const int row = u.pm * BM + ai * HALF + wr * 64 + m * 16 + fr; const u32x4 yw = *(const u32x4*)(YS5 + (size_t)row * 256 + col);
                    f32x4 a = acc[ai][bj][m][0] + b0, b = acc[ai][bj][m][1] + b1;
                    a[0] = bflo(yw.x) * sigm(a[0]); a[1] = bfhi(yw.x) * sigm(a[1]); a[2] = bflo(yw.y) * sigm(a[2]); a[3] = bfhi(yw.y) * sigm(a[3]);
                    b[0] = bflo(yw.z) * sigm(b[0]); b[1] = bfhi(yw.z) * sigm(b[1]); b[2] = bflo(yw.w) * sigm(b[2]); b[3] = bfhi(yw.w) * sigm(b[3]);
                    *(u32x4*)(Y + (size_t)row * 1024 + 768 + col) = pack8(a, b); } }
    }
};

template <class Epi, class Sched, bool ALIGN_EPI = false, bool SP2 = false>
__device__ __forceinline__ void gemm_phase(PG8_LAS unsigned char* lds, const Gemm g, const Sched& S, const Epi& E) {
    const int tid = threadIdx.x, wid = __builtin_amdgcn_readfirstlane(tid >> 6), lane = tid & 63, wr = wid >> 2, wc = wid & 3, fr = lane & 15, fq = lane >> 4;
    const int K = g.K, nt = K / BK;
    unsigned voffA[2], voffB[2];
#pragma unroll
    for (int i = 0; i < 2; ++i) { int R, C; stage_rc(tid * 16 + i * 8192, R, C); const int Rb = Epi::PERM ? ((R & ~31) + perm32(R & 31)) : R;
        voffA[i] = (unsigned)(R * g.lda + C) * 2u; voffB[i] = (unsigned)(Rb * g.ldb + C) * 2u; }
    const size_t kstep = (size_t)(BK * 2);
    const size_t hstepA = (size_t)HALF * g.lda * 2, hstepB = (size_t)HALF * g.ldb * 2;
    const size_t tstepA = 2 * hstepA, tstepB = 2 * hstepB;
#define PG8_ABASE(u) ((const char*)g.A + (size_t)(u).pm * tstepA)
#define PG8_BBASE(u) ((const char*)g.Bt + (size_t)(u).pn * tstepB + (g.bgrp ? (size_t)((u).pm / g.bgrp) * g.bgrp_stride : (size_t)0))
    const unsigned ldsw = (unsigned)wid * 1024u;
    const int aoff = lds_byte(wr * 64 + fr, fq * 8), boff = lds_byte(wc * 32 + fr, fq * 8);
#define PG8_SA(b, h) (((b) * 2 + (h)) * HTB)
#define PG8_SB(b, h) ((4 + (b) * 2 + (h)) * HTB)
#define PG8_STAGE(bufoff, gbase, voff) do { _Pragma("unroll") for (int _i = 0; _i < 2; ++_i) \
        __builtin_amdgcn_global_load_lds((const unsigned*)((const char*)(gbase) + (voff)[_i]), (PG8_LAS unsigned*)(lds + (bufoff) + ldsw + _i * 8192), 16, 0, 0); } while (0)
#define PG8_LDA(dst, b, h) do { _Pragma("unroll") for (int m = 0; m < 4; ++m) _Pragma("unroll") for (int k = 0; k < 2; ++k) dst[m][k] = *(const PG8_LAS bf16x8*)(lds + PG8_SA(b, h) + aoff + m * 2048 + k * 1024); } while (0)
#define PG8_LDB(dst, b, h) do { _Pragma("unroll") for (int n = 0; n < 2; ++n) _Pragma("unroll") for (int k = 0; k < 2; ++k) dst[n][k] = *(const PG8_LAS bf16x8*)(lds + PG8_SB(b, h) + boff + n * 2048 + k * 1024); } while (0)
#define PG8_MMA(ai, bj, At, Bt) do { __builtin_amdgcn_s_setprio(1); _Pragma("unroll") for (int m = 0; m < 4; ++m) _Pragma("unroll") for (int n = 0; n < 2; ++n) _Pragma("unroll") for (int k = 0; k < 2; ++k) \
        acc[ai][bj][m][n] = __builtin_amdgcn_mfma_f32_16x16x32_bf16(Bt[n][k], At[m][k], acc[ai][bj][m][n], 0, 0, 0); __builtin_amdgcn_s_setprio(0); } while (0)
#define PG8_WAIT_V(n) asm volatile("s_waitcnt vmcnt(" #n ")" ::: "memory")
#define PG8_WAIT_L(n) asm volatile("s_waitcnt lgkmcnt(" #n ")" ::: "memory")
#define PG8_BAR __builtin_amdgcn_s_barrier()
#define PG8_SCHED __builtin_amdgcn_sched_barrier(0)
    Unit cur, nxt; int ui = 0;
    if (!S.next(0, cur)) return;
    f32x4 acc[2][2][4][2];
#pragma unroll
    for (int a = 0; a < 2; ++a)
#pragma unroll
        for (int b = 0; b < 2; ++b)
#pragma unroll
            for (int m = 0; m < 4; ++m)
#pragma unroll
                for (int n = 0; n < 2; ++n) acc[a][b][m][n] = (f32x4){0.f, 0.f, 0.f, 0.f};
    bf16x8 At[4][2], B0[2][2], B1[2][2];
    const char* cA = PG8_ABASE(cur); const char* cB = PG8_BBASE(cur);
    S.a_ready(cur);
    if constexpr (SP2) {
        PG8_STAGE(PG8_SB(0, 0), cB, voffB); PG8_STAGE(PG8_SB(0, 1), cB + hstepB, voffB); PG8_STAGE(PG8_SA(0, 0), cA, voffA); PG8_STAGE(PG8_SA(0, 1), cA + hstepA, voffA);
        if (wr == 1) PG8_BAR;
        PG8_WAIT_V(2); PG8_BAR;
        PG8_STAGE(PG8_SB(1, 0), cB + kstep, voffB); PG8_STAGE(PG8_SA(1, 0), cA + kstep, voffA); PG8_STAGE(PG8_SB(1, 1), cB + hstepB + kstep, voffB);
        PG8_WAIT_V(6); PG8_BAR;
    } else {
        PG8_STAGE(PG8_SB(0, 0), cB, voffB); PG8_STAGE(PG8_SA(0, 0), cA, voffA); PG8_STAGE(PG8_SB(0, 1), cB + hstepB, voffB); PG8_STAGE(PG8_SA(0, 1), cA + hstepA, voffA);
        if (wr == 1) PG8_BAR;
        PG8_WAIT_V(4); PG8_BAR;
        PG8_STAGE(PG8_SB(1, 0), cB + kstep, voffB); PG8_STAGE(PG8_SA(1, 0), cA + kstep, voffA); PG8_STAGE(PG8_SB(1, 1), cB + hstepB + kstep, voffB);
        PG8_WAIT_V(6); PG8_BAR;
    }
    for (;;) {
        const bool has_next = S.next(ui + 1, nxt);
        const char* nA = has_next ? PG8_ABASE(nxt) : cA; const char* nB = has_next ? PG8_BBASE(nxt) : cB;
        for (int t = 0; t < nt; t += 2) {
            const bool last = (t == nt - 2);
            const char* a1 = cA + (size_t)(t + 1) * kstep;
            const char* a2 = last ? nA : cA + (size_t)(t + 2) * kstep; const char* b2 = last ? nB : cB + (size_t)(t + 2) * kstep;
            const char* a3 = a2 + kstep; const char* b3 = b2 + kstep;
            if (last && has_next) S.a_ready(nxt);
            if constexpr (SP2) {
            PG8_LDB(B0, 0, 0); PG8_LDB(B1, 0, 1); PG8_SCHED; PG8_LDA(At, 0, 0); PG8_STAGE(PG8_SA(1, 1), a1 + hstepA, voffA);
            PG8_WAIT_V(8); PG8_WAIT_L(0); PG8_BAR; PG8_MMA(0, 0, At, B0); PG8_MMA(0, 1, At, B1); PG8_BAR; PG8_SCHED;
            PG8_LDA(At, 0, 1); PG8_STAGE(PG8_SB(0, 0), b2, voffB); PG8_STAGE(PG8_SB(0, 1), b2 + hstepB, voffB); PG8_STAGE(PG8_SA(0, 0), a2, voffA);
            PG8_WAIT_V(8); PG8_WAIT_L(0); PG8_BAR; PG8_MMA(1, 0, At, B0); PG8_MMA(1, 1, At, B1); PG8_BAR; PG8_SCHED;
            PG8_LDB(B0, 1, 0); PG8_LDB(B1, 1, 1); PG8_SCHED; PG8_LDA(At, 1, 0); PG8_STAGE(PG8_SA(0, 1), a2 + hstepA, voffA);
            PG8_WAIT_V(8); PG8_WAIT_L(0); PG8_BAR; PG8_MMA(0, 0, At, B0); PG8_MMA(0, 1, At, B1); PG8_BAR; PG8_SCHED;
            PG8_LDA(At, 1, 1); PG8_STAGE(PG8_SB(1, 0), b3, voffB); PG8_STAGE(PG8_SB(1, 1), b3 + hstepB, voffB); PG8_STAGE(PG8_SA(1, 0), a3, voffA);
            PG8_WAIT_V(8); PG8_WAIT_L(0); PG8_BAR; PG8_MMA(1, 0, At, B0); PG8_MMA(1, 1, At, B1); PG8_BAR; PG8_SCHED;
            } else {
            PG8_LDB(B0, 0, 0); PG8_SCHED; PG8_LDA(At, 0, 0); PG8_STAGE(PG8_SA(1, 1), a1 + hstepA, voffA);
            PG8_WAIT_L(8); PG8_BAR; PG8_WAIT_L(0); PG8_MMA(0, 0, At, B0); PG8_BAR; PG8_SCHED;
            PG8_LDB(B1, 0, 1); PG8_STAGE(PG8_SB(0, 0), b2, voffB);
            PG8_BAR; PG8_WAIT_L(0); PG8_MMA(0, 1, At, B1); PG8_BAR;
            PG8_LDA(At, 0, 1); PG8_STAGE(PG8_SA(0, 0), a2, voffA);
            PG8_BAR; PG8_WAIT_L(0); PG8_MMA(1, 0, At, B0); PG8_BAR; PG8_SCHED;
            PG8_STAGE(PG8_SB(0, 1), b2 + hstepB, voffB);
            PG8_WAIT_V(6); PG8_BAR; PG8_MMA(1, 1, At, B1); PG8_BAR;
            PG8_LDB(B0, 1, 0); PG8_SCHED; PG8_LDA(At, 1, 0); PG8_STAGE(PG8_SA(0, 1), a2 + hstepA, voffA);
            PG8_WAIT_L(8); PG8_BAR; PG8_WAIT_L(0); PG8_MMA(0, 0, At, B0); PG8_BAR; PG8_SCHED;
            PG8_LDB(B1, 1, 1); PG8_STAGE(PG8_SB(1, 0), b3, voffB);
            PG8_BAR; PG8_WAIT_L(0); PG8_MMA(0, 1, At, B1); PG8_BAR;
            PG8_LDA(At, 1, 1); PG8_STAGE(PG8_SA(1, 0), a3, voffA);
            PG8_BAR; PG8_WAIT_L(0); PG8_MMA(1, 0, At, B0); PG8_BAR; PG8_SCHED;
            PG8_STAGE(PG8_SB(1, 1), b3 + hstepB, voffB);
            PG8_WAIT_V(6); PG8_BAR; PG8_MMA(1, 1, At, B1); PG8_BAR;
            }
        }
        if constexpr (ALIGN_EPI) { if (wr == 0) PG8_BAR; }
        if constexpr (!Epi::AFTER_DRAIN) { E(acc, cur, wr, wc, fr, fq); S.done(cur); }
        if (!has_next) break;
#pragma unroll
        for (int a = 0; a < 2; ++a)
#pragma unroll
            for (int b = 0; b < 2; ++b)
#pragma unroll
                for (int m = 0; m < 4; ++m)
#pragma unroll
                    for (int n = 0; n < 2; ++n) acc[a][b][m][n] = (f32x4){0.f, 0.f, 0.f, 0.f};
        cur = nxt; cA = nA; cB = nB; ++ui;
        if constexpr (ALIGN_EPI) { if (wr == 1) PG8_BAR; }
    }
    PG8_WAIT_V(0);
    if constexpr (!ALIGN_EPI) { if (wr == 0) PG8_BAR; }
    PG8_BAR;
    if constexpr (Epi::AFTER_DRAIN) { E.fused(acc, cur, wr, wc, fr, fq, lds, wid, lane); S.done(cur); }
#undef PG8_ABASE
#undef PG8_BBASE
#undef PG8_SA
#undef PG8_SB
#undef PG8_STAGE
#undef PG8_LDA
#undef PG8_LDB
#undef PG8_MMA
#undef PG8_WAIT_V
#undef PG8_WAIT_L
#undef PG8_BAR
#undef PG8_SCHED
}
}

#ifndef MK_ONE_LAUNCH
#define MK_ONE_LAUNCH 1
#endif
#ifndef MK_REPEAT_PH
#define MK_REPEAT_PH -1
#endif
namespace mk {
using namespace pg8;
#define LAS __attribute__((address_space(3)))
constexpr int D = 1024, NB = 16, SEQ = 2048, CTXL = 256, DFF = 2816, PIN = 2320, NPH = 22;
constexpr float ALPHA = 1.41421356237309515f, LN_EPS = 1e-5f;
constexpr size_t MiB = 1u << 20;
constexpr size_t WS_CTL = 0, WS_MOD = 1 * MiB, WS_WT = 2 * MiB, WT_LAYER = 30 * MiB;
constexpr size_t WT_IN = 0, WT_OUT = 5 * MiB, WT_FFIN = 7 * MiB, WT_FFOUT = 18 * MiB, WT_GLU = 47 * MiB / 2, WT_BTY = 95 * MiB / 4, WT_BTS = 111 * MiB / 4, WT_SGUW = 119 * MiB / 4;
constexpr size_t WS_GATES = 62 * MiB, WS_XC = 65 * MiB, WS_HY = 81 * MiB, WS_Z = 153 * MiB, WS_ACT = 153 * MiB, WS_UH = 297 * MiB, WS_MST = 333 * MiB, WS_YS5 = 369 * MiB,
                 WS_S5S = 387 * MiB, WS_MISC = 423 * MiB, WS_HSUM = 427 * MiB, WS_Y32 = 463 * MiB, WS_END = 499 * MiB;
constexpr int LDS_BYTES = 147456;

struct Args { const float* in[34]; float* out; unsigned char* ws; int ph_lo, ph_hi; };
enum { I_X = 0, I_C, I_CTX, I_CCTX, I_WMOD, I_BMOD, I_WIN, I_GBIAS, I_MNORM, I_SLNW, I_SLNB, I_SW, I_SB, I_CW, I_CB, I_CLNW, I_CLNB, I_ARE, I_AIM, I_LDT, I_BRE, I_BIM, I_CRE, I_CIM, I_DSK, I_GLUW, I_GLUB,
       I_WOUT, I_LN1W, I_LN1B, I_WFFIN, I_WFFOUT, I_LN2W, I_LN2B };

struct Ctx { LAS unsigned char* lds; int tid, lane, wave, bid, G; const float* const* in; float* out; unsigned char* ws; };

__device__ __forceinline__ float bf2f(bf16_t h) { return __uint_as_float((unsigned)h << 16); }
__device__ __forceinline__ unsigned f2bf(float f) { unsigned u = __float_as_uint(f); return (u + 0x7fffu + ((u >> 16) & 1u)) >> 16; }
__device__ __forceinline__ unsigned pk2(float lo, float hi) { return f2bf(lo) | (f2bf(hi) << 16); }
__device__ __forceinline__ float wave_sum(float v) {
#pragma unroll
    for (int o = 1; o < 64; o <<= 1) v += __shfl_xor(v, o);
    return v;
}
__device__ __forceinline__ float logsig(float x) { return fminf(x, 0.f) - log1pf(expf(-fabsf(x))); }
__device__ __forceinline__ int chain_row(int b, int dir, int j) {
    if (j < CTXL) { const int t = dir ? CTXL - 1 - j : j; return NLAT + b * CTXL + t; }
    int t = j - CTXL; t = dir ? SEQ - 1 - t : t; return b * SEQ + t;
}
#define LDS_WAIT() asm volatile("s_waitcnt lgkmcnt(0)" ::: "memory")

__device__ __forceinline__ void s5_table_item(const Ctx& C, int l, int g, int part);
__device__ __forceinline__ void transpose_item(const float* W, int ldw, int col0, bf16_t* WT, int K, int drow0, int k0, LAS float* scr, int lane) {
#pragma unroll 8
    for (int i = 0; i < 32; ++i) { const int kk = 2 * i + (lane >> 5); scr[kk * 33 + (lane & 31)] = W[(size_t)(k0 + kk) * ldw + col0 + (lane & 31)]; }
    LDS_WAIT(); asm volatile("" ::: "memory");
    const int c = lane & 7;
#pragma unroll
    for (int j = 0; j < 4; ++j) { const int n = (lane >> 3) + 8 * j; const LAS float* s = scr + (8 * c) * 33 + n;
        u32x4 o; o.x = pk2(s[0 * 33], s[1 * 33]); o.y = pk2(s[2 * 33], s[3 * 33]); o.z = pk2(s[4 * 33], s[5 * 33]); o.w = pk2(s[6 * 33], s[7 * 33]);
        *(u32x4*)(WT + (size_t)(drow0 + n) * K + k0 + 8 * c) = o; }
    LDS_WAIT(); asm volatile("" ::: "memory");
}
__device__ __forceinline__ void p_prologue(const Ctx& C) {
    LAS float* scr = (LAS float*)(C.lds + C.wave * 8448);
    const int gw = C.bid * 8 + C.wave, NGW = C.G * 8;
    constexpr int N_IN = 16 * 73, N_OUT = 16 * 32, N_FI = 16 * 176, N_FO = 44 * 32, N_GL = 4 * 8, N_L = N_IN + N_OUT + N_FI + N_FO + N_GL;
    for (int it = gw; it < 2 * N_L; it += NGW) {
        const int l = it / N_L; int r = it % N_L; unsigned char* wt = C.ws + WS_WT + (size_t)l * WT_LAYER;
        if (r < N_IN) { const int kb = r / 73, nb = r % 73; transpose_item(C.in[I_WIN] + (size_t)l * D * PIN, PIN, nb == 72 ? 1024 : nb * 32 + (nb >= 32 ? 16 : 0), (bf16_t*)(wt + WT_IN), D, nb * 32, kb * 64, scr, C.lane); continue; } r -= N_IN;
        if (r < N_OUT) { const int kb = r / 32, nb = r % 32; transpose_item(C.in[I_WOUT] + (size_t)l * D * D, D, nb * 32, (bf16_t*)(wt + WT_OUT), D, nb * 32, kb * 64, scr, C.lane); continue; } r -= N_OUT;
        if (r < N_FI) { const int kb = r / 176, nb = r % 176, dr = nb * 32, pn = dr >> 8, bj = (dr >> 7) & 1, jj = dr & 127;
            transpose_item(C.in[I_WFFIN] + (size_t)l * D * 2 * DFF, 2 * DFF, bj * DFF + pn * 128 + jj, (bf16_t*)(wt + WT_FFIN), D, dr, kb * 64, scr, C.lane); continue; } r -= N_FI;
        if (r < N_FO) { const int kb = r / 32, nb = r % 32; transpose_item(C.in[I_WFFOUT] + (size_t)l * DFF * D, D, nb * 32, (bf16_t*)(wt + WT_FFOUT), DFF, nb * 32, kb * 64, scr, C.lane); continue; } r -= N_FO;
        { const int kb = r / 8, nb = r % 8; transpose_item(C.in[I_GLUW] + (size_t)l * 65536, 256, nb * 32, (bf16_t*)(wt + WT_GLU), 256, nb * 32, kb * 64, scr, C.lane); }
    }
    __syncthreads();
    LAS float* sc = (LAS float*)C.lds; LAS float* red = (LAS float*)(C.lds + 69632);
    if (C.bid < 192) {
        for (int idx = C.tid; idx < 17 * 1024; idx += 512) { const int i = idx >> 10, k = idx & 1023; const float v = i < 16 ? C.in[I_C][i * 1024 + k] : C.in[I_CCTX][k]; sc[idx] = v / (1.0f + expf(-v)); }
        __syncthreads();
        float* MOD = (float*)(C.ws + WS_MOD);
        for (int item = C.bid; item < 192; item += C.G) {
            const int l = item / 96, j = (item % 96) * 64 + C.lane; const float* w = C.in[I_WMOD] + (size_t)l * D * 6144 + j;
            float acc[17];
#pragma unroll
            for (int i = 0; i < 17; ++i) acc[i] = 0.f;
            for (int k = C.wave * 128; k < C.wave * 128 + 128; ++k) { const float wv = w[(size_t)k * 6144];
#pragma unroll
                for (int i = 0; i < 17; ++i) acc[i] += sc[i * 1024 + k] * wv; }
#pragma unroll
            for (int i = 0; i < 17; ++i) red[(C.wave * 17 + i) * 64 + C.lane] = acc[i];
            __syncthreads();
            for (int i = C.wave; i < 17; i += 8) { float s = 0.f;
#pragma unroll
                for (int w8 = 0; w8 < 8; ++w8) s += red[(w8 * 17 + i) * 64 + C.lane];
                MOD[(size_t)(l * 17 + i) * 6144 + j] = s + C.in[I_BMOD][l * 6144 + j]; }
            __syncthreads();
        }
    }
    __syncthreads();
    for (int it = C.bid; it < 256; it += C.G) s5_table_item(C, it >> 7, (it >> 3) & 15, it & 7);
    for (int idx = C.bid * 512 + C.tid; idx < 2 * 16384; idx += C.G * 512) { const int l = idx >> 14, o = (idx & 16383) * 4; const f32x4 v = *(const f32x4*)(C.in[I_SW] + (size_t)l * 65536 + o);
        *(unsigned long long*)((bf16_t*)(C.ws + WS_WT + (size_t)l * WT_LAYER + WT_SGUW) + o) = (unsigned long long)pk2(v[0], v[1]) | ((unsigned long long)pk2(v[2], v[3]) << 32); }
}

__device__ __forceinline__ void p_rowpass(const Ctx& C, int mode, int l) {
    const bool doLN = mode != 0, doH = !(mode == 2 && l == 1);
    const int nrows = (mode == 0 || l == 0) ? NROWS : NLAT;
    const int lm = (mode == 2) ? l + 1 : l;
    const float* MOD = (const float*)(C.ws + WS_MOD) + (size_t)(lm < 2 ? lm : 1) * 17 * 6144; const int osh = (mode == 1) ? 3072 : 0, osc = (mode == 1) ? 4096 : 1024;
    const float* lnw = C.in[mode == 1 ? I_LN1W : I_LN2W] + l * D; const float* lnb = C.in[mode == 1 ? I_LN1B : I_LN2B] + l * D;
    bf16_t* H = (bf16_t*)(C.ws + WS_HY); float* XC = (float*)(C.ws + WS_XC);
    for (int row = C.bid * 8 + C.wave; row < nrows; row += C.G * 8) {
        const bool lat = row < NLAT; const int mi = lat ? (row >> 11) : 16;
        float* xrow = lat ? C.out + (size_t)row * D : XC + (size_t)(row - NLAT) * D;
        const float* src = (mode == 0) ? (lat ? C.in[I_X] + (size_t)row * D : C.in[I_CTX] + (size_t)(row - NLAT) * D) : xrow;
        f32x4 v[4];
#pragma unroll
        for (int j = 0; j < 4; ++j) v[j] = *(const f32x4*)(src + 4 * C.lane + 256 * j);
        if (doLN) {
            float s = 0.f;
#pragma unroll
            for (int j = 0; j < 4; ++j) s += (v[j][0] + v[j][1]) + (v[j][2] + v[j][3]);
            const float mean = wave_sum(s) * (1.0f / D); float q = 0.f;
#pragma unroll
            for (int j = 0; j < 4; ++j) { v[j] = v[j] - mean; q += (v[j][0] * v[j][0] + v[j][1] * v[j][1]) + (v[j][2] * v[j][2] + v[j][3] * v[j][3]); }
            const float rstd = 1.0f / sqrtf(wave_sum(q) * (1.0f / D) + LN_EPS);
#pragma unroll
            for (int j = 0; j < 4; ++j) { const f32x4 w = *(const f32x4*)(lnw + 4 * C.lane + 256 * j), b = *(const f32x4*)(lnb + 4 * C.lane + 256 * j); v[j] = v[j] * rstd * w + b; *(f32x4*)(xrow + 4 * C.lane + 256 * j) = v[j]; }
        }
        if (doH) {
            const float* mp = MOD + (size_t)mi * 6144;
#pragma unroll
            for (int j = 0; j < 4; ++j) { const f32x4 sh = *(const f32x4*)(mp + osh + 4 * C.lane + 256 * j), scv = *(const f32x4*)(mp + osc + 4 * C.lane + 256 * j); v[j] = v[j] * (scv + 1.0f) + sh;
                unsigned long long o = (unsigned long long)pk2(v[j][0], v[j][1]) | ((unsigned long long)pk2(v[j][2], v[j][3]) << 32); *(unsigned long long*)(H + (size_t)row * D + 4 * C.lane + 256 * j) = o; }
        }
    }
}
#define XB_TMO      128
#define XB_XCNT(j)  (256  + 64 * (j))
#define XB_XSUB(j)  (1280 + 64 * (j))
#define XB_XGEN(j)  (2304 + 64 * (j))
#define XB_TOP      3328
#define XB_TOPGEN   3392
#define XCD_BAR_WORDS 3456
#define XB_SPIN_CAP (1u << 20)
__device__ __forceinline__ unsigned xb_ld(unsigned* p)              { return __hip_atomic_load(p, __ATOMIC_RELAXED, __HIP_MEMORY_SCOPE_AGENT); }
__device__ __forceinline__ unsigned xb_add(unsigned* p, unsigned v) { return __hip_atomic_fetch_add(p, v, __ATOMIC_RELAXED, __HIP_MEMORY_SCOPE_AGENT); }
__device__ __forceinline__ unsigned xb_xcc_id() { return (unsigned)__builtin_amdgcn_s_getreg((3 << 11) | 20) & 0xFu; }
#define XB_SPIN(cond, bar) do { unsigned _sp = 0; while (cond) { __builtin_amdgcn_s_sleep(1); \
    if ((++_sp & 255u) == 0u) { if (xb_ld(&(bar)[XB_TMO])) break; if (_sp > XB_SPIN_CAP) { atomicAdd(&(bar)[XB_TMO], 1u); break; } } } } while (0)
struct XcdBarrier { unsigned* bar; unsigned x; volatile LAS unsigned* st; };
__device__ __forceinline__ XcdBarrier xcd_barrier_post(unsigned* bar, volatile LAS unsigned* st) {
    XcdBarrier b; b.bar = bar; b.x = xb_xcc_id(); b.st = st;
    if (threadIdx.x == 0) (void)xb_add(&bar[XB_XCNT(b.x)], 1u);
    return b;
}
__device__ __forceinline__ void xcd_barrier_complete(unsigned* bar, unsigned x, unsigned& nloc, unsigned& nx) {
    const unsigned G = gridDim.x * gridDim.y * gridDim.z;
    unsigned sum, cnt, mine, sp = 0u;
    for (;;) {
        sum = 0u; cnt = 0u; mine = 0u;
#pragma unroll
        for (unsigned j = 0; j < 16; ++j) { const unsigned c = xb_ld(&bar[XB_XCNT(j)]); sum += c; cnt += (c > 0u) ? 1u : 0u; mine = (j == x) ? c : mine; }
        if (sum == G) break;
        __builtin_amdgcn_s_sleep(1);
        if ((++sp & 255u) == 0u) { if (xb_ld(&bar[XB_TMO])) break; if (sp > XB_SPIN_CAP) { atomicAdd(&bar[XB_TMO], 1u); break; } }
    }
    nloc = mine > 0u ? mine : 1u; nx = cnt > 0u ? cnt : 1u;
}
__device__ __forceinline__ void xcd_barrier(const XcdBarrier& b) {
    asm volatile("s_waitcnt vmcnt(0)" ::: "memory");
    __syncthreads();
    if (threadIdx.x == 0) {
        unsigned* bar = b.bar;
        __builtin_amdgcn_s_waitcnt(0);
        unsigned nloc = b.st[0], nx = b.st[1];
        if (nloc == 0u) { xcd_barrier_complete(bar, b.x, nloc, nx); b.st[0] = nloc; b.st[1] = nx; }
        const unsigned old = xb_add(&bar[XB_XSUB(b.x)], 1u);
        const unsigned gen = old / nloc;
        if (old + 1u == (gen + 1u) * nloc) {
            __builtin_amdgcn_fence(__ATOMIC_RELEASE, "agent");
            asm volatile("s_waitcnt vmcnt(0)" ::: "memory");
            const unsigned og = xb_add(&bar[XB_TOP], 1u);
            const unsigned tg = og / nx;
            if (og + 1u == (tg + 1u) * nx) xb_add(&bar[XB_TOPGEN], 1u);
            else XB_SPIN(xb_ld(&bar[XB_TOPGEN]) == tg, bar);
            __builtin_amdgcn_fence(__ATOMIC_ACQUIRE, "agent");
            xb_add(&bar[XB_XGEN(b.x)], 1u);
            asm volatile("s_waitcnt vmcnt(0)" ::: "memory");
        } else {
            XB_SPIN(xb_ld(&bar[XB_XGEN(b.x)]) == gen, bar);
            __builtin_amdgcn_fence(__ATOMIC_ACQUIRE, "agent");
            asm volatile("s_waitcnt vmcnt(0)" ::: "memory");
        }
    }
    __syncthreads();
}
__device__ __forceinline__ void nv_mlstm_chain(const Ctx& C, int b, int hd, int dir) {
    const bf16_t* Z = (const bf16_t*)(C.ws + WS_Z); const float* GT = (const float*)(C.ws + WS_GATES); float* HS = (float*)(C.ws + WS_HSUM);
    LAS float* qkv = (LAS float*)C.lds; LAS float* red = qkv + 192;
    const int tid = C.tid, vrow = tid >> 3, k0 = (tid & 7) * 8;
    float Cst[8]; for (int e = 0; e < 8; ++e) Cst[e] = 0.f;
    float nk = 0.f, m = 0.f, r0 = 0.f, ig_n, fg_n; int row_n;
#define NV_LOAD(j) do { const int row_ = chain_row(b, dir, (j)); row_n = row_; const bf16_t* zr = Z + (size_t)row_ * ZLD + hd * 64; \
        if (tid < 64) r0 = bf2f(zr[tid]); else if (tid < 128) r0 = bf2f(zr[256 + tid - 64]) * 0.125f; else if (tid < 192) r0 = bf2f(zr[512 + tid - 128]); \
        ig_n = GT[(size_t)row_ * 16 + dir * 8 + hd]; fg_n = GT[(size_t)row_ * 16 + dir * 8 + 4 + hd]; } while (0)
    NV_LOAD(0);
    for (int j = 0; j < CTXL + SEQ; ++j) {
        if (tid < 192) qkv[tid] = r0;
        const float ig = ig_n, lf = logsig(fg_n); const int row = row_n;
        __syncthreads();
        if (j + 1 < CTXL + SEQ) NV_LOAD(j + 1);
        const float mn = fmaxf(lf + m, ig), fdec = expf(lf + m - mn), iw = expf(ig - mn);
        if (tid < 64) { nk = fdec * nk + iw * qkv[64 + tid]; const float d = wave_sum(nk * qkv[tid]); if (tid == 0) red[0] = d; }
        const float vv = qkv[128 + vrow] * iw; float part = 0.f;
#pragma unroll
        for (int e = 0; e < 8; ++e) { Cst[e] = fdec * Cst[e] + vv * qkv[64 + k0 + e]; part += Cst[e] * qkv[k0 + e]; }
        part += __shfl_xor(part, 1); part += __shfl_xor(part, 2); part += __shfl_xor(part, 4);
        __syncthreads();
        const float den = red[0], h = part / fmaxf(fabsf(den), expf(-mn));
        if ((tid & 7) == 0) { float* hp = HS + (size_t)row * 256 + hd * 64 + vrow; if (dir) *hp += h; else *hp = h; }
        m = mn;
    }
#undef NV_LOAD
    __syncthreads();
}
__device__ __forceinline__ void nv_s5_item(const Ctx& C, int l, int b, int gh, int dir) {
    const bf16_t* UH = (const bf16_t*)(C.ws + WS_UH); float* Y32 = (float*)(C.ws + WS_Y32);
    const int g = gh * 8 + C.wave, n = C.lane;
    LAS float* base = (LAS float*)(C.lds + C.wave * 17920);
    LAS float* xr = base; LAS float* xi = base + 16 * 65; LAS float* cre = base + 2 * 16 * 65; LAS float* cim = cre + 1024; LAS float* us = cim + 1024;
    const float are = C.in[I_ARE][((l * 2 + dir) * 16 + g) * 64 + n], aim = C.in[I_AIM][((l * 2 + dir) * 16 + g) * 64 + n], dt = expf(C.in[I_LDT][(l * 2 + dir) * 16 + g]);
    const float mag = expf(are * dt), abr = mag * cosf(aim * dt), abi = mag * sinf(aim * dt), d2 = are * are + aim * aim;
    const float cr = ((abr - 1.f) * are + abi * aim) / d2, ci = (abi * are - (abr - 1.f) * aim) / d2;
    float br[16], bi[16];
#pragma unroll
    for (int q = 0; q < 16; ++q) { const float re = C.in[I_BRE][((size_t)(l * 16 + g) * 64 + n) * 16 + q], im = C.in[I_BIM][((size_t)(l * 16 + g) * 64 + n) * 16 + q]; br[q] = cr * re - ci * im; bi[q] = cr * im + ci * re; }
    for (int p = 0; p < 16; ++p) { cre[n * 16 + p] = C.in[I_CRE][((size_t)(l * 16 + g) * 16 + p) * 64 + n]; cim[n * 16 + p] = C.in[I_CIM][((size_t)(l * 16 + g) * 16 + p) * 64 + n]; }
    float sr = 0.f, si = 0.f;
    const int t_ = n >> 2, p0 = (n & 3) * 4;
    const f32x4 dv = *(const f32x4*)(C.in[I_DSK] + l * 256 + g * 16 + p0);
    for (int j0 = 0; j0 < CTXL + SEQ; j0 += 16) {
        { const int s = n >> 2, q0 = (n & 3) * 4, row = chain_row(b, dir, j0 + s); const bf16_t* up = UH + ((size_t)(g * NCH_S5 + (row >> 4)) * 512 + (row & 15) * 16 + q0);
#pragma unroll
          for (int e = 0; e < 4; ++e) us[s * 16 + q0 + e] = bf2f(up[e]); }
        __syncthreads();
        for (int s = 0; s < 16; ++s) { float bur = 0.f, bui = 0.f;
#pragma unroll
            for (int q = 0; q < 16; ++q) { const float uv = us[s * 16 + q]; bur += br[q] * uv; bui += bi[q] * uv; }
            const float nr = abr * sr - abi * si + bur, ni = abr * si + abi * sr + bui; sr = nr; si = ni; xr[s * 65 + n] = sr; xi[s * 65 + n] = si; }
        __syncthreads();
        f32x4 acc = {0.f, 0.f, 0.f, 0.f};
        for (int nn = 0; nn < 64; ++nn) { const float a = xr[t_ * 65 + nn], bq = xi[t_ * 65 + nn]; const f32x4 c1 = *(const LAS f32x4*)(cre + nn * 16 + p0), c2 = *(const LAS f32x4*)(cim + nn * 16 + p0); acc += c1 * a - c2 * bq; }
        const int row = chain_row(b, dir, j0 + t_); float* yp = Y32 + (size_t)row * 256 + g * 16 + p0;
        if (dir == 0) { f32x4 uu; uu[0] = us[t_ * 16 + p0]; uu[1] = us[t_ * 16 + p0 + 1]; uu[2] = us[t_ * 16 + p0 + 2]; uu[3] = us[t_ * 16 + p0 + 3]; *(f32x4*)yp = acc + dv * uu; }
        else { const f32x4 o = *(const f32x4*)yp; *(f32x4*)yp = o + acc; }
        __syncthreads();
    }
}
__device__ __forceinline__ void nv_glu_item(const Ctx& C, int l, int item) {
    const float* Y32 = (const float*)(C.ws + WS_Y32); bf16_t* Y = (bf16_t*)(C.ws + WS_HY); LAS float* ys = (LAS float*)C.lds;
    const int r0 = item * 32;
    for (int idx = C.tid; idx < 32 * 256; idx += 512) ys[idx] = gelu_t(Y32[(size_t)r0 * 256 + idx]);
    __syncthreads();
    const int c = C.tid & 255, th = C.tid >> 8; const float* w = C.in[I_GLUW] + (size_t)l * 65536 + c;
    float acc[16];
#pragma unroll
    for (int t = 0; t < 16; ++t) acc[t] = 0.f;
    for (int k = 0; k < 256; ++k) { const float wv = w[k * 256];
#pragma unroll
        for (int t = 0; t < 16; ++t) acc[t] += ys[(th * 16 + t) * 256 + k] * wv; }
    const float gb = C.in[I_GLUB][l * 256 + c];
#pragma unroll
    for (int t = 0; t < 16; ++t) { const int rr = th * 16 + t; Y[(size_t)(r0 + rr) * D + 768 + c] = (bf16_t)f2bf(ys[rr * 256 + c] * sigm(acc[t] + gb)); }
    __syncthreads();
}
__device__ __forceinline__ void nv_readout_row(const Ctx& C, int l, int row) {
    const float* HS = (const float*)(C.ws + WS_HSUM); const bf16_t* Z = (const bf16_t*)(C.ws + WS_Z); bf16_t* Y = (bf16_t*)(C.ws + WS_HY);
    const int ch = 4 * C.lane; f32x4 h = *(const f32x4*)(HS + (size_t)row * 256 + ch);
    float s = (h[0] + h[1]) + (h[2] + h[3]); s += __shfl_xor(s, 1); s += __shfl_xor(s, 2); s += __shfl_xor(s, 4); s += __shfl_xor(s, 8);
    const float mu = s * (1.0f / 64.0f); h = h - mu; float q = (h[0] * h[0] + h[1] * h[1]) + (h[2] * h[2] + h[3] * h[3]); q += __shfl_xor(q, 1); q += __shfl_xor(q, 2); q += __shfl_xor(q, 4); q += __shfl_xor(q, 8);
    const float rstd = 1.0f / sqrtf(q * (1.0f / 64.0f) + LN_EPS); const f32x4 nw = *(const f32x4*)(C.in[I_MNORM] + l * 256 + ch);
    const unsigned long long ow = *(const unsigned long long*)(Z + (size_t)row * ZLD + 768 + ch); const unsigned o0 = (unsigned)ow, o1 = (unsigned)(ow >> 32);
    const float y0 = h[0] * rstd * nw[0] * sigm(bflo(o0)), y1 = h[1] * rstd * nw[1] * sigm(bfhi(o0)), y2 = h[2] * rstd * nw[2] * sigm(bflo(o1)), y3 = h[3] * rstd * nw[3] * sigm(bfhi(o1));
    *(unsigned long long*)(Y + (size_t)row * D + ch) = (unsigned long long)pk2(y0, y1) | ((unsigned long long)pk2(y2, y3) << 32);
}
typedef short s16x4 __attribute__((ext_vector_type(4)));
__device__ __forceinline__ s16x4 lds_tr16(const LAS bf16_t* p) { return __builtin_bit_cast(s16x4, __builtin_amdgcn_ds_read_tr16_b64_v4i16((LAS s16x4*)p)); }
__device__ __forceinline__ bf16x8 lds_frag_tr(const LAS bf16_t* X, int ld, int k0, int n0, int lane) {
    const int i = lane & 15, g = lane >> 4; const LAS bf16_t* p = X + (k0 + 8 * g + (i >> 2)) * ld + n0 + 4 * (i & 3);
    const s16x4 lo = lds_tr16(p), hi = lds_tr16(p + 4 * ld); bf16x8 r; r[0] = lo[0]; r[1] = lo[1]; r[2] = lo[2]; r[3] = lo[3]; r[4] = hi[0]; r[5] = hi[1]; r[6] = hi[2]; r[7] = hi[3]; return r;
}
constexpr int VP = 264;
__device__ __forceinline__ void sgu_item(const Ctx& C, int l, int ci) {
    const bf16_t* Z = (const bf16_t*)(C.ws + WS_Z); bf16_t* Y = (bf16_t*)(C.ws + WS_HY); LAS bf16_t* Vr = (LAS bf16_t*)C.lds;
    const int r0 = ci < 256 ? ci * 128 : NLAT + (ci - 256) * 128, lane = C.lane;
    { const int ch = 4 * lane; const f32x4 lw = *(const f32x4*)(C.in[I_SLNW] + l * 256 + ch), lb = *(const f32x4*)(C.in[I_SLNB] + l * 256 + ch);
      for (int s = C.wave; s < 128; s += 8) {
        const unsigned long long zw = *(const unsigned long long*)(Z + (size_t)(r0 + s) * ZLD + 1280 + ch); const unsigned z0 = (unsigned)zw, z1 = (unsigned)(zw >> 32);
        f32x4 v = {gelu_t(bflo(z0)), gelu_t(bfhi(z0)), gelu_t(bflo(z1)), gelu_t(bfhi(z1))};
        const float mu = wave_sum((v[0] + v[1]) + (v[2] + v[3])) * (1.0f / 256.0f); v = v - mu;
        const float rstd = 1.0f / sqrtf(wave_sum((v[0] * v[0] + v[1] * v[1]) + (v[2] * v[2] + v[3] * v[3])) * (1.0f / 256.0f) + LN_EPS);
        v = v * rstd * lw + lb;
        *(LAS unsigned long long*)(Vr + s * VP + ch) = (unsigned long long)cvt_pk_bf16(v[0], v[1]) | ((unsigned long long)cvt_pk_bf16(v[2], v[3]) << 32); } }
    __syncthreads();
    const int g = __builtin_amdgcn_readfirstlane(C.wave & 3), th = __builtin_amdgcn_readfirstlane(C.wave >> 2);
    const bf16_t* W = (const bf16_t*)(C.ws + WS_WT + (size_t)l * WT_LAYER + WT_SGUW) + (size_t)g * 16384; const float* bs = C.in[I_SB] + (l * 4 + g) * 128;
    bf16x8 afr[4][4];
#pragma unroll
    for (int ct = 0; ct < 4; ++ct)
#pragma unroll
        for (int ks = 0; ks < 4; ++ks) afr[ct][ks] = lds_frag_tr(Vr, VP, ks * 32, g * 64 + ct * 16, lane);
#pragma unroll 1
    for (int tt = 0; tt < 4; ++tt) { const int t = th * 64 + tt * 16 + (lane & 15), row = r0 + t; bf16x8 bfr[4];
#pragma unroll
        for (int ks = 0; ks < 4; ++ks) bfr[ks] = *(const bf16x8*)(W + t * 128 + ks * 32 + 8 * (lane >> 4));
        const float bst = bs[t];
#pragma unroll
        for (int ct = 0; ct < 4; ++ct) { f32x4 acc = {0.f, 0.f, 0.f, 0.f};
#pragma unroll
            for (int ks = 0; ks < 4; ++ks) acc = __builtin_amdgcn_mfma_f32_16x16x32_bf16(afr[ct][ks], bfr[ks], acc, 0, 0, 0);
            const int c = g * 64 + ct * 16 + 4 * (lane >> 4);
            const unsigned long long uw = *(const unsigned long long*)(Z + (size_t)row * ZLD + 1024 + c); const unsigned u0 = (unsigned)uw, u1 = (unsigned)(uw >> 32);
            const float y0 = gelu_t(bflo(u0)) * (acc[0] + bst), y1 = gelu_t(bfhi(u0)) * (acc[1] + bst), y2 = gelu_t(bflo(u1)) * (acc[2] + bst), y3 = gelu_t(bfhi(u1)) * (acc[3] + bst);
            *(unsigned long long*)(Y + (size_t)row * D + 256 + c) = (unsigned long long)cvt_pk_bf16(y0, y1) | ((unsigned long long)cvt_pk_bf16(y2, y3) << 32); } }
    __syncthreads();
}
__device__ __forceinline__ void conv_item(const Ctx& C, int l, int ti) {
    const bf16_t* Z = (const bf16_t*)(C.ws + WS_Z); bf16_t* Y = (bf16_t*)(C.ws + WS_HY); LAS float* A = (LAS float*)C.lds;
    int r0, seg_lo, seg_len; if (ti < 512) { r0 = ti * 64; seg_lo = 0; seg_len = 64; } else { const int b = (ti - 512) >> 2, tq = (ti - 512) & 3; r0 = NLAT + b * 256 + tq * 64; seg_lo = tq * 64; seg_len = 256; }
    { const int ch = 4 * (C.tid & 63);
      for (int a = C.tid >> 6; a < 94; a += 8) { const int ts = seg_lo + a - 15; f32x4 v = {0.f, 0.f, 0.f, 0.f};
        if (ts >= 0 && ts < seg_len) { const bf16_t* zr = Z + (size_t)(r0 + a - 15) * ZLD + 1536 + ch; const unsigned long long vw = *(const unsigned long long*)zr, gw = *(const unsigned long long*)(zr + 256);
            const unsigned v0 = (unsigned)vw, v1 = (unsigned)(vw >> 32), g0 = (unsigned)gw, g1 = (unsigned)(gw >> 32);
            v[0] = bflo(v0) * sigm(bflo(g0)); v[1] = bfhi(v0) * sigm(bfhi(g0)); v[2] = bflo(v1) * sigm(bflo(g1)); v[3] = bfhi(v1) * sigm(bfhi(g1)); }
        *(LAS f32x4*)(A + a * 256 + ch) = v; } }
    __syncthreads();
    const int ch = C.tid & 255, th = C.tid >> 8; float o[32];
    { const float* cw = C.in[I_CW] + (size_t)l * 31 * 256 + ch; const float cb = C.in[I_CB][l * 256 + ch];
#pragma unroll
      for (int t = 0; t < 32; ++t) o[t] = cb;
      for (int j = 0; j < 31; ++j) { const float w = cw[j * 256];
#pragma unroll
        for (int t = 0; t < 32; ++t) o[t] += w * A[(th * 32 + t + j) * 256 + ch]; } }
    __syncthreads();
#pragma unroll
    for (int t = 0; t < 32; ++t) A[(th * 32 + t) * 256 + ch] = o[t];
    __syncthreads();
    { const int c4 = 4 * C.lane; const f32x4 lw = *(const f32x4*)(C.in[I_CLNW] + l * 256 + c4), lb = *(const f32x4*)(C.in[I_CLNB] + l * 256 + c4);
      for (int t = C.wave; t < 64; t += 8) { f32x4 v = *(const LAS f32x4*)(A + t * 256 + c4);
        const float mu = wave_sum((v[0] + v[1]) + (v[2] + v[3])) * (1.0f / 256.0f); v = v - mu;
        const float rstd = 1.0f / sqrtf(wave_sum((v[0] * v[0] + v[1] * v[1]) + (v[2] * v[2] + v[3] * v[3])) * (1.0f / 256.0f) + LN_EPS);
        v = v * rstd * lw + lb; const float y0 = v[0] * sigm(v[0]), y1 = v[1] * sigm(v[1]), y2 = v[2] * sigm(v[2]), y3 = v[3] * sigm(v[3]);
        *(unsigned long long*)(Y + (size_t)(r0 + t) * D + 512 + c4) = (unsigned long long)pk2(y0, y1) | ((unsigned long long)pk2(y2, y3) << 32); } }
    __syncthreads();
}
constexpr size_t MSN_OFF = 0, MSS_OFF = 2 * MiB, MSM_OFF = 3 * MiB;
__device__ __forceinline__ int ml_row0(int b, int c) { return c < 32 ? b * SEQ + 64 * c : NLAT + b * CTXL + 64 * (c - 32); }
__device__ __forceinline__ int ml_jf(int c) { return c < 32 ? 4 + c : c - 32; }
__device__ __forceinline__ int ml_jb(int c) { return c < 32 ? 35 - c : 35 - c; }
template <int K> __device__ __forceinline__ void lds_mma(f32x4& acc, const LAS bf16_t* A, int lda, const LAS bf16_t* B, int ldb, int lane) {
    const LAS bf16_t* ap = A + (lane & 15) * lda + 8 * (lane >> 4); const LAS bf16_t* bp = B + (lane & 15) * ldb + 8 * (lane >> 4);
#pragma unroll
    for (int k = 0; k < K; k += 32) { const bf16x8 a = *(const LAS bf16x8*)(ap + k), b = *(const LAS bf16x8*)(bp + k); acc = __builtin_amdgcn_mfma_f32_16x16x32_bf16(a, b, acc, 0, 0, 0); }
}
__device__ __forceinline__ float scan_add(float v, int lane) {
#pragma unroll
    for (int o = 1; o < 64; o <<= 1) { const float t = __shfl_up(v, o); if (lane >= o) v += t; }
    return v;
}
__device__ __forceinline__ float scan_max(float v, int lane) {
#pragma unroll
    for (int o = 1; o < 64; o <<= 1) { const float t = __shfl_up(v, o); if (lane >= o) v = fmaxf(v, t); }
    return v;
}
__device__ __forceinline__ float wave_max(float v) {
#pragma unroll
    for (int o = 1; o < 64; o <<= 1) v = fmaxf(v, __shfl_xor(v, o));
    return v;
}
constexpr int TS = 72;

__device__ __forceinline__ void ml_state_item(const Ctx& C, int b, int hd, int c) {
    const bf16_t* Z = (const bf16_t*)(C.ws + WS_Z); const float* GT = (const float*)(C.ws + WS_GATES);
    bf16_t* MST = (bf16_t*)(C.ws + WS_MST); float* MSN = (float*)(C.ws + WS_MISC + MSN_OFF); float* MSS = (float*)(C.ws + WS_MISC + MSS_OFF);
    LAS bf16_t* KT = (LAS bf16_t*)C.lds;
    LAS bf16_t* VE = KT + 64 * TS;
    LAS float* ef = (LAS float*)(VE + 144 * TS); LAS float* eb = ef + 64;
    const int r0 = ml_row0(b, c), tid = C.tid, lane = C.lane;
    const int s = tid >> 3, c8 = 8 * (tid & 7);
    const u32x4 kw = *(const u32x4*)(Z + (size_t)(r0 + s) * ZLD + 256 + hd * 64 + c8), vw = *(const u32x4*)(Z + (size_t)(r0 + s) * ZLD + 512 + hd * 64 + c8);
    if (C.wave < 2) { const int dir = C.wave, tok = dir ? 63 - lane : lane;
        const float ig = GT[(size_t)(r0 + tok) * 16 + dir * 8 + hd], lf = logsig(GT[(size_t)(r0 + tok) * 16 + dir * 8 + 4 + hd]);
        const float bb = scan_add(lf, lane), bend = __shfl(bb, 63), lu = bend - bb + ig, ml = wave_max(lu);
        (dir ? eb : ef)[tok] = expf(lu - ml);
        if (lane == 0) { const int chain = (b * 4 + hd) * 2 + dir, j = dir ? ml_jb(c) : ml_jf(c); MSS[(chain * 36 + j) * 2] = ml; MSS[(chain * 36 + j) * 2 + 1] = bend; } }
    for (int idx = tid; idx < 14 * TS; idx += 512) VE[130 * TS + idx] = 0;
    __syncthreads();
    { const float e0 = ef[s], e1 = eb[s]; const unsigned kk[4] = {kw.x, kw.y, kw.z, kw.w}, vv[4] = {vw.x, vw.y, vw.z, vw.w};
#pragma unroll
      for (int e = 0; e < 4; ++e) { const float k0 = bflo(kk[e]) * 0.125f, k1 = bfhi(kk[e]) * 0.125f, v0 = bflo(vv[e]), v1 = bfhi(vv[e]);
        KT[(c8 + 2 * e) * TS + s] = (bf16_t)f2bf(k0); KT[(c8 + 2 * e + 1) * TS + s] = (bf16_t)f2bf(k1);
        VE[(c8 + 2 * e) * TS + s] = (bf16_t)f2bf(v0 * e0); VE[(c8 + 2 * e + 1) * TS + s] = (bf16_t)f2bf(v1 * e0);
        VE[(64 + c8 + 2 * e) * TS + s] = (bf16_t)f2bf(v0 * e1); VE[(64 + c8 + 2 * e + 1) * TS + s] = (bf16_t)f2bf(v1 * e1); }
      if (tid < 64) { VE[128 * TS + tid] = (bf16_t)f2bf(ef[tid]); VE[129 * TS + tid] = (bf16_t)f2bf(eb[tid]); } }
    __syncthreads();
    const int chf = (b * 4 + hd) * 2, jf = ml_jf(c), jb = ml_jb(c);
    for (int t = C.wave; t < 36; t += 8) { const int mt = t & 3, nt = t >> 2; f32x4 acc = {0.f, 0.f, 0.f, 0.f};
        lds_mma<64>(acc, KT + mt * 16 * TS, TS, VE + nt * 16 * TS, TS, lane);
        const int k = mt * 16 + 4 * (lane >> 4), n = nt * 16 + (lane & 15);
        if (n < 128) { const int dir = n >> 6, v = n & 63; bf16_t* dst = MST + ((size_t)((chf + dir) * 36 + (dir ? jb : jf)) * 4096 + v * 64 + k);
            *(unsigned long long*)dst = (unsigned long long)cvt_pk_bf16(acc[0], acc[1]) | ((unsigned long long)cvt_pk_bf16(acc[2], acc[3]) << 32); }
        else if (n < 130) { const int dir = n - 128; *(f32x4*)(MSN + ((size_t)((chf + dir) * 36 + (dir ? jb : jf)) * 64 + k)) = acc; } }
    __syncthreads();
}
__device__ __forceinline__ void ml_carry_item(const Ctx& C, int item) {
    const int chain = item >> 1, half = item & 1, tid = C.tid;
    bf16_t* base = (bf16_t*)(C.ws + WS_MST) + (size_t)chain * 36 * 4096 + half * 2048 + tid * 4;
    float* MSN = (float*)(C.ws + WS_MISC + MSN_OFF) + (size_t)chain * 36 * 64; const float* MSS = (const float*)(C.ws + WS_MISC + MSS_OFF) + chain * 72; float* MSM = (float*)(C.ws + WS_MISC + MSM_OFF) + chain * 36;
    unsigned long long v[36]; float nn[36];
#pragma unroll
    for (int j = 0; j < 36; ++j) v[j] = *(const unsigned long long*)(base + (size_t)j * 4096);
    const bool don = (half == 0 && tid < 64);
    if (don) {
#pragma unroll
        for (int j = 0; j < 36; ++j) nn[j] = MSN[j * 64 + tid]; }
    float c0 = 0.f, c1 = 0.f, c2 = 0.f, c3 = 0.f, nk = 0.f, m = 0.f;
#pragma unroll
    for (int j = 0; j < 36; ++j) {
        const float ml = MSS[2 * j], be = MSS[2 * j + 1], mn = fmaxf(be + m, ml), dec = expf(be + m - mn), sc = expf(ml - mn);
        *(unsigned long long*)(base + (size_t)j * 4096) = (unsigned long long)cvt_pk_bf16(c0, c1) | ((unsigned long long)cvt_pk_bf16(c2, c3) << 32);
        if (half == 0 && tid == 0) MSM[j] = m;
        const unsigned lo = (unsigned)v[j], hi = (unsigned)(v[j] >> 32);
        c0 = dec * c0 + sc * bflo(lo); c1 = dec * c1 + sc * bfhi(lo); c2 = dec * c2 + sc * bflo(hi); c3 = dec * c3 + sc * bfhi(hi);
        if (don) { MSN[j * 64 + tid] = nk; nk = dec * nk + sc * nn[j]; }
        m = mn;
    }
}
__device__ __forceinline__ void ml_out_item(const Ctx& C, int l, int b, int hd, int c) {
    const bf16_t* Z = (const bf16_t*)(C.ws + WS_Z); const float* GT = (const float*)(C.ws + WS_GATES); bf16_t* Y = (bf16_t*)(C.ws + WS_HY);
    const bf16_t* MST = (const bf16_t*)(C.ws + WS_MST); const float* MSN = (const float*)(C.ws + WS_MISC + MSN_OFF); const float* MSM = (const float*)(C.ws + WS_MISC + MSM_OFF);
    LAS bf16_t* Qs = (LAS bf16_t*)C.lds; LAS bf16_t* Ks = Qs + 64 * TS; LAS bf16_t* VT = Ks + 64 * TS; LAS bf16_t* CF = VT + 64 * TS; LAS bf16_t* CB = CF + 64 * TS;
    LAS float* QK = (LAS float*)(C.lds + 46080);
    LAS bf16_t* AP = (LAS bf16_t*)(C.lds + 63488);
    LAS float* sc = (LAS float*)(C.lds + 89088);
    const int r0 = ml_row0(b, c), tid = C.tid, lane = C.lane, chf = (b * 4 + hd) * 2, jf = ml_jf(c), jb = ml_jb(c);
    const int s = tid >> 3, c8 = 8 * (tid & 7);
    { const bf16_t* zr = Z + (size_t)(r0 + s) * ZLD + hd * 64 + c8;
      const u32x4 qw = *(const u32x4*)zr, kw = *(const u32x4*)(zr + 256), vw = *(const u32x4*)(zr + 512);
      const u32x4 cf = *(const u32x4*)(MST + (size_t)((chf) * 36 + jf) * 4096 + s * 64 + c8), cb = *(const u32x4*)(MST + (size_t)((chf + 1) * 36 + jb) * 4096 + s * 64 + c8);
      if (C.wave < 2) { const int dir = C.wave, tok = dir ? 63 - lane : lane; LAS float* sd = sc + dir * 256;
        const float ig = GT[(size_t)(r0 + tok) * 16 + dir * 8 + hd], lf = logsig(GT[(size_t)(r0 + tok) * 16 + dir * 8 + 4 + hd]), min_ = MSM[(chf + dir) * 36 + (dir ? jb : jf)];
        const float bb = scan_add(lf, lane), a = ig - bb, pm = scan_max(a, lane), mx = fmaxf(min_, pm);
        sd[tok] = -mx; sd[64 + tok] = a; sd[128 + tok] = expf(min_ - mx); sd[192 + tok] = expf(-(bb + mx));
        sc[512 + dir * 64 + lane] = MSN[(size_t)((chf + dir) * 36 + (dir ? jb : jf)) * 64 + lane]; }
      *(LAS u32x4*)(Qs + s * TS + c8) = qw; *(LAS u32x4*)(CF + s * TS + c8) = cf; *(LAS u32x4*)(CB + s * TS + c8) = cb;
      const unsigned kk[4] = {kw.x, kw.y, kw.z, kw.w}, vv[4] = {vw.x, vw.y, vw.z, vw.w}; u32x4 ks;
      ks.x = cvt_pk_bf16(bflo(kk[0]) * 0.125f, bfhi(kk[0]) * 0.125f); ks.y = cvt_pk_bf16(bflo(kk[1]) * 0.125f, bfhi(kk[1]) * 0.125f); ks.z = cvt_pk_bf16(bflo(kk[2]) * 0.125f, bfhi(kk[2]) * 0.125f); ks.w = cvt_pk_bf16(bflo(kk[3]) * 0.125f, bfhi(kk[3]) * 0.125f);
      *(LAS u32x4*)(Ks + s * TS + c8) = ks;
#pragma unroll
      for (int e = 0; e < 4; ++e) { VT[(c8 + 2 * e) * TS + s] = (bf16_t)(vv[e] & 0xffffu); VT[(c8 + 2 * e + 1) * TS + s] = (bf16_t)(vv[e] >> 16); } }
    __syncthreads();
    for (int t = C.wave; t < 16; t += 8) { const int mt = t >> 2, nt = t & 3; f32x4 acc = {0.f, 0.f, 0.f, 0.f};
        lds_mma<64>(acc, Qs + mt * 16 * TS, TS, Ks + nt * 16 * TS, TS, lane);
#pragma unroll
        for (int r = 0; r < 4; ++r) QK[(mt * 16 + 4 * (lane >> 4) + r) * 68 + nt * 16 + (lane & 15)] = acc[r]; }
    __syncthreads();
    { const int t = tid >> 3, s0 = 8 * (tid & 7);
      const float rtf = sc[t], wf = sc[128 + t], emf = sc[192 + t], rtb = sc[256 + t], wb = sc[256 + 128 + t], emb = sc[256 + 192 + t];
      float sf[8], sb[8], rsf = 0.f, rsb = 0.f, qnf = 0.f, qnb = 0.f;
      const u32x4 qw = *(const LAS u32x4*)(Qs + t * TS + s0); const unsigned qq[4] = {qw.x, qw.y, qw.z, qw.w}; float qv[8];
#pragma unroll
      for (int e = 0; e < 4; ++e) { qv[2 * e] = bflo(qq[e]); qv[2 * e + 1] = bfhi(qq[e]); }
#pragma unroll
      for (int e = 0; e < 8; ++e) { const int ss = s0 + e; const float qk = QK[t * 68 + ss];
        sf[e] = (ss <= t) ? qk * expf(rtf + sc[64 + ss]) : 0.f; sb[e] = (ss >= t) ? qk * expf(rtb + sc[256 + 64 + ss]) : 0.f; rsf += sf[e]; rsb += sb[e];
        qnf += qv[e] * sc[512 + ss]; qnb += qv[e] * sc[576 + ss]; }
#pragma unroll
      for (int o = 1; o < 8; o <<= 1) { rsf += __shfl_xor(rsf, o); rsb += __shfl_xor(rsb, o); qnf += __shfl_xor(qnf, o); qnb += __shfl_xor(qnb, o); }
      const float idf = 1.0f / fmaxf(fabsf(rsf + wf * qnf), emf), idb = 1.0f / fmaxf(fabsf(rsb + wb * qnb), emb), qf = wf * idf, qb = wb * idb;
      u32x4 pw, fw, bw;
      pw.x = cvt_pk_bf16(sf[0] * idf + sb[0] * idb, sf[1] * idf + sb[1] * idb); pw.y = cvt_pk_bf16(sf[2] * idf + sb[2] * idb, sf[3] * idf + sb[3] * idb);
      pw.z = cvt_pk_bf16(sf[4] * idf + sb[4] * idb, sf[5] * idf + sb[5] * idb); pw.w = cvt_pk_bf16(sf[6] * idf + sb[6] * idb, sf[7] * idf + sb[7] * idb);
      fw.x = cvt_pk_bf16(qv[0] * qf, qv[1] * qf); fw.y = cvt_pk_bf16(qv[2] * qf, qv[3] * qf); fw.z = cvt_pk_bf16(qv[4] * qf, qv[5] * qf); fw.w = cvt_pk_bf16(qv[6] * qf, qv[7] * qf);
      bw.x = cvt_pk_bf16(qv[0] * qb, qv[1] * qb); bw.y = cvt_pk_bf16(qv[2] * qb, qv[3] * qb); bw.z = cvt_pk_bf16(qv[4] * qb, qv[5] * qb); bw.w = cvt_pk_bf16(qv[6] * qb, qv[7] * qb);
      *(LAS u32x4*)(AP + t * 200 + s0) = pw; *(LAS u32x4*)(AP + t * 200 + 64 + s0) = fw; *(LAS u32x4*)(AP + t * 200 + 128 + s0) = bw; }
    __syncthreads();
    for (int t = C.wave; t < 16; t += 8) { const int mt = t >> 2, nt = t & 3; f32x4 acc = {0.f, 0.f, 0.f, 0.f};
        lds_mma<64>(acc, AP + mt * 16 * 200, 200, VT + nt * 16 * TS, TS, lane);
        lds_mma<64>(acc, AP + mt * 16 * 200 + 64, 200, CF + nt * 16 * TS, TS, lane);
        lds_mma<64>(acc, AP + mt * 16 * 200 + 128, 200, CB + nt * 16 * TS, TS, lane);
#pragma unroll
        for (int r = 0; r < 4; ++r) QK[(mt * 16 + 4 * (lane >> 4) + r) * 68 + nt * 16 + (lane & 15)] = acc[r]; }
    __syncthreads();
    { const int t = tid >> 3, v0 = 8 * (tid & 7); float h[8]; float sm = 0.f;
#pragma unroll
      for (int e = 0; e < 8; ++e) { h[e] = QK[t * 68 + v0 + e]; sm += h[e]; }
      sm += __shfl_xor(sm, 1); sm += __shfl_xor(sm, 2); sm += __shfl_xor(sm, 4); const float mu = sm * (1.0f / 64.0f); float q = 0.f;
#pragma unroll
      for (int e = 0; e < 8; ++e) { h[e] -= mu; q += h[e] * h[e]; }
      q += __shfl_xor(q, 1); q += __shfl_xor(q, 2); q += __shfl_xor(q, 4); const float rstd = 1.0f / sqrtf(q * (1.0f / 64.0f) + LN_EPS);
      const float* nw = C.in[I_MNORM] + l * 256 + hd * 64 + v0; const u32x4 ow = *(const u32x4*)(Z + (size_t)(r0 + t) * ZLD + 768 + hd * 64 + v0); const unsigned oo[4] = {ow.x, ow.y, ow.z, ow.w};
      float y[8];
#pragma unroll
      for (int e = 0; e < 4; ++e) { y[2 * e] = h[2 * e] * rstd * nw[2 * e] * sigm(bflo(oo[e])); y[2 * e + 1] = h[2 * e + 1] * rstd * nw[2 * e + 1] * sigm(bfhi(oo[e])); }
      u32x4 w; w.x = cvt_pk_bf16(y[0], y[1]); w.y = cvt_pk_bf16(y[2], y[3]); w.z = cvt_pk_bf16(y[4], y[5]); w.w = cvt_pk_bf16(y[6], y[7]);
      *(u32x4*)(Y + (size_t)(r0 + t) * D + hd * 64 + v0) = w; }
    __syncthreads();
}
__device__ __forceinline__ const bf16_t* wt_ptr(const Ctx& C, int l, size_t off) { return (const bf16_t*)(C.ws + WS_WT + (size_t)l * WT_LAYER + off); }
template <class Epi> __device__ __forceinline__ void run_gemm(const Ctx& C, const Gemm& g, const Epi& E) {
    StaticOrder S; S.init(g.M, g.N, C.G, C.bid);
    gemm_phase<Epi, StaticOrder, true, true>(C.lds, g, S, E);
}
__device__ __forceinline__ void p_inproj(const Ctx& C, int l) {
    Gemm g{(const bf16_t*)(C.ws + WS_HY), wt_ptr(C, l, WT_IN), NROWS, 2560, D, D, D, 0, 0};
    EpiInProj E{(bf16_t*)(C.ws + WS_Z), (bf16_t*)(C.ws + WS_UH), (float*)(C.ws + WS_GATES), C.in[I_GBIAS] + l * 16}; run_gemm(C, g, E);
}
__device__ __forceinline__ void p_outproj(const Ctx& C, int l) {
    Gemm g{(const bf16_t*)(C.ws + WS_HY), wt_ptr(C, l, WT_OUT), l == 0 ? NROWS : NLAT, D, D, D, D, 0, 0};
    float* XC = (float*)(C.ws + WS_XC);
    EpiResGate E{l == 0 ? C.in[I_X] : C.out, l == 0 ? C.in[I_CTX] : XC, C.out, XC, (const float*)(C.ws + WS_MOD) + (size_t)l * 17 * 6144 + 2048, ALPHA}; run_gemm(C, g, E);
}
__device__ __forceinline__ void p_ffnin(const Ctx& C, int l) {
    Gemm g{(const bf16_t*)(C.ws + WS_HY), wt_ptr(C, l, WT_FFIN), l == 0 ? NROWS : NLAT, 2 * DFF, D, D, D, 0, 0};
    EpiSwiGlu E{(bf16_t*)(C.ws + WS_ACT), DFF}; run_gemm(C, g, E);
}
__device__ __forceinline__ void p_ffnout(const Ctx& C, int l) {
    Gemm g{(const bf16_t*)(C.ws + WS_ACT), wt_ptr(C, l, WT_FFOUT), l == 0 ? NROWS : NLAT, D, DFF, DFF, DFF, 0, 0};
    float* XC = (float*)(C.ws + WS_XC);
    EpiResGate E{C.out, XC, C.out, XC, (const float*)(C.ws + WS_MOD) + (size_t)l * 17 * 6144 + 5120, ALPHA}; run_gemm(C, g, E);
}
__device__ __forceinline__ void s5_table_item(const Ctx& C, int l, int g, int part) {
    LAS float* APW = (LAS float*)C.lds;
    LAS float* BB = APW + 4352;
    LAS float* CC = BB + 4096;
    LAS float* KT = CC + 2048;
    const int tid = C.tid;
    if (tid < 128) { const int d = tid >> 6, n = tid & 63, ix = ((l * 2 + d) * 16 + g) * 64 + n;
        const double are = C.in[I_ARE][ix], aim = C.in[I_AIM][ix], dt = exp((double)C.in[I_LDT][(l * 2 + d) * 16 + g]);
        const double mag = exp(are * dt), abr = mag * cos(aim * dt), abi = mag * sin(aim * dt), d2 = are * are + aim * aim;
        const double cr = ((abr - 1.0) * are + abi * aim) / d2, ci = (abi * are - (abr - 1.0) * aim) / d2;
        double pr = 1.0, pi = 0.0;
        for (int k = 0; k < 17; ++k) { APW[((d * 17 + k) * 64 + n) * 2] = (float)pr; APW[((d * 17 + k) * 64 + n) * 2 + 1] = (float)pi; const double t = pr * abr - pi * abi; pi = pr * abi + pi * abr; pr = t; }
        for (int q = 0; q < 16; ++q) { const double re = C.in[I_BRE][((size_t)(l * 16 + g) * 64 + n) * 16 + q], im = C.in[I_BIM][((size_t)(l * 16 + g) * 64 + n) * 16 + q];
            BB[((d * 64 + n) * 16 + q) * 2] = (float)(cr * re - ci * im); BB[((d * 64 + n) * 16 + q) * 2 + 1] = (float)(cr * im + ci * re); } }
    for (int idx = tid; idx < 1024; idx += 512) { const int p = idx >> 6, n = idx & 63; CC[idx * 2] = C.in[I_CRE][((size_t)(l * 16 + g) * 16 + p) * 64 + n]; CC[idx * 2 + 1] = C.in[I_CIM][((size_t)(l * 16 + g) * 16 + p) * 64 + n]; }
    __syncthreads();
    { const int d = tid >> 8, k = (tid >> 4) & 15, p = tid & 15; float acc[16];
#pragma unroll
      for (int q = 0; q < 16; ++q) acc[q] = 0.f;
      for (int n = 0; n < 64; ++n) { const float cr = CC[(p * 64 + n) * 2], ci = CC[(p * 64 + n) * 2 + 1], ar = APW[((d * 17 + k) * 64 + n) * 2], ai = APW[((d * 17 + k) * 64 + n) * 2 + 1];
          const float zr = cr * ar - ci * ai, zi = cr * ai + ci * ar;
#pragma unroll
          for (int q = 0; q < 16; ++q) acc[q] += zr * BB[((d * 64 + n) * 16 + q) * 2] - zi * BB[((d * 64 + n) * 16 + q) * 2 + 1]; }
#pragma unroll
      for (int q = 0; q < 16; ++q) KT[((d * 16 + k) * 16 + p) * 16 + q] = acc[q]; }
    __syncthreads();
    bf16_t* BtY = (bf16_t*)(C.ws + WS_WT + (size_t)l * WT_LAYER + WT_BTY) + (size_t)g * 256 * 512; bf16_t* BtS = (bf16_t*)(C.ws + WS_WT + (size_t)l * WT_LAYER + WT_BTS) + (size_t)g * 256 * 256;
    for (int i = 0; i < 4; ++i) { const int idx = tid + 512 * i, row = part * 32 + (idx >> 6), col0 = (idx & 63) * 8, t = row >> 4, p = row & 15; float v[8];
        if (col0 < 256) { const int s = col0 >> 4, q0 = col0 & 15;
#pragma unroll
            for (int e = 0; e < 8; ++e) v[e] = s < t ? KT[((0 * 16 + (t - s)) * 16 + p) * 16 + q0 + e] : (s > t ? KT[((1 * 16 + (s - t)) * 16 + p) * 16 + q0 + e] : KT[(p) * 16 + q0 + e] + KT[((16) * 16 + p) * 16 + q0 + e]); }
        else { const int h0 = col0 - 256, ds = h0 >> 7, im = (h0 >> 6) & 1, n0 = h0 & 63, kp = ds ? 16 - t : t + 1;
#pragma unroll
            for (int e = 0; e < 8; ++e) { const int n = n0 + e; const float cr = CC[(p * 64 + n) * 2], ci = CC[(p * 64 + n) * 2 + 1], ar = APW[((ds * 17 + kp) * 64 + n) * 2], ai = APW[((ds * 17 + kp) * 64 + n) * 2 + 1];
                v[e] = im ? -(cr * ai + ci * ar) : (cr * ar - ci * ai); } }
        u32x4 w; w.x = cvt_pk_bf16(v[0], v[1]); w.y = cvt_pk_bf16(v[2], v[3]); w.z = cvt_pk_bf16(v[4], v[5]); w.w = cvt_pk_bf16(v[6], v[7]);
        *(u32x4*)(BtY + (size_t)row * 512 + col0) = w; }
    for (int i = 0; i < 2; ++i) { const int idx = tid + 512 * i, row = part * 32 + (idx >> 5), col0 = (idx & 31) * 8, s = col0 >> 4, q0 = col0 & 15, ds = row >> 7, im = (row >> 6) & 1, n = row & 63, kp = ds ? s : 15 - s;
        const float ar = APW[((ds * 17 + kp) * 64 + n) * 2], ai = APW[((ds * 17 + kp) * 64 + n) * 2 + 1]; float v[8];
#pragma unroll
        for (int e = 0; e < 8; ++e) { const float br = BB[((ds * 64 + n) * 16 + q0 + e) * 2], bi = BB[((ds * 64 + n) * 16 + q0 + e) * 2 + 1]; v[e] = im ? (ar * bi + ai * br) : (ar * br - ai * bi); }
        u32x4 w; w.x = cvt_pk_bf16(v[0], v[1]); w.y = cvt_pk_bf16(v[2], v[3]); w.z = cvt_pk_bf16(v[4], v[5]); w.w = cvt_pk_bf16(v[6], v[7]);
        *(u32x4*)(BtS + (size_t)row * 256 + col0) = w; }
    __syncthreads();
}
__device__ __forceinline__ int s5_chunk_id(int b, int dir, int j) { if (j < 16) return 2048 + b * 16 + (dir ? 15 - j : j); const int jl = j - 16; return b * 128 + (dir ? 127 - jl : jl); }
__device__ __forceinline__ void s5_carry_item(const Ctx& C, int l, int item) {
    const int gid = item * 512 + C.tid, n = gid & 63, dir = (gid >> 6) & 1, g = (gid >> 7) & 15, b = gid >> 11;
    const float* S = (const float*)(C.ws + WS_S5S) + (size_t)g * NCH_S5 * 256 + dir * 128 + n; bf16_t* Hh = (bf16_t*)(C.ws + WS_UH) + (size_t)g * NCH_S5 * 512 + 256 + dir * 128 + n;
    const int ix = ((l * 2 + dir) * 16 + g) * 64 + n;
    const double are = C.in[I_ARE][ix], aim = C.in[I_AIM][ix], dt = exp((double)C.in[I_LDT][(l * 2 + dir) * 16 + g]), mag = exp(16.0 * are * dt);
    const float a_r = (float)(mag * cos(16.0 * aim * dt)), a_i = (float)(mag * sin(16.0 * aim * dt));
    float cr = 0.f, ci = 0.f;
    for (int j0 = 0; j0 < 144; j0 += 16) { float sr[16], si[16];
#pragma unroll
        for (int jj = 0; jj < 16; ++jj) { const int ch = s5_chunk_id(b, dir, j0 + jj); sr[jj] = S[(size_t)ch * 256]; si[jj] = S[(size_t)ch * 256 + 64]; }
#pragma unroll
        for (int jj = 0; jj < 16; ++jj) { const int ch = s5_chunk_id(b, dir, j0 + jj); Hh[(size_t)ch * 512] = (bf16_t)f2bf(cr); Hh[(size_t)ch * 512 + 64] = (bf16_t)f2bf(ci);
            const float nr = a_r * cr - a_i * ci + sr[jj], ni = a_r * ci + a_i * cr + si[jj]; cr = nr; ci = ni; } }
}
__device__ __forceinline__ void p_s5_gemmS(const Ctx& C, int l) {
    Gemm g{(const bf16_t*)(C.ws + WS_UH), wt_ptr(C, l, WT_BTS), 16 * NCH_S5, 256, 256, 512, 256, 9, (size_t)256 * 256 * 2};
    EpiF32 E{(float*)(C.ws + WS_S5S), 256}; run_gemm(C, g, E);
}
__device__ __forceinline__ void p_s5_gemmY(const Ctx& C, int l) {
    Gemm g{(const bf16_t*)(C.ws + WS_UH), wt_ptr(C, l, WT_BTY), 16 * NCH_S5, 256, 512, 512, 512, 9, (size_t)256 * 512 * 2};
    EpiS5Y E{(const bf16_t*)(C.ws + WS_UH), C.in[I_DSK] + l * 256, (bf16_t*)(C.ws + WS_YS5)}; run_gemm(C, g, E);
}
__device__ __forceinline__ void p_s5_glu(const Ctx& C, int l) {
    Gemm g{(const bf16_t*)(C.ws + WS_YS5), wt_ptr(C, l, WT_GLU), l == 0 ? NROWS : NLAT, 256, 256, 256, 256, 0, 0};
    EpiGlu E{(const bf16_t*)(C.ws + WS_YS5), C.in[I_GLUB] + l * 256, (bf16_t*)(C.ws + WS_HY)}; run_gemm(C, g, E);
}
__device__ __forceinline__ void p_mixA(const Ctx& C, int l) {
    p_s5_gemmS(C, l);
    __syncthreads();
    const int nsgu = l == 0 ? 288 : 256, ncv = l == 0 ? 576 : 512, total = 2304 + nsgu + ncv;
    for (int it = C.bid; it < total; it += C.G) {
        int r = it;
        if (r < 2304) { const int b = r / 144, q = r % 144; ml_state_item(C, b, q / 36, q % 36); continue; } r -= 2304;
        if (r < nsgu) { sgu_item(C, l, r); continue; } r -= nsgu;
        conv_item(C, l, r);
    }
}
__device__ __forceinline__ void p_mixB(const Ctx& C, int l) {
    for (int it = C.bid; it < 320; it += C.G) { if (it < 256) ml_carry_item(C, it); else s5_carry_item(C, l, it - 256); }
}
__device__ __forceinline__ void p_mixC(const Ctx& C, int l) {
    p_s5_gemmY(C, l);
    __syncthreads();
    const int ncs = l == 0 ? 36 : 32;
    for (int it = C.bid; it < 64 * ncs; it += C.G) { const int bh = it / ncs; ml_out_item(C, l, bh >> 2, bh & 3, it % ncs); }
}

__global__ void __launch_bounds__(512, 2) mk_fwd(Args a) {
    extern __shared__ __attribute__((aligned(16))) unsigned char lds_raw[];
    Ctx C; C.lds = (LAS unsigned char*)lds_raw; C.tid = threadIdx.x; C.lane = C.tid & 63; C.wave = __builtin_amdgcn_readfirstlane(C.tid >> 6); C.bid = blockIdx.x; C.G = gridDim.x;
    C.in = a.in; C.out = a.out; C.ws = a.ws;
    const int lo = a.ph_lo, hi = a.ph_hi;
    volatile LAS unsigned* MISC = (volatile LAS unsigned*)(C.lds + LDS_BYTES - 64);
    if (C.tid < 16) MISC[C.tid] = 0u;
    __syncthreads();
    XcdBarrier bar = xcd_barrier_post((unsigned*)(a.ws + WS_CTL) + 4096, MISC);
#define PH(k, body) if (lo <= (k) && (k) < hi) { body; if ((k) == MK_REPEAT_PH) { xcd_barrier(bar); body; } if ((k) + 1 < hi) { if ((k) == 0) { __threadfence(); cooperative_groups::this_grid().sync(); } else xcd_barrier(bar); } }
    PH(0, p_prologue(C))
    PH(1, p_rowpass(C, 0, 0))
    PH(2, p_inproj(C, 0))
    PH(3, p_mixA(C, 0))
    PH(4, p_mixB(C, 0))
    PH(5, p_mixC(C, 0))
    PH(6, p_s5_glu(C, 0))
    PH(7, p_outproj(C, 0))
    PH(8, p_rowpass(C, 1, 0))
    PH(9, p_ffnin(C, 0))
    PH(10, p_ffnout(C, 0))
    PH(11, p_rowpass(C, 2, 0))
    PH(12, p_inproj(C, 1))
    PH(13, p_mixA(C, 1))
    PH(14, p_mixB(C, 1))
    PH(15, p_mixC(C, 1))
    PH(16, p_s5_glu(C, 1))
    PH(17, p_outproj(C, 1))
    PH(18, p_rowpass(C, 1, 1))
    PH(19, p_ffnin(C, 1))
    PH(20, p_ffnout(C, 1))
    PH(21, p_rowpass(C, 2, 1))
#undef PH
}
}

extern "C" void kernel_launch(void* const* d_in, const int* in_sizes, int n_in, void* d_out, int out_size, void* d_ws, size_t ws_size, hipStream_t stream) {
    static int ready = 0;
    if (!ready) {
        if (n_in != 34 || in_sizes[0] != mk::NLAT * mk::D || out_size != mk::NLAT * mk::D || ws_size < mk::WS_END) { fprintf(stderr, "kernel_launch: unexpected shapes (n_in %d, in0 %d, out %d, ws %zu)\n", n_in, n_in > 0 ? in_sizes[0] : -1, out_size, ws_size); ready = -1; return; }
        if (hipFuncSetAttribute((const void*)mk::mk_fwd, hipFuncAttributeMaxDynamicSharedMemorySize, mk::LDS_BYTES) != hipSuccess) { fprintf(stderr, "kernel_launch: hipFuncSetAttribute failed\n"); ready = -1; return; }
        ready = 1;
    }
    if (ready < 0) return;
    if (hipMemsetAsync((char*)d_ws + mk::WS_CTL, 0, 65536, stream) != hipSuccess) { fprintf(stderr, "kernel_launch: hipMemsetAsync failed\n"); return; }
    mk::Args a{};
    for (int i = 0; i < 34; ++i) a.in[i] = (const float*)d_in[i];
    a.out = (float*)d_out; a.ws = (unsigned char*)d_ws;
#if MK_ONE_LAUNCH
    a.ph_lo = 0; a.ph_hi = mk::NPH;
    void* args[] = {&a};
    hipError_t e = hipLaunchCooperativeKernel((const void*)mk::mk_fwd, dim3(256), dim3(512), args, mk::LDS_BYTES, stream);
    if (e != hipSuccess) fprintf(stderr, "cooperative launch failed: %s\n", hipGetErrorString(e));
#else
    for (int ph = 0; ph < mk::NPH; ++ph) {
        a.ph_lo = ph; a.ph_hi = ph + 1;
        hipLaunchKernelGGL(mk::mk_fwd, dim3(256), dim3(512), mk::LDS_BYTES, stream, a);
    }
#endif
}
```
